# Optimizing an MI355X kernel written in HIP

```python
import math
import jax
import jax.numpy as jnp
from jax import lax
import numpy as np

D_MODEL = 1024
BATCH = 2
SEQ = 16384
DEPTH = 2

GRID_W = 64
CTX_LEN = 256
F32 = jnp.float32

D_FF = 2816
BR_WIDTH = D_MODEL // 2
A_DK = 128
A_WIDTH = BR_WIDTH
A_HEADS = A_WIDTH // A_DK
A_DV = A_WIDTH // A_HEADS
A_CHUNK = 64
B_WIDTH = BR_WIDTH
B_ORDER = 2
B_EMB = 33
B_BANDS = (B_EMB - 1) // 2
B_FFN = 64
B_FAST_DECAY = 0.3
B_SLOW_DECAY = 1.5
B_TARGET = 1e-2
C_HEAD_DIM = 64
C_HEADS = BR_WIDTH // C_HEAD_DIM
C_KV_HEADS = 2
C_GROUP = C_HEADS // C_KV_HEADS
C_WIDTH = C_HEADS * C_HEAD_DIM
C_KV_WIDTH = C_KV_HEADS * C_HEAD_DIM
C_WINDOW = 128
C_BLOCK = C_WINDOW
ROPE_BASE = 10000.0
N_BRANCH = 3
N_MOD = 9
OFF_B = 5 * A_WIDTH
OFF_Q = OFF_B + (B_ORDER + 1) * B_WIDTH
OFF_K = OFF_Q + C_WIDTH
OFF_V = OFF_K + C_KV_WIDTH
OFF_G = OFF_V + C_KV_WIDTH
IN_WIDTH = OFF_G + N_BRANCH * D_MODEL
IN_SPLITS = (OFF_B, OFF_Q, OFF_K, OFF_V, OFF_G)
DN_ALPHA = (2.0 * DEPTH) ** 0.25
DN_BETA = (8.0 * DEPTH) ** -0.25
LN_EPS = 1e-5
RMS_EPS = 1e-6

kernel_name = 'hybrid_hgrn2_hyena_swa_flow_block'


def layer_norm(x, g, b):
    xf = x.astype(F32)
    mu = jnp.mean(xf, axis=-1, keepdims=True)
    var = jnp.mean(jnp.square(xf - mu), axis=-1, keepdims=True)
    return ((xf - mu) * lax.rsqrt(var + LN_EPS) * g.astype(F32) + b.astype(F32)).astype(x.dtype)


def modulate(x, shift, scale):
    return x * (1.0 + scale) + shift


def swiglu(u, w_in, w_out):
    a, b = jnp.split(u @ w_in, 2, axis=-1)
    return (jax.nn.silu(a) * b) @ w_out


def macaron_ffn(h, shift, scale, gate, w_in, w_out, g, b):
    y = swiglu(modulate(h, shift, scale), w_in, w_out)
    return layer_norm(DN_ALPHA * h + 0.5 * gate * y, g, b)


def _heads(a):
    n, b, l, _ = a.shape
    return a.reshape(n, b, l, A_HEADS, -1).transpose(0, 1, 3, 2, 4)


def hgrn_streams(pa, lb):
    q, i, g, zf, zb = jnp.split(pa.astype(F32), 5, axis=-1)
    lbx = lb.astype(F32)[:, None, None, :]
    z = jnp.stack([zf, zb[:, ::-1]], 0)
    logf = jnp.log(lbx + (1.0 - lbx) * jax.nn.sigmoid(z))
    k = (1.0 - lbx) * jax.nn.sigmoid(-z)
    qd = jnp.stack([q, q[:, ::-1]], 0)
    vd = jnp.stack([i, i[:, ::-1]], 0)
    return _heads(qd), _heads(k), _heads(vd), _heads(logf), g


def hgrn_chunk_scan(q, k, v, logf, s0):
    n, b, h, L, _ = q.shape
    nc = L // A_CHUNK

    def to_chunks(a):
        return jnp.moveaxis(a.reshape(n, b, h, nc, A_CHUNK, a.shape[-1]), 3, 0)

    mask = jnp.tril(jnp.ones((A_CHUNK, A_CHUNK), bool))[:, :, None]

    def step(S, inp):
        qc, kc, vc, gc = inp
        bcum = jnp.cumsum(gc, axis=-2)
        inter = jnp.einsum('nbhtk,nbhkv->nbhtv', qc * jnp.exp(bcum), S)
        rel = jnp.exp(jnp.where(mask, bcum[..., :, None, :] - bcum[..., None, :, :], -jnp.inf))
        att = jnp.einsum('nbhtk,nbhsk,nbhtsk->nbhts', qc, kc, rel)
        out = inter + jnp.einsum('nbhts,nbhsv->nbhtv', att, vc)
        blast = bcum[..., -1:, :]
        S = jnp.exp(blast[..., 0, :])[..., None] * S + jnp.einsum(
            'nbhsk,nbhsv->nbhkv', kc * jnp.exp(blast - bcum), vc)
        return S, out

    s_fin, out = lax.scan(step, s0, (to_chunks(q), to_chunks(k), to_chunks(v), to_chunks(logf)))
    out = jnp.moveaxis(out, 0, 3).reshape(n, b, h, L, -1)
    return out, s_fin


def hgrn_readout(out, g, norm_w):
    o = out[0] + out[1][:, :, ::-1]
    o = o.transpose(0, 2, 1, 3)
    o = o * lax.rsqrt(jnp.mean(jnp.square(o), axis=-1, keepdims=True) + RMS_EPS)
    o = o * norm_w.astype(F32).reshape(A_HEADS, A_DV)
    bsz, L = o.shape[:2]
    return o.reshape(bsz, L, A_WIDTH) * jax.nn.silu(g)


def short_conv3(x, w, b):
    xp = jnp.pad(x, ((0, 0), (1, 1), (0, 0)))
    return xp[:, :-2] * w[0] + xp[:, 1:-1] * w[1] + xp[:, 2:] * w[2] + b


def hyena_decay_rates():
    max_decay = math.log(B_TARGET) / B_FAST_DECAY
    min_decay = math.log(B_TARGET) / B_SLOW_DECAY
    return jnp.abs(jnp.linspace(min_decay, max_decay, B_WIDTH, dtype=F32))


def hyena_filters(L, w1, b1, f1, w2, b2, f2, w3):
    pos = jnp.arange(L, dtype=F32)
    t = pos / (L - 1)
    w = 2.0 * math.pi * pos / L
    bands = jnp.linspace(1e-4, B_BANDS - 1, B_BANDS, dtype=F32)
    feats = jnp.concatenate([t[:, None], jnp.cos(w[:, None] * bands), -jnp.sin(w[:, None] * bands)], axis=-1)
    h = jnp.sin(f1.astype(F32) * (feats @ w1.astype(F32) + b1.astype(F32)))
    h = jnp.sin(f2.astype(F32) * (h @ w2.astype(F32) + b2.astype(F32)))
    h = (h @ w3.astype(F32)).reshape(L, 2, B_ORDER, B_WIDTH)
    h = h * jnp.exp(-t[:, None] * hyena_decay_rates())[:, None, None, :]
    h_fwd = h[:, 0]
    h_bwd = h[:0:-1, 1]
    l1 = jnp.sum(jnp.abs(h_fwd), axis=0) + jnp.sum(jnp.abs(h_bwd), axis=0)
    filt = jnp.concatenate([h_fwd, jnp.zeros((1, B_ORDER, B_WIDTH), F32), h_bwd], axis=0)
    return filt / l1


def long_conv(z, filt):
    L = z.shape[1]
    zf = jnp.fft.rfft(z, n=2 * L, axis=1)
    ff = jnp.fft.rfft(filt, n=2 * L, axis=0)
    return jnp.fft.irfft(zf * ff[None], n=2 * L, axis=1)[:, :L]


def hyena_mixer(p, conv_w, conv_b, w1, b1, f1, w2, b2, f2, w3, bias):
    L = p.shape[1]
    parts = jnp.split(short_conv3(p, conv_w, conv_b).astype(F32), B_ORDER + 1, axis=-1)
    filt = hyena_filters(L, w1, b1, f1, w2, b2, f2, w3)
    z = parts[0]
    for n in range(B_ORDER):
        z = parts[n + 1] * (long_conv(z, filt[:, n]) + bias[n].astype(F32) * z)
    return z


def axial_rope_tables(L):
    n_rows = L // GRID_W
    row = jnp.repeat(jnp.arange(n_rows), GRID_W).astype(F32)
    col = jnp.tile(jnp.arange(GRID_W), n_rows).astype(F32)
    nf = C_HEAD_DIM // 4
    inv = ROPE_BASE ** (-jnp.arange(nf, dtype=F32) * 2.0 / (C_HEAD_DIM // 2))
    ang = jnp.concatenate([row[:, None] * inv, col[:, None] * inv], axis=-1)
    return jnp.cos(ang), jnp.sin(ang)


def apply_axial_rope(x, cos, sin):
    bsz, L, hh, _ = x.shape
    nf = C_HEAD_DIM // 4
    xr = x.astype(F32).reshape(bsz, L, hh, 2, 2, nf)
    x1, x2 = xr[..., 0, :], xr[..., 1, :]
    cs = cos.reshape(1, L, 1, 2, nf)
    sn = sin.reshape(1, L, 1, 2, nf)
    out = jnp.stack([x1 * cs - x2 * sn, x2 * cs + x1 * sn], axis=-2)
    return out.reshape(x.shape).astype(x.dtype)


def _sink_column(sink, shape):
    s = sink.astype(F32).reshape(C_KV_HEADS, C_GROUP)[:, :, None, None]
    return jnp.broadcast_to(s, shape)


def windowed_attention(q, k, v, k_ctx, v_ctx, sink):
    bsz, S = q.shape[:2]
    nb = S // C_BLOCK
    scale = C_HEAD_DIM ** -0.5
    qb = q.reshape(bsz, nb, C_BLOCK, C_KV_HEADS, C_GROUP, C_HEAD_DIM)

    def band(a):
        ap = jnp.pad(a, ((0, 0), (C_BLOCK, C_BLOCK), (0, 0), (0, 0)))
        ap = ap.reshape(bsz, nb + 2, C_BLOCK, C_KV_HEADS, C_HEAD_DIM)
        return jnp.concatenate([ap[:, :-2], ap[:, 1:-1], ap[:, 2:]], axis=2)

    kw, vw = band(k), band(v)
    s_loc = jnp.einsum('bnqhgd,bnkhd->bnhgqk', qb, kw).astype(F32) * scale
    s_ctx = jnp.einsum('bnqhgd,bchd->bnhgqc', qb, k_ctx).astype(F32) * scale
    blk = jnp.arange(nb)[:, None, None] * C_BLOCK
    qpos = blk + jnp.arange(C_BLOCK)[None, :, None]
    kpos = blk - C_BLOCK + jnp.arange(3 * C_BLOCK)[None, None, :]
    valid = (jnp.abs(qpos - kpos) <= C_WINDOW) & (kpos >= 0) & (kpos < S)
    s_loc = jnp.where(valid[None, :, None, None], s_loc, -jnp.inf)
    sink_col = _sink_column(sink, s_loc.shape[:-1] + (1,))
    p = jax.nn.softmax(jnp.concatenate([s_loc, s_ctx, sink_col], axis=-1), axis=-1).astype(v.dtype)
    nw = 3 * C_BLOCK
    lc = k_ctx.shape[1]
    o = jnp.einsum('bnhgqk,bnkhd->bnqhgd', p[..., :nw], vw) + jnp.einsum(
        'bnhgqc,bchd->bnqhgd', p[..., nw:nw + lc], v_ctx)
    return o.reshape(bsz, S, C_WIDTH)


def context_attention(q_ctx, k_ctx, v_ctx, sink):
    bsz, lc = q_ctx.shape[:2]
    qg = q_ctx.reshape(bsz, lc, C_KV_HEADS, C_GROUP, C_HEAD_DIM)
    s = jnp.einsum('bqhgd,bkhd->bhgqk', qg, k_ctx).astype(F32) * (C_HEAD_DIM ** -0.5)
    sink_col = _sink_column(sink, s.shape[:-1] + (1,))
    p = jax.nn.softmax(jnp.concatenate([s, sink_col], axis=-1), axis=-1).astype(v_ctx.dtype)
    o = jnp.einsum('bhgqk,bkhd->bqhgd', p[..., :lc], v_ctx)
    return o.reshape(bsz, lc, C_WIDTH)


def merge_branches(ys, pg, w_branch, w_out):
    gates = jnp.split(pg, N_BRANCH, axis=-1)
    m = jax.nn.sigmoid(gates[0]) * (ys[0] @ w_branch[0])
    for n in range(1, N_BRANCH):
        m = m + jax.nn.sigmoid(gates[n]) * (ys[n] @ w_branch[n])
    return m @ w_out


def token_mixer(u, uc, w_in, lb, a_norm_w, b_conv_w, b_conv_b, b_w1, b_b1, b_f1, b_w2, b_b2, b_f2, b_w3,
                b_bias, sink, w_branch, w_out, with_ctx_out):
    bsz, S, _ = u.shape
    lc = uc.shape[1]
    pa, pb, pq, pk, pv, pg = jnp.split(u @ w_in, IN_SPLITS, axis=-1)
    ca, cb, cq, ck, cv, cg = jnp.split(uc @ w_in, IN_SPLITS, axis=-1)
    filt = (b_w1, b_b1, b_f1, b_w2, b_b2, b_f2, b_w3)

    qa_c, ka_c, va_c, lf_c, ga_c = hgrn_streams(ca, lb)
    s0 = jnp.zeros((2, bsz, A_HEADS, A_DK, A_DV), F32)
    oa_c, s_ctx = hgrn_chunk_scan(qa_c, ka_c, va_c, lf_c, s0)
    qa, ka, va, lf, ga = hgrn_streams(pa, lb)
    oa, _ = hgrn_chunk_scan(qa, ka, va, lf, s_ctx)
    y_a = hgrn_readout(oa, ga, a_norm_w).astype(u.dtype)

    y_b = hyena_mixer(pb, b_conv_w, b_conv_b, *filt, b_bias).astype(u.dtype)

    cos, sin = axial_rope_tables(S)
    q = apply_axial_rope(pq.reshape(bsz, S, C_HEADS, C_HEAD_DIM), cos, sin)
    k = apply_axial_rope(pk.reshape(bsz, S, C_KV_HEADS, C_HEAD_DIM), cos, sin)
    v = pv.reshape(bsz, S, C_KV_HEADS, C_HEAD_DIM)
    k_ctx = ck.reshape(bsz, lc, C_KV_HEADS, C_HEAD_DIM)
    v_ctx = cv.reshape(bsz, lc, C_KV_HEADS, C_HEAD_DIM)
    y_c = windowed_attention(q, k, v, k_ctx, v_ctx, sink).astype(u.dtype)

    y = merge_branches((y_a, y_b, y_c), pg, w_branch, w_out)
    if not with_ctx_out:
        return y, None
    yc_a = hgrn_readout(oa_c, ga_c, a_norm_w).astype(uc.dtype)
    yc_b = hyena_mixer(cb, b_conv_w, b_conv_b, *filt, b_bias).astype(uc.dtype)
    yc_c = context_attention(cq.reshape(bsz, lc, C_HEADS, C_HEAD_DIM), k_ctx, v_ctx, sink).astype(uc.dtype)
    yc = merge_branches((yc_a, yc_b, yc_c), cg, w_branch, w_out)
    return y, yc


def setup_inputs(seed: int = 0) -> dict:
    key = jax.random.key(seed)
    ks = jax.random.split(key, 26)

    def nrm(k, shape, scale):
        return jax.random.normal(k, shape, F32) * scale

    gate_offset = jnp.repeat(jnp.array([0.0, 0.0, 1.0] * 3, F32), D_MODEL)
    return {
        'x': nrm(ks[0], (BATCH, SEQ, D_MODEL), 1.0),
        'c': nrm(ks[1], (BATCH, D_MODEL), 1.0),
        'ctx': nrm(ks[2], (BATCH, CTX_LEN, D_MODEL), 1.0),
        'c_ctx': nrm(ks[3], (D_MODEL,), 1.0),
        'ada_w': nrm(ks[4], (DEPTH, D_MODEL, N_MOD * D_MODEL), 0.5 * D_MODEL ** -0.5),
        'ada_b': nrm(ks[5], (DEPTH, N_MOD * D_MODEL), 0.02) + gate_offset,
        'ln_g': 1.0 + nrm(ks[6], (DEPTH, 3, D_MODEL), 0.02),
        'ln_b': nrm(ks[7], (DEPTH, 3, D_MODEL), 0.02),
        'ffn_w_in': nrm(ks[8], (DEPTH, 2, D_MODEL, 2 * D_FF), D_MODEL ** -0.5),
        'ffn_w_out': nrm(ks[9], (DEPTH, 2, D_FF, D_MODEL), DN_BETA * D_FF ** -0.5),
        'mix_w_in': nrm(ks[10], (DEPTH, D_MODEL, IN_WIDTH), D_MODEL ** -0.5),
        'hgrn_lb': nrm(ks[11], (DEPTH, 2, A_WIDTH), 0.5),
        'hgrn_norm_w': 1.0 + nrm(ks[12], (DEPTH, A_WIDTH), 0.02),
        'hyena_conv_w': nrm(ks[13], (DEPTH, 3, (B_ORDER + 1) * B_WIDTH), 3 ** -0.5),
        'hyena_conv_b': nrm(ks[14], (DEPTH, (B_ORDER + 1) * B_WIDTH), 0.02),
        'hyena_w1': nrm(ks[15], (DEPTH, B_EMB, B_FFN), B_EMB ** -0.5),
        'hyena_b1': nrm(ks[16], (DEPTH, B_FFN), 0.1),
        'hyena_f1': 1.0 + nrm(ks[17], (DEPTH, B_FFN), 0.1),
        'hyena_w2': nrm(ks[18], (DEPTH, B_FFN, B_FFN), B_FFN ** -0.5),
        'hyena_b2': nrm(ks[19], (DEPTH, B_FFN), 0.1),
        'hyena_f2': 1.0 + nrm(ks[20], (DEPTH, B_FFN), 0.1),
        'hyena_w3': nrm(ks[21], (DEPTH, B_FFN, 2 * B_ORDER * B_WIDTH), B_FFN ** -0.5),
        'hyena_bias': nrm(ks[22], (DEPTH, B_ORDER, B_WIDTH), 0.5),
        'attn_sink': nrm(ks[23], (DEPTH, C_HEADS), 0.5),
        'branch_w': nrm(ks[24], (DEPTH, N_BRANCH, BR_WIDTH, D_MODEL), BR_WIDTH ** -0.5),
        'out_w': nrm(ks[25], (DEPTH, D_MODEL, D_MODEL), DN_BETA * D_MODEL ** -0.5),
    }


def reference(x, c, ctx, c_ctx, ada_w, ada_b, ln_g, ln_b, ffn_w_in, ffn_w_out, mix_w_in, hgrn_lb, hgrn_norm_w,
              hyena_conv_w, hyena_conv_b, hyena_w1, hyena_b1, hyena_f1, hyena_w2, hyena_b2, hyena_f2, hyena_w3,
              hyena_bias, attn_sink, branch_w, out_w):
    s = jax.nn.softmax(hgrn_lb.astype(F32), axis=0)
    lower_bounds = jnp.cumsum(s, axis=0) - s[0:1]
    h, hc = x, ctx
    for l in range(DEPTH):
        last = l == DEPTH - 1
        mod = jnp.split((jax.nn.silu(c) @ ada_w[l] + ada_b[l])[:, None, :], N_MOD, axis=-1)
        modc = jnp.split(jax.nn.silu(c_ctx) @ ada_w[l] + ada_b[l], N_MOD, axis=-1)
        h = macaron_ffn(h, mod[0], mod[1], mod[2], ffn_w_in[l, 0], ffn_w_out[l, 0], ln_g[l, 0], ln_b[l, 0])
        hc = macaron_ffn(hc, modc[0], modc[1], modc[2], ffn_w_in[l, 0], ffn_w_out[l, 0], ln_g[l, 0], ln_b[l, 0])
        y, yc = token_mixer(modulate(h, mod[3], mod[4]), modulate(hc, modc[3], modc[4]), mix_w_in[l],
                            lower_bounds[l], hgrn_norm_w[l], hyena_conv_w[l], hyena_conv_b[l], hyena_w1[l],
                            hyena_b1[l], hyena_f1[l], hyena_w2[l], hyena_b2[l], hyena_f2[l], hyena_w3[l],
                            hyena_bias[l], attn_sink[l], branch_w[l], out_w[l], not last)
        h = layer_norm(DN_ALPHA * h + mod[5] * y, ln_g[l, 1], ln_b[l, 1])
        h = macaron_ffn(h, mod[6], mod[7], mod[8], ffn_w_in[l, 1], ffn_w_out[l, 1], ln_g[l, 2], ln_b[l, 2])
        if not last:
            hc = layer_norm(DN_ALPHA * hc + modc[5] * yc, ln_g[l, 1], ln_b[l, 1])
            hc = macaron_ffn(hc, modc[6], modc[7], modc[8], ffn_w_in[l, 1], ffn_w_out[l, 1],
                             ln_g[l, 2], ln_b[l, 2])
    return h
```

```cpp
#include <hip/hip_runtime.h>
#include <hip/hip_cooperative_groups.h>
#include <cstdio>
namespace cg = cooperative_groups;
#define LAS __attribute__((address_space(3)))
typedef unsigned short bf16_t;
typedef short bf16x8 __attribute__((ext_vector_type(8)));
typedef float f32x4 __attribute__((ext_vector_type(4)));
typedef float f32x2 __attribute__((ext_vector_type(2)));
typedef float f32x16 __attribute__((ext_vector_type(16)));
typedef unsigned u32x4 __attribute__((ext_vector_type(4)));
typedef unsigned u32x2 __attribute__((ext_vector_type(2)));

constexpr int D = 1024, SEQ = 16384, NLAT = 32768, LCTX = 256, NCTX = 512, MROWS = 33280;
constexpr int DFF = 2816, NFF2 = 5632;
constexpr int NAC = 3328, NPB = 1536, NPG = 3072, NMIX = 7936;
constexpr int NMOD = 9216;
constexpr int FRLEN = 2 * SEQ + 128, FRC = SEQ + 63;
constexpr int ZP = ((SEQ + 2048) / 32) * 40;
constexpr int LDS_BYTES = 2 * ZP * 2 + FRLEN * 2 + 256;
constexpr float DN_ALPHA = 1.41421356237f;

constexpr size_t WS_U = 0;
constexpr size_t WS_HC = WS_U + (size_t)MROWS * D * 2;
constexpr size_t WS_W = WS_HC + (size_t)NCTX * D * 4;
constexpr size_t W_IN = 0, W_OUT = W_IN + (size_t)2 * NFF2 * D * 2, W_MIX = W_OUT + (size_t)2 * D * DFF * 2, W_BR = W_MIX + (size_t)NMIX * D * 2, W_O = W_BR + (size_t)3 * D * 512 * 2, W_END = W_O + (size_t)D * D * 2;
constexpr size_t WS_MISC = WS_W + W_END;
constexpr size_t MI_MODS = 0, MI_TAB = MI_MODS + (size_t)2 * 3 * NMOD * 4, MI_L1 = MI_TAB + 256 * 16 * 2 * 4, MI_L1C = MI_L1 + 2 * 1024 * 4, MI_FC = MI_L1C + 1024 * 4,
                 MI_SC = MI_FC + (size_t)256 * 2048 * 4, MI_Z1C = MI_SC + (size_t)NCTX * 1536 * 4, MI_BAR = MI_Z1C + (size_t)NCTX * 512 * 4, MI_BAR2 = MI_BAR + 256, MI_END = MI_BAR2 + 512;
constexpr size_t WS_BIG = WS_MISC + 8388608;
static_assert(MI_END <= 8388608, "misc");
constexpr size_t WS_TOTAL = 536870912;
constexpr size_t BIG_SIZE = WS_TOTAL - WS_BIG;
constexpr size_t YSZ = (size_t)MROWS * 512 * 2;
constexpr size_t B_PAC = 0, B_OB = (size_t)MROWS * NAC * 2, B_ACT = 0, B_PG = 0, B_Y = (size_t)MROWS * NPG * 2, B_PB = 0, B_T = (size_t)MROWS * NPB * 2,
                 B_F = B_T + (size_t)3 * 512 * 2 * SEQ * 2, B_SCR = B_Y, B_QB = B_OB + YSZ, B_DB = B_QB + YSZ, B_YA = BIG_SIZE - 3 * YSZ, B_YB = B_YA + YSZ, B_YC = B_YB + YSZ;
static_assert(B_DB + (size_t)2 * (MROWS / 16) * 512 * 4 <= B_YA && B_OB + YSZ <= B_YA && B_F + (size_t)1024 * FRLEN * 2 <= B_YA && B_Y + (size_t)MROWS * D * 2 <= B_YA && B_SCR + (size_t)256 * 65536 * 4 <= B_YA && (size_t)MROWS * DFF * 2 <= B_Y, "big region");

struct Args { const float* in[26]; float* out; unsigned char* ws; int ph_lo, ph_hi; };

__device__ __forceinline__ float bf2f(unsigned b) { return __uint_as_float(b << 16); }
__device__ __forceinline__ float bflo(unsigned w) { return __uint_as_float(w << 16); }
__device__ __forceinline__ float bfhi(unsigned w) { return __uint_as_float(w & 0xffff0000u); }
__device__ __forceinline__ unsigned cvt_pk_bf16(float lo, float hi) { unsigned r; asm("v_cvt_pk_bf16_f32 %0, %1, %2" : "=v"(r) : "v"(lo), "v"(hi)); return r; }
__device__ __forceinline__ unsigned cvt_pk_bf16_sw(float lo, float hi) { unsigned a = __float_as_uint(lo), b = __float_as_uint(hi); a += 0x7fffu + ((a >> 16) & 1u); b += 0x7fffu + ((b >> 16) & 1u); return (a >> 16) | (b & 0xffff0000u); }
__device__ __forceinline__ bf16_t f2bf(float f) { return (bf16_t)(cvt_pk_bf16(f, 0.f) & 0xffffu); }
__device__ __forceinline__ int otid() { int t = threadIdx.x; asm volatile("" : "+v"(t)); return t; }
__device__ __forceinline__ f32x4 zero4() { float z; asm volatile("v_mov_b32 %0, 0" : "=v"(z)); return (f32x4){z, z, z, z}; }
__device__ __forceinline__ float sigm(float x) { return __builtin_amdgcn_rcpf(1.f + __builtin_amdgcn_exp2f(-1.44269504089f * x)); }
__device__ __forceinline__ float silu(float x) { return x * __builtin_amdgcn_rcpf(1.f + __builtin_amdgcn_exp2f(-1.44269504089f * x)); }
__device__ __forceinline__ void unpack8(u32x4 w, float* f) { f[0] = bflo(w.x); f[1] = bfhi(w.x); f[2] = bflo(w.y); f[3] = bfhi(w.y); f[4] = bflo(w.z); f[5] = bfhi(w.z); f[6] = bflo(w.w); f[7] = bfhi(w.w); }
__device__ __forceinline__ u32x4 pack8(const float* f) { u32x4 w; w.x = cvt_pk_bf16(f[0], f[1]); w.y = cvt_pk_bf16(f[2], f[3]); w.z = cvt_pk_bf16(f[4], f[5]); w.w = cvt_pk_bf16(f[6], f[7]); return w; }

namespace pg8 {
constexpr int BM = 256, BK = 64, HALF = 128, HTB = HALF * BK * 2, STAGE_BYTES = 8 * HTB, NXCD = 8, WGM = 8;
__device__ __forceinline__ int lds_byte(int r, int c) { const int st = (r >> 4) * 2 + (c >> 5), rr = r & 15, cc = c & 31, ob = rr * 64 + cc * 2; return st * 1024 + (ob ^ (((ob >> 9) & 1) << 5)); }
__device__ __forceinline__ void stage_rc(int b, int& R, int& C) { const int st = b / 1024, sb = b % 1024, swz = sb ^ (((sb >> 9) & 1) << 5); R = (st >> 1) * 16 + swz / 64; C = (st & 1) * 32 + (swz % 64) / 2; }
__device__ __forceinline__ int perm32(int rho) { const int n = rho >> 4, i = rho & 15; return 8 * (i >> 2) + 4 * n + (i & 3); }
struct Unit { int pm, pn, br; };
struct Gemm { const bf16_t* A; const bf16_t* Bt; size_t sA, sB; int lda, ldb, K;
    __device__ __forceinline__ const char* a(int br) const { return (const char*)A + (size_t)br * sA; }
    __device__ __forceinline__ const char* b(int br) const { return (const char*)Bt + (size_t)br * sB; } };
struct Order {
    int nM, nN, nwg, G, c, nbr;
    __device__ void init(int M, int N, int G_, int c_, int nbr_) { nM = M / BM; nN = N / BM; nwg = nM * nN; G = G_; c = c_; nbr = nbr_; }
    __device__ bool next(int i, Unit& u) const {
        const int ti = i / nbr; u.br = i - ti * nbr;
        const long L = (long)ti * G + c; if (L >= nwg) return false;
        int wgid = (int)L; { const int q = nwg / NXCD, r = nwg % NXCD, xcd = wgid % NXCD, off = wgid / NXCD; wgid = (xcd < r ? xcd * (q + 1) : r * (q + 1) + (xcd - r) * q) + off; }
        const int nig = WGM * nN, gid = wgid / nig, fm = gid * WGM, gsz = (nM - fm) < WGM ? (nM - fm) : WGM;
        u.pm = fm + ((wgid % nig) % gsz); u.pn = (wgid % nig) / gsz; return true;
    }
};
struct EpiAny {
    int kind; bf16_t* O; int ldc; const bf16_t* PG; float* scr;
    __device__ __forceinline__ void operator()(const f32x4 (&acc)[2][2][4][2], const Unit& u, int wr, int wc, int fr, int fq) const {
        asm volatile("" : "+v"(fr), "+v"(fq));
        if (kind == 0) {
            const int row0 = u.pm * BM + wr * 64 + fr, col0 = u.pn * BM + wc * 32 + 8 * fq;
#pragma unroll
            for (int ai = 0; ai < 2; ++ai)
#pragma unroll
                for (int m = 0; m < 4; ++m) { bf16_t* rowp = O + (size_t)(row0 + ai * HALF + m * 16) * ldc + col0;
#pragma unroll
                    for (int bj = 0; bj < 2; ++bj) { const f32x4 v0 = acc[ai][bj][m][0], v1 = acc[ai][bj][m][1];
                        u32x4 w; w.x = cvt_pk_bf16(v0[0], v0[1]); w.y = cvt_pk_bf16(v0[2], v0[3]); w.z = cvt_pk_bf16(v1[0], v1[1]); w.w = cvt_pk_bf16(v1[2], v1[3]);
                        *(u32x4*)(rowp + bj * HALF) = w; } }
        } else if (kind == 1) {
            const int row0 = u.pm * BM + wr * 64 + fr, col0 = u.pn * HALF + wc * 32 + 8 * fq;
#pragma unroll
            for (int ai = 0; ai < 2; ++ai)
#pragma unroll
                for (int m = 0; m < 4; ++m) { bf16_t* rowp = O + (size_t)(row0 + ai * HALF + m * 16) * ldc + col0;
                    const f32x4 a0 = acc[ai][0][m][0], a1 = acc[ai][0][m][1], b0 = acc[ai][1][m][0], b1 = acc[ai][1][m][1];
                    u32x4 w; w.x = cvt_pk_bf16(silu(a0[0]) * b0[0], silu(a0[1]) * b0[1]); w.y = cvt_pk_bf16(silu(a0[2]) * b0[2], silu(a0[3]) * b0[3]);
                    w.z = cvt_pk_bf16(silu(a1[0]) * b1[0], silu(a1[1]) * b1[1]); w.w = cvt_pk_bf16(silu(a1[2]) * b1[2], silu(a1[3]) * b1[3]);
                    *(u32x4*)rowp = w; }
        } else {
            const int rl0 = wr * 64 + fr, cl0 = wc * 32 + 8 * fq;
            const bf16_t* gbase = PG + (size_t)u.pm * BM * ldc + u.pn * BM + u.br * 1024; bf16_t* obase = O + (size_t)u.pm * BM * ldc + u.pn * BM;
#define MERGE_LOOP(BODY) _Pragma("unroll") for (int ai = 0; ai < 2; ++ai) _Pragma("unroll") for (int m = 0; m < 4; ++m) { _Pragma("unroll") for (int bj = 0; bj < 2; ++bj) _Pragma("unroll") for (int n = 0; n < 2; ++n) { \
                const unsigned rl = rl0 + ai * HALF + m * 16, cl = cl0 + bj * HALF + 4 * n; const unsigned go = rl * (unsigned)ldc + cl, so = rl * 256u + cl; \
                const u32x2 gw = *(const u32x2*)(gbase + go); f32x4 v = acc[ai][bj][m][n]; \
                v[0] *= sigm(bflo(gw.x)); v[1] *= sigm(bfhi(gw.x)); v[2] *= sigm(bflo(gw.y)); v[3] *= sigm(bfhi(gw.y)); BODY } __builtin_amdgcn_sched_barrier(0); }
            if (u.br == 0) { MERGE_LOOP({ *(f32x4*)(scr + so) = v; }) }
            else if (u.br == 1) { MERGE_LOOP({ v += *(const f32x4*)(scr + so); *(f32x4*)(scr + so) = v; }) }
            else { MERGE_LOOP({ v += *(const f32x4*)(scr + so); u32x2 w; w.x = cvt_pk_bf16(v[0], v[1]); w.y = cvt_pk_bf16(v[2], v[3]); *(u32x2*)(obase + go) = w; }) }
#undef MERGE_LOOP
        }
    }
};

template <class Epi>
__device__ __forceinline__ void gemm_phase(LAS unsigned char* lds, const Gemm g, const Order& S, const Epi& E) {
    const int tid = otid(), wid = __builtin_amdgcn_readfirstlane(tid >> 6), lane = tid & 63, wr = wid >> 2, wc = wid & 3, fr = lane & 15, fq = lane >> 4;
    const int K = g.K, nt = K / BK;
    unsigned voffA[2], voffB[2];
#pragma unroll
    for (int i = 0; i < 2; ++i) { int R, C; stage_rc(tid * 16 + i * 8192, R, C); const int Rb = (R & ~31) + perm32(R & 31);
        voffA[i] = (unsigned)(R * g.lda + C) * 2u; voffB[i] = (unsigned)(Rb * g.ldb + C) * 2u; }
    const size_t kstep = (size_t)(BK * 2);
    const size_t hstepA = (size_t)HALF * g.lda * 2, hstepB = (size_t)HALF * g.ldb * 2;
    const size_t tstepA = 2 * hstepA, tstepB = 2 * hstepB;
    const unsigned ldsw = (unsigned)wid * 1024u;
    const int aoff = lds_byte(wr * 64 + fr, fq * 8), boff = lds_byte(wc * 32 + fr, fq * 8);
#define PG8_SA(b, h) (((b) * 2 + (h)) * HTB)
#define PG8_SB(b, h) ((4 + (b) * 2 + (h)) * HTB)
#define PG8_STAGE(bufoff, gbase, voff) do { _Pragma("unroll") for (int _i = 0; _i < 2; ++_i) \
        __builtin_amdgcn_global_load_lds((const unsigned*)((const char*)(gbase) + (voff)[_i]), (LAS unsigned*)(lds + (bufoff) + ldsw + _i * 8192), 16, 0, 0); } while (0)
#define PG8_LDA(dst, b, h) do { _Pragma("unroll") for (int m = 0; m < 4; ++m) _Pragma("unroll") for (int k = 0; k < 2; ++k) dst[m][k] = *(const LAS bf16x8*)(lds + PG8_SA(b, h) + aoff + m * 2048 + k * 1024); } while (0)
#define PG8_LDB(dst, b, h) do { _Pragma("unroll") for (int n = 0; n < 2; ++n) _Pragma("unroll") for (int k = 0; k < 2; ++k) dst[n][k] = *(const LAS bf16x8*)(lds + PG8_SB(b, h) + boff + n * 2048 + k * 1024); } while (0)
#define PG8_MMA(ai, bj, At, Bt) do { __builtin_amdgcn_s_setprio(1); _Pragma("unroll") for (int m = 0; m < 4; ++m) _Pragma("unroll") for (int n = 0; n < 2; ++n) _Pragma("unroll") for (int k = 0; k < 2; ++k) \
        acc[ai][bj][m][n] = __builtin_amdgcn_mfma_f32_16x16x32_bf16(Bt[n][k], At[m][k], acc[ai][bj][m][n], 0, 0, 0); __builtin_amdgcn_s_setprio(0); } while (0)
#define PG8_WAIT_V(n) asm volatile("s_waitcnt vmcnt(" #n ")" ::: "memory")
#define PG8_WAIT_L(n) asm volatile("s_waitcnt lgkmcnt(" #n ")" ::: "memory")
#define PG8_BAR __builtin_amdgcn_s_barrier()
#define PG8_SCHED __builtin_amdgcn_sched_barrier(0)
    Unit cur, nxt; int ui = 0;
    if (!S.next(0, cur)) return;
    f32x4 acc[2][2][4][2];
#pragma unroll
    for (int a = 0; a < 2; ++a)
#pragma unroll
        for (int b = 0; b < 2; ++b)
#pragma unroll
            for (int m = 0; m < 4; ++m)
#pragma unroll
                for (int n = 0; n < 2; ++n) acc[a][b][m][n] = (f32x4){0.f, 0.f, 0.f, 0.f};
    bf16x8 At[4][2], B0[2][2], B1[2][2];
    const char* cA = g.a(cur.br) + (size_t)cur.pm * tstepA; const char* cB = g.b(cur.br) + (size_t)cur.pn * tstepB;
    PG8_STAGE(PG8_SB(0, 0), cB, voffB); PG8_STAGE(PG8_SA(0, 0), cA, voffA); PG8_STAGE(PG8_SB(0, 1), cB + hstepB, voffB); PG8_STAGE(PG8_SA(0, 1), cA + hstepA, voffA);
    if (wr == 1) PG8_BAR;
    PG8_WAIT_V(4); PG8_BAR;
    PG8_STAGE(PG8_SB(1, 0), cB + kstep, voffB); PG8_STAGE(PG8_SA(1, 0), cA + kstep, voffA); PG8_STAGE(PG8_SB(1, 1), cB + hstepB + kstep, voffB);
    PG8_WAIT_V(6); PG8_BAR;
    for (;;) {
        const bool has_next = S.next(ui + 1, nxt);
        const char* nA = has_next ? g.a(nxt.br) + (size_t)nxt.pm * tstepA : cA; const char* nB = has_next ? g.b(nxt.br) + (size_t)nxt.pn * tstepB : cB;
        for (int t = 0; t < nt; t += 2) {
            const bool last = (t == nt - 2);
            const char* a1 = cA + (size_t)(t + 1) * kstep;
            const char* a2 = last ? nA : cA + (size_t)(t + 2) * kstep; const char* b2 = last ? nB : cB + (size_t)(t + 2) * kstep;
            const char* a3 = a2 + kstep; const char* b3 = b2 + kstep;
            PG8_LDB(B0, 0, 0); PG8_SCHED; PG8_LDA(At, 0, 0); PG8_STAGE(PG8_SA(1, 1), a1 + hstepA, voffA);
            PG8_WAIT_L(8); PG8_BAR; PG8_WAIT_L(0); PG8_MMA(0, 0, At, B0); PG8_BAR; PG8_SCHED;
            PG8_LDB(B1, 0, 1); PG8_STAGE(PG8_SB(0, 0), b2, voffB);
            PG8_BAR; PG8_WAIT_L(0); PG8_MMA(0, 1, At, B1); PG8_BAR;
            PG8_LDA(At, 0, 1); PG8_STAGE(PG8_SA(0, 0), a2, voffA);
            PG8_BAR; PG8_WAIT_L(0); PG8_MMA(1, 0, At, B0); PG8_BAR; PG8_SCHED;
            PG8_STAGE(PG8_SB(0, 1), b2 + hstepB, voffB);
            PG8_WAIT_V(6); PG8_BAR; PG8_MMA(1, 1, At, B1); PG8_BAR;
            PG8_LDB(B0, 1, 0); PG8_SCHED; PG8_LDA(At, 1, 0); PG8_STAGE(PG8_SA(0, 1), a2 + hstepA, voffA);
            PG8_WAIT_L(8); PG8_BAR; PG8_WAIT_L(0); PG8_MMA(0, 0, At, B0); PG8_BAR; PG8_SCHED;
            PG8_LDB(B1, 1, 1); PG8_STAGE(PG8_SB(1, 0), b3, voffB);
            PG8_BAR; PG8_WAIT_L(0); PG8_MMA(0, 1, At, B1); PG8_BAR;
            PG8_LDA(At, 1, 1); PG8_STAGE(PG8_SA(1, 0), a3, voffA);
            PG8_BAR; PG8_WAIT_L(0); PG8_MMA(1, 0, At, B0); PG8_BAR; PG8_SCHED;
            PG8_STAGE(PG8_SB(1, 1), b3 + hstepB, voffB);
            PG8_WAIT_V(6); PG8_BAR; PG8_MMA(1, 1, At, B1); PG8_BAR;
        }
        E(acc, cur, wr, wc, fr, fq);
        if (!has_next) break;
#pragma unroll
        for (int a = 0; a < 2; ++a)
#pragma unroll
            for (int b = 0; b < 2; ++b)
#pragma unroll
                for (int m = 0; m < 4; ++m)
#pragma unroll
                    for (int n = 0; n < 2; ++n) acc[a][b][m][n] = (f32x4){0.f, 0.f, 0.f, 0.f};
        cur = nxt; cA = nA; cB = nB; ++ui;
    }
    PG8_WAIT_V(0);
    if (wr == 0) PG8_BAR;
    PG8_BAR;
#undef PG8_SA
#undef PG8_SB
#undef PG8_STAGE
#undef PG8_LDA
#undef PG8_LDB
#undef PG8_MMA
#undef PG8_WAIT_V
#undef PG8_WAIT_L
#undef PG8_BAR
#undef PG8_SCHED
}
}

struct WTile { const float* s; int lds_; bf16_t* d; int ldd; };
__device__ __forceinline__ WTile wconv_decode(const Args& a, int layer, int it) {
    unsigned char* W = a.ws + WS_W;
    const float* w_in = a.in[8] + (size_t)layer * 2 * D * NFF2; const float* w_out = a.in[9] + (size_t)layer * 2 * DFF * D;
    const float* w_mix = a.in[10] + (size_t)layer * D * NMIX; const float* w_br = a.in[24] + (size_t)layer * 3 * 512 * D; const float* w_o = a.in[25] + (size_t)layer * D * D;
    WTile t;
    if (it < 2816) { const int f = it / 1408, r = it % 1408, kt = r / 88, ntile = r % 88, n0 = ntile * 64, tq = n0 >> 8, rr = n0 & 255;
        const int c0 = rr < 128 ? 128 * tq + rr : DFF + 128 * tq + (rr - 128);
        t.s = w_in + (size_t)f * D * NFF2 + (size_t)kt * 64 * NFF2 + c0; t.lds_ = NFF2; t.d = (bf16_t*)(W + W_IN) + (size_t)(1 - f) * NFF2 * D + (size_t)n0 * D + kt * 64; t.ldd = D; }
    else if (it < 4224) { const int j = it - 2816, f = j / 704, r = j % 704, kt = r / 16, ntile = r % 16;
        t.s = w_out + (size_t)f * DFF * D + (size_t)kt * 64 * D + ntile * 64; t.lds_ = D; t.d = (bf16_t*)(W + W_OUT) + (size_t)(1 - f) * D * DFF + (size_t)ntile * 64 * DFF + kt * 64; t.ldd = DFF; }
    else if (it < 6208) { const int j = it - 4224, kt = j / 124, ntile = j % 124, n0 = ntile * 64;
        const int c0 = n0 < 2560 ? n0 : (n0 < 3328 ? 4096 + (n0 - 2560) : (n0 < 4864 ? 2560 + (n0 - 3328) : n0));
        t.s = w_mix + (size_t)kt * 64 * NMIX + c0; t.lds_ = NMIX; t.d = (bf16_t*)(W + W_MIX) + (size_t)n0 * D + kt * 64; t.ldd = D; }
    else if (it < 6592) { const int j = it - 6208, br = j / 128, r = j % 128, kt = r / 16, ntile = r % 16;
        t.s = w_br + (size_t)br * 512 * D + (size_t)kt * 64 * D + ntile * 64; t.lds_ = D; t.d = (bf16_t*)(W + W_BR) + (size_t)br * D * 512 + (size_t)ntile * 64 * 512 + kt * 64; t.ldd = 512; }
    else { const int j = it - 6592, kt = j / 16, ntile = j % 16;
        t.s = w_o + (size_t)kt * 64 * D + ntile * 64; t.lds_ = D; t.d = (bf16_t*)(W + W_O) + (size_t)ntile * 64 * D + kt * 64; t.ldd = D; }
    return t;
}
__device__ __forceinline__ void phase_wconv(LAS unsigned char* L, const Args& a, int layer, int bid, int G) {
    LAS float* tl = (LAS float*)L;
    const int tid = otid(); const int r0 = tid >> 4, c4 = (tid & 15) * 4;
    int it = bid;
    if (it >= 6848) return;
    WTile cur = wconv_decode(a, layer, it);
    f32x4 v0 = *(const f32x4*)(cur.s + (size_t)r0 * cur.lds_ + c4), v1 = *(const f32x4*)(cur.s + (size_t)(r0 + 32) * cur.lds_ + c4);
    for (; it < 6848; it += G) {
        __syncthreads();
        tl[r0 * 65 + c4] = v0[0]; tl[r0 * 65 + c4 + 1] = v0[1]; tl[r0 * 65 + c4 + 2] = v0[2]; tl[r0 * 65 + c4 + 3] = v0[3];
        tl[(r0 + 32) * 65 + c4] = v1[0]; tl[(r0 + 32) * 65 + c4 + 1] = v1[1]; tl[(r0 + 32) * 65 + c4 + 2] = v1[2]; tl[(r0 + 32) * 65 + c4 + 3] = v1[3];
        __syncthreads();
        WTile nxt = cur;
        if (it + G < 6848) { nxt = wconv_decode(a, layer, it + G); v0 = *(const f32x4*)(nxt.s + (size_t)r0 * nxt.lds_ + c4); v1 = *(const f32x4*)(nxt.s + (size_t)(r0 + 32) * nxt.lds_ + c4); }
        { const int n = tid >> 3, kc = (tid & 7) * 8; float f[8];
#pragma unroll
          for (int j = 0; j < 8; ++j) f[j] = tl[(kc + j) * 65 + n];
          *(u32x4*)(cur.d + (size_t)n * cur.ldd + kc) = pack8(f); }
        cur = nxt;
    }
    __syncthreads();
}

__device__ __forceinline__ void phase_mods(LAS unsigned char* L, const Args& a, int bid, int G) {
    LAS float* sc = (LAS float*)L;
    LAS float* red = sc + 3 * 1024;
    const int tid = otid();
    float* mods = (float*)(a.ws + WS_MISC + MI_MODS);
    for (int e = tid; e < 3 * 1024; e += 512) { const int v = e >> 10, k = e & 1023; const float x = v < 2 ? a.in[1][v * 1024 + k] : a.in[3][k]; sc[e] = silu(x); }
    __syncthreads();
    for (int it = bid; it < 288; it += G) {
        const int layer = it / 144, n = (it % 144) * 64 + (tid & 63), kq = tid >> 6;
        const float* w = a.in[4] + (size_t)layer * D * NMOD + n;
        float s0 = 0.f, s1 = 0.f, s2 = 0.f;
#pragma unroll 8
        for (int k = kq * 128; k < kq * 128 + 128; ++k) { const float wv = w[(size_t)k * NMOD]; s0 += sc[k] * wv; s1 += sc[1024 + k] * wv; s2 += sc[2048 + k] * wv; }
        red[(kq * 3 + 0) * 64 + (tid & 63)] = s0; red[(kq * 3 + 1) * 64 + (tid & 63)] = s1; red[(kq * 3 + 2) * 64 + (tid & 63)] = s2;
        __syncthreads();
        if (tid < 192) { const int v = tid >> 6, c = tid & 63; const int nn = (it % 144) * 64 + c; float s = 0.f;
#pragma unroll
            for (int q = 0; q < 8; ++q) s += red[(q * 3 + v) * 64 + c];
            mods[((size_t)layer * 3 + v) * NMOD + nn] = s + a.in[5][(size_t)layer * NMOD + nn]; }
        __syncthreads();
    }
    const int gt = bid * 512 + tid;
    if (gt < 4096) { const int pos = gt >> 4, f = gt & 15; const float inv = __builtin_amdgcn_exp2f(-(float)f * (13.287712379549449f / 16.0f)); const float ang = (float)pos * inv;
        float* tab = (float*)(a.ws + WS_MISC + MI_TAB); tab[gt * 2] = __cosf(ang); tab[gt * 2 + 1] = __sinf(ang); }
    if (gt < 3072) ((float*)(a.ws + WS_MISC + MI_L1))[gt] = 0.f;
}

struct LnP { const float* hs_lat; const float* hs_ctx; float* hd_lat; float* hd_ctx; const bf16_t* y; int ldy; const float* mods; int gi; float coef; const float* g; const float* b; const float* mods_u; int si; bf16_t* u; int rows; int mode; };
__device__ __forceinline__ void phase_ln(const LnP& p, int bid, int G) {
    const int tid_ = otid(); const int lane = tid_ & 63, wv = tid_ >> 6;
    const int nw = G * 8, wid = bid * 8 + wv;
    const int per = (MROWS + nw - 1) / nw;
    const int r0 = wid * per, r1 = min(p.rows, r0 + per);
    if (r0 >= r1) return;
    f32x4 t[4], tn[4]; u32x2 yw[4], ywn[4];
#define LN_LOAD(R, T_, Y_) { const int rr = (R); const float* hs = rr < NLAT ? p.hs_lat + (size_t)rr * D : p.hs_ctx + (size_t)(rr - NLAT) * D; \
        _Pragma("unroll") for (int i = 0; i < 4; ++i) { T_[i] = *(const f32x4*)(hs + 4 * lane + 256 * i); Y_[i] = p.mode != 0 ? *(const u32x2*)(p.y + (size_t)rr * p.ldy + 4 * lane + 256 * i) : *(const u32x2*)(hs + 4 * lane + 256 * i); } }
    LN_LOAD(r0, t, yw)
    for (int r = r0; r < r1; ++r) {
        if (r + 1 < r1) LN_LOAD(r + 1, tn, ywn)
        const int v = r < SEQ ? 0 : (r < NLAT ? 1 : 2);
        if (p.mode != 0) {
            const float* gate = p.mods + (size_t)v * NMOD + p.gi * 1024;
            float s = 0.f;
#pragma unroll
            for (int i = 0; i < 4; ++i) { const f32x4 gv = *(const f32x4*)(gate + 4 * lane + 256 * i);
                t[i][0] = DN_ALPHA * t[i][0] + p.coef * gv[0] * bflo(yw[i].x); t[i][1] = DN_ALPHA * t[i][1] + p.coef * gv[1] * bfhi(yw[i].x);
                t[i][2] = DN_ALPHA * t[i][2] + p.coef * gv[2] * bflo(yw[i].y); t[i][3] = DN_ALPHA * t[i][3] + p.coef * gv[3] * bfhi(yw[i].y);
                s += (t[i][0] + t[i][1]) + (t[i][2] + t[i][3]); }
#pragma unroll
            for (int o = 32; o >= 1; o >>= 1) s += __shfl_xor(s, o);
            const float mean = s * (1.0f / 1024.0f); float q = 0.f;
#pragma unroll
            for (int i = 0; i < 4; ++i) { const f32x4 d = t[i] - mean; q += (d[0] * d[0] + d[1] * d[1]) + (d[2] * d[2] + d[3] * d[3]); }
#pragma unroll
            for (int o = 32; o >= 1; o >>= 1) q += __shfl_xor(q, o);
            const float rstd = rsqrtf(q * (1.0f / 1024.0f) + 1e-5f);
            float* hd = r < NLAT ? p.hd_lat + (size_t)r * D : p.hd_ctx + (size_t)(r - NLAT) * D;
#pragma unroll
            for (int i = 0; i < 4; ++i) { const int c = 4 * lane + 256 * i; const f32x4 gv = *(const f32x4*)(p.g + c), bv = *(const f32x4*)(p.b + c);
                t[i] = (t[i] - mean) * rstd * gv + bv; *(f32x4*)(hd + c) = t[i]; }
        }
        if (p.mode != 2) {
            const float* sh = p.mods_u + (size_t)v * NMOD + p.si * 1024; const float* scl = sh + 1024;
#pragma unroll
            for (int i = 0; i < 4; ++i) { const int c = 4 * lane + 256 * i; const f32x4 sv = *(const f32x4*)(sh + c), cv = *(const f32x4*)(scl + c);
                const f32x4 o = t[i] * (1.0f + cv) + sv; u32x2 w; w.x = cvt_pk_bf16(o[0], o[1]); w.y = cvt_pk_bf16(o[2], o[3]);
                *(u32x2*)(p.u + (size_t)r * D + c) = w; }
        }
#pragma unroll
        for (int i = 0; i < 4; ++i) { t[i] = tn[i]; yw[i] = ywn[i]; }
    }
#undef LN_LOAD
}

__device__ __forceinline__ int hgrn_row(int s, int dir, int b) {
    if (s < LCTX) { const int c = dir ? (LCTX - 1 - s) : s; return NLAT + b * LCTX + c; }
    const int t = s - LCTX; const int pos = dir ? (SEQ - 1 - t) : t; return b * SEQ + pos;
}
typedef float f32x4v __attribute__((ext_vector_type(4)));
constexpr int NGRP = MROWS / 16;
__device__ __forceinline__ void hgrn_prepass(bf16_t* PAC, bf16_t* QB, float* DB, const float* lbsrc, int layer, int bid, int G) {
    const int col = otid();
    float lbf = 0.f, lbb = 0.f;
    if (layer == 1) { const float a0 = lbsrc[(0 * 2 + 0) * 512 + col], a1 = lbsrc[(1 * 2 + 0) * 512 + col], c0 = lbsrc[(0 * 2 + 1) * 512 + col], c1 = lbsrc[(1 * 2 + 1) * 512 + col];
        lbf = 1.f / (1.f + __expf(a0 - a1)); lbb = 1.f / (1.f + __expf(c0 - c1)); }
    for (int g = bid; g < NGRP; g += G) {
        bf16_t* base = PAC + (size_t)g * 16 * NAC;
        float q[16], ff[16], fb[16];
#pragma unroll
        for (int t = 0; t < 16; ++t) { const bf16_t* rp = base + (size_t)t * NAC; q[t] = bf2f(rp[col]); ff[t] = lbf + (1.f - lbf) * sigm(bf2f(rp[1536 + col])); fb[t] = lbb + (1.f - lbb) * sigm(bf2f(rp[2048 + col])); }
        float p = 1.f;
#pragma unroll
        for (int t = 0; t < 16; ++t) { p *= ff[t]; const float E = fmaxf(p, 1e-30f); bf16_t* rp = base + (size_t)t * NAC; rp[col] = f2bf(q[t] * E); rp[1536 + col] = f2bf((1.f - ff[t]) * __builtin_amdgcn_rcpf(E)); }
        DB[(size_t)g * 512 + col] = p;
        p = 1.f;
#pragma unroll
        for (int t = 15; t >= 0; --t) { p *= fb[t]; const float E = fmaxf(p, 1e-30f); bf16_t* rp = base + (size_t)t * NAC; QB[((size_t)g * 16 + t) * 512 + col] = f2bf(q[t] * E); rp[2048 + col] = f2bf((1.f - fb[t]) * __builtin_amdgcn_rcpf(E)); }
        DB[((size_t)NGRP + g) * 512 + col] = p;
    }
}
__device__ __forceinline__ void hgrn_scan_item(LAS unsigned char* L, int item, const bf16_t* PAC, const bf16_t* QB, const float* DB, bf16_t* OF, bf16_t* OB) {
    const int vs = item & 7, h = (item >> 3) & 3, b = (item >> 5) & 1, dir = item >> 6;
    const int tid = otid(), wave = tid >> 6, lane = tid & 63, l15 = lane & 15, g4 = lane >> 4;
    LAS bf16_t* Qs = (LAS bf16_t*)L;
    LAS bf16_t* Ks = Qs + 64 * 136;
    LAS bf16_t* KT = Ks + 64 * 136;
    LAS bf16_t* VT = KT + 4 * 128 * 40;
    LAS bf16_t* As = VT + 4 * 16 * 40;
    LAS float* Ds = (LAS float*)(As + 4 * 16 * 40);
    LAS float* O2s = Ds + 4 * 128;
    LAS float* Pp = O2s + 4 * 256;
    __syncthreads();
    for (int e2 = tid; e2 < (4 * 128 * 40 + 4 * 16 * 40 + 4 * 16 * 40) / 2; e2 += 512) ((LAS unsigned*)KT)[e2] = 0u;
    __syncthreads();
    f32x4v accS = (f32x4v){0.f, 0.f, 0.f, 0.f};
    bf16_t* Od = dir ? OB : OF;
    const bf16_t* Qsrc = dir ? QB : PAC; const int qld = dir ? 512 : NAC;
    const int kcol = (dir ? 2048 : 1536) + h * 128, qcol = h * 128, icol = 512 + h * 128 + vs * 16;
    const int st = tid >> 3, kc = (tid & 7) * 16;
    constexpr int NSTEP = LCTX + SEQ;
    u32x4 pq0A, pq1A, pk0A, pk1A, piA = (u32x4){0, 0, 0, 0}, pq0B, pq1B, pk0B, pk1B, piB = (u32x4){0, 0, 0, 0}, pq0C, pq1C, pk0C, pk1C, piC = (u32x4){0, 0, 0, 0}, pq0D, pq1D, pk0D, pk1D, piD = (u32x4){0, 0, 0, 0}; float pdA = 0.f, pdB = 0.f, pdC = 0.f, pdD = 0.f;
#define HG_LOAD(S0_, X) { const int row = hgrn_row((S0_) + st, dir, b); const bf16_t* qp = Qsrc + (size_t)row * qld + qcol + kc; const bf16_t* kp = PAC + (size_t)row * NAC + kcol + kc; \
      pq0##X = *(const u32x4*)qp; pq1##X = *(const u32x4*)(qp + 8); pk0##X = *(const u32x4*)kp; pk1##X = *(const u32x4*)(kp + 8); \
      if (tid < 128) { const int row2 = hgrn_row((S0_) + (tid >> 1), dir, b); pi##X = *(const u32x4*)(PAC + (size_t)row2 * NAC + icol + (tid & 1) * 8); } \
      { const int rowc = hgrn_row((S0_) + (tid >> 7) * 16, dir, b); pd##X = DB[((size_t)dir * NGRP + (rowc >> 4)) * 512 + h * 128 + (tid & 127)]; } }
    HG_LOAD(0, A) HG_LOAD(64, B) HG_LOAD(128, C) HG_LOAD(192, D)
    for (int s0 = 0; s0 < NSTEP; s0 += 256) {
      {
        { const int c = st >> 4, sl = st & 15;
          *(LAS u32x4*)(Qs + st * 136 + kc) = pq0A; *(LAS u32x4*)(Qs + st * 136 + kc + 8) = pq1A; *(LAS u32x4*)(Ks + st * 136 + kc) = pk0A; *(LAS u32x4*)(Ks + st * 136 + kc + 8) = pk1A;
          Ds[tid] = pdA; }
        if (tid < 128) { const unsigned vw[4] = {piA.x, piA.y, piA.z, piA.w}; const int tk = tid >> 1, c = tk >> 4, sl = tk & 15;
#pragma unroll
            for (int e = 0; e < 4; ++e) { VT[(c * 16 + (tid & 1) * 8 + 2 * e) * 40 + sl] = (bf16_t)(vw[e] & 0xffffu); VT[(c * 16 + (tid & 1) * 8 + 2 * e + 1) * 40 + sl] = (bf16_t)(vw[e] >> 16); } }
        __syncthreads();
        if (s0 + 0 + 256 < NSTEP) HG_LOAD(s0 + 0 + 256, A)
        if (wave >= 1 && wave <= 4) { const int c = wave - 1;
            f32x4v sc = (f32x4v){0.f, 0.f, 0.f, 0.f};
#pragma unroll
            for (int ks = 0; ks < 4; ++ks) { const bf16x8 af = *(const LAS bf16x8*)(Qs + (c * 16 + l15) * 136 + 32 * ks + 8 * g4), kfv = *(const LAS bf16x8*)(Ks + (c * 16 + l15) * 136 + 32 * ks + 8 * g4);
                sc = __builtin_amdgcn_mfma_f32_16x16x32_bf16(af, kfv, sc, 0, 0, 0); }
#pragma unroll
            for (int rg = 0; rg < 4; ++rg) { const int t = 4 * g4 + rg; As[(c * 16 + t) * 40 + l15] = f2bf(l15 <= t ? sc[rg] : 0.f); }
            asm volatile("s_waitcnt lgkmcnt(0)" ::: "memory");
            const bf16x8 af2 = *(const LAS bf16x8*)(As + (c * 16 + l15) * 40 + 8 * g4), vfv = *(const LAS bf16x8*)(VT + (c * 16 + l15) * 40 + 8 * g4);
            f32x4v o2 = (f32x4v){0.f, 0.f, 0.f, 0.f}; o2 = __builtin_amdgcn_mfma_f32_16x16x32_bf16(af2, vfv, o2, 0, 0, 0);
#pragma unroll
            for (int rg = 0; rg < 4; ++rg) O2s[(c * 16 + 4 * g4 + rg) * 16 + l15] = o2[rg];
        }
        __syncthreads();
#pragma unroll 1
        for (int c = 0; c < 4; ++c) {
            { const u32x2 qa = *(const LAS u32x2*)(Qs + (c * 16 + l15) * 136 + 16 * wave + 4 * g4);
              const bf16x8 af = __builtin_bit_cast(bf16x8, ((u32x4){qa.x, qa.y, 0u, 0u})), sfv = __builtin_bit_cast(bf16x8, ((u32x4){cvt_pk_bf16_sw(accS[0], accS[1]), cvt_pk_bf16_sw(accS[2], accS[3]), 0u, 0u}));
              f32x4v po = (f32x4v){0.f, 0.f, 0.f, 0.f}; po = __builtin_amdgcn_mfma_f32_16x16x32_bf16(af, sfv, po, 0, 0, 0);
#pragma unroll
              for (int rg = 0; rg < 4; ++rg) Pp[((c * 8 + wave) * 16 + 4 * g4 + rg) * 16 + l15] = po[rg]; }
            { const LAS bf16_t* kg_ = Ks + (c * 16 + 8 * (g4 & 1)) * 136 + 16 * wave + l15;
              const unsigned m_ = g4 < 2 ? 0xffffffffu : 0u;
              const u32x4 aw_ = (u32x4){((unsigned)kg_[0] | ((unsigned)kg_[136] << 16)) & m_, ((unsigned)kg_[2 * 136] | ((unsigned)kg_[3 * 136] << 16)) & m_, ((unsigned)kg_[4 * 136] | ((unsigned)kg_[5 * 136] << 16)) & m_, ((unsigned)kg_[6 * 136] | ((unsigned)kg_[7 * 136] << 16)) & m_};
              const bf16x8 af = __builtin_bit_cast(bf16x8, aw_), bfv = *(const LAS bf16x8*)(VT + (c * 16 + l15) * 40 + 8 * g4);
              const f32x4v dv = *(const LAS f32x4v*)(Ds + c * 128 + 16 * wave + 4 * g4);
              accS = __builtin_amdgcn_mfma_f32_16x16x32_bf16(af, bfv, accS, 0, 0, 0); accS = accS * dv; }
        }
        __syncthreads();
        { const int c = tid >> 7, t = (tid >> 3) & 15, v2 = (tid & 7) * 2; f32x2 sum = *(const LAS f32x2*)(O2s + (c * 16 + t) * 16 + v2);
#pragma unroll
          for (int w = 0; w < 8; ++w) sum += *(const LAS f32x2*)(Pp + ((c * 8 + w) * 16 + t) * 16 + v2);
          const int row = hgrn_row((s0 + 0) + c * 16 + t, dir, b); *(unsigned*)(Od + (size_t)row * 512 + h * 128 + vs * 16 + v2) = cvt_pk_bf16(sum[0], sum[1]); }

      }
      {
        { const int c = st >> 4, sl = st & 15;
          *(LAS u32x4*)(Qs + st * 136 + kc) = pq0B; *(LAS u32x4*)(Qs + st * 136 + kc + 8) = pq1B; *(LAS u32x4*)(Ks + st * 136 + kc) = pk0B; *(LAS u32x4*)(Ks + st * 136 + kc + 8) = pk1B;
          Ds[tid] = pdB; }
        if (tid < 128) { const unsigned vw[4] = {piB.x, piB.y, piB.z, piB.w}; const int tk = tid >> 1, c = tk >> 4, sl = tk & 15;
#pragma unroll
            for (int e = 0; e < 4; ++e) { VT[(c * 16 + (tid & 1) * 8 + 2 * e) * 40 + sl] = (bf16_t)(vw[e] & 0xffffu); VT[(c * 16 + (tid & 1) * 8 + 2 * e + 1) * 40 + sl] = (bf16_t)(vw[e] >> 16); } }
        __syncthreads();
        if (s0 + 64 + 256 < NSTEP) HG_LOAD(s0 + 64 + 256, B)
        if (wave >= 1 && wave <= 4) { const int c = wave - 1;
            f32x4v sc = (f32x4v){0.f, 0.f, 0.f, 0.f};
#pragma unroll
            for (int ks = 0; ks < 4; ++ks) { const bf16x8 af = *(const LAS bf16x8*)(Qs + (c * 16 + l15) * 136 + 32 * ks + 8 * g4), kfv = *(const LAS bf16x8*)(Ks + (c * 16 + l15) * 136 + 32 * ks + 8 * g4);
                sc = __builtin_amdgcn_mfma_f32_16x16x32_bf16(af, kfv, sc, 0, 0, 0); }
#pragma unroll
            for (int rg = 0; rg < 4; ++rg) { const int t = 4 * g4 + rg; As[(c * 16 + t) * 40 + l15] = f2bf(l15 <= t ? sc[rg] : 0.f); }
            asm volatile("s_waitcnt lgkmcnt(0)" ::: "memory");
            const bf16x8 af2 = *(const LAS bf16x8*)(As + (c * 16 + l15) * 40 + 8 * g4), vfv = *(const LAS bf16x8*)(VT + (c * 16 + l15) * 40 + 8 * g4);
            f32x4v o2 = (f32x4v){0.f, 0.f, 0.f, 0.f}; o2 = __builtin_amdgcn_mfma_f32_16x16x32_bf16(af2, vfv, o2, 0, 0, 0);
#pragma unroll
            for (int rg = 0; rg < 4; ++rg) O2s[(c * 16 + 4 * g4 + rg) * 16 + l15] = o2[rg];
        }
        __syncthreads();
#pragma unroll 1
        for (int c = 0; c < 4; ++c) {
            { const u32x2 qa = *(const LAS u32x2*)(Qs + (c * 16 + l15) * 136 + 16 * wave + 4 * g4);
              const bf16x8 af = __builtin_bit_cast(bf16x8, ((u32x4){qa.x, qa.y, 0u, 0u})), sfv = __builtin_bit_cast(bf16x8, ((u32x4){cvt_pk_bf16_sw(accS[0], accS[1]), cvt_pk_bf16_sw(accS[2], accS[3]), 0u, 0u}));
              f32x4v po = (f32x4v){0.f, 0.f, 0.f, 0.f}; po = __builtin_amdgcn_mfma_f32_16x16x32_bf16(af, sfv, po, 0, 0, 0);
#pragma unroll
              for (int rg = 0; rg < 4; ++rg) Pp[((c * 8 + wave) * 16 + 4 * g4 + rg) * 16 + l15] = po[rg]; }
            { const LAS bf16_t* kg_ = Ks + (c * 16 + 8 * (g4 & 1)) * 136 + 16 * wave + l15;
              const unsigned m_ = g4 < 2 ? 0xffffffffu : 0u;
              const u32x4 aw_ = (u32x4){((unsigned)kg_[0] | ((unsigned)kg_[136] << 16)) & m_, ((unsigned)kg_[2 * 136] | ((unsigned)kg_[3 * 136] << 16)) & m_, ((unsigned)kg_[4 * 136] | ((unsigned)kg_[5 * 136] << 16)) & m_, ((unsigned)kg_[6 * 136] | ((unsigned)kg_[7 * 136] << 16)) & m_};
              const bf16x8 af = __builtin_bit_cast(bf16x8, aw_), bfv = *(const LAS bf16x8*)(VT + (c * 16 + l15) * 40 + 8 * g4);
              const f32x4v dv = *(const LAS f32x4v*)(Ds + c * 128 + 16 * wave + 4 * g4);
              accS = __builtin_amdgcn_mfma_f32_16x16x32_bf16(af, bfv, accS, 0, 0, 0); accS = accS * dv; }
        }
        __syncthreads();
        { const int c = tid >> 7, t = (tid >> 3) & 15, v2 = (tid & 7) * 2; f32x2 sum = *(const LAS f32x2*)(O2s + (c * 16 + t) * 16 + v2);
#pragma unroll
          for (int w = 0; w < 8; ++w) sum += *(const LAS f32x2*)(Pp + ((c * 8 + w) * 16 + t) * 16 + v2);
          const int row = hgrn_row((s0 + 64) + c * 16 + t, dir, b); *(unsigned*)(Od + (size_t)row * 512 + h * 128 + vs * 16 + v2) = cvt_pk_bf16(sum[0], sum[1]); }

      }
      {
        { const int c = st >> 4, sl = st & 15;
          *(LAS u32x4*)(Qs + st * 136 + kc) = pq0C; *(LAS u32x4*)(Qs + st * 136 + kc + 8) = pq1C; *(LAS u32x4*)(Ks + st * 136 + kc) = pk0C; *(LAS u32x4*)(Ks + st * 136 + kc + 8) = pk1C;
          Ds[tid] = pdC; }
        if (tid < 128) { const unsigned vw[4] = {piC.x, piC.y, piC.z, piC.w}; const int tk = tid >> 1, c = tk >> 4, sl = tk & 15;
#pragma unroll
            for (int e = 0; e < 4; ++e) { VT[(c * 16 + (tid & 1) * 8 + 2 * e) * 40 + sl] = (bf16_t)(vw[e] & 0xffffu); VT[(c * 16 + (tid & 1) * 8 + 2 * e + 1) * 40 + sl] = (bf16_t)(vw[e] >> 16); } }
        __syncthreads();
        if (s0 + 128 + 256 < NSTEP) HG_LOAD(s0 + 128 + 256, C)
        if (wave >= 1 && wave <= 4) { const int c = wave - 1;
            f32x4v sc = (f32x4v){0.f, 0.f, 0.f, 0.f};
#pragma unroll
            for (int ks = 0; ks < 4; ++ks) { const bf16x8 af = *(const LAS bf16x8*)(Qs + (c * 16 + l15) * 136 + 32 * ks + 8 * g4), kfv = *(const LAS bf16x8*)(Ks + (c * 16 + l15) * 136 + 32 * ks + 8 * g4);
                sc = __builtin_amdgcn_mfma_f32_16x16x32_bf16(af, kfv, sc, 0, 0, 0); }
#pragma unroll
            for (int rg = 0; rg < 4; ++rg) { const int t = 4 * g4 + rg; As[(c * 16 + t) * 40 + l15] = f2bf(l15 <= t ? sc[rg] : 0.f); }
            asm volatile("s_waitcnt lgkmcnt(0)" ::: "memory");
            const bf16x8 af2 = *(const LAS bf16x8*)(As + (c * 16 + l15) * 40 + 8 * g4), vfv = *(const LAS bf16x8*)(VT + (c * 16 + l15) * 40 + 8 * g4);
            f32x4v o2 = (f32x4v){0.f, 0.f, 0.f, 0.f}; o2 = __builtin_amdgcn_mfma_f32_16x16x32_bf16(af2, vfv, o2, 0, 0, 0);
#pragma unroll
            for (int rg = 0; rg < 4; ++rg) O2s[(c * 16 + 4 * g4 + rg) * 16 + l15] = o2[rg];
        }
        __syncthreads();
#pragma unroll 1
        for (int c = 0; c < 4; ++c) {
            { const u32x2 qa = *(const LAS u32x2*)(Qs + (c * 16 + l15) * 136 + 16 * wave + 4 * g4);
              const bf16x8 af = __builtin_bit_cast(bf16x8, ((u32x4){qa.x, qa.y, 0u, 0u})), sfv = __builtin_bit_cast(bf16x8, ((u32x4){cvt_pk_bf16_sw(accS[0], accS[1]), cvt_pk_bf16_sw(accS[2], accS[3]), 0u, 0u}));
              f32x4v po = (f32x4v){0.f, 0.f, 0.f, 0.f}; po = __builtin_amdgcn_mfma_f32_16x16x32_bf16(af, sfv, po, 0, 0, 0);
#pragma unroll
              for (int rg = 0; rg < 4; ++rg) Pp[((c * 8 + wave) * 16 + 4 * g4 + rg) * 16 + l15] = po[rg]; }
            { const LAS bf16_t* kg_ = Ks + (c * 16 + 8 * (g4 & 1)) * 136 + 16 * wave + l15;
              const unsigned m_ = g4 < 2 ? 0xffffffffu : 0u;
              const u32x4 aw_ = (u32x4){((unsigned)kg_[0] | ((unsigned)kg_[136] << 16)) & m_, ((unsigned)kg_[2 * 136] | ((unsigned)kg_[3 * 136] << 16)) & m_, ((unsigned)kg_[4 * 136] | ((unsigned)kg_[5 * 136] << 16)) & m_, ((unsigned)kg_[6 * 136] | ((unsigned)kg_[7 * 136] << 16)) & m_};
              const bf16x8 af = __builtin_bit_cast(bf16x8, aw_), bfv = *(const LAS bf16x8*)(VT + (c * 16 + l15) * 40 + 8 * g4);
              const f32x4v dv = *(const LAS f32x4v*)(Ds + c * 128 + 16 * wave + 4 * g4);
              accS = __builtin_amdgcn_mfma_f32_16x16x32_bf16(af, bfv, accS, 0, 0, 0); accS = accS * dv; }
        }
        __syncthreads();
        { const int c = tid >> 7, t = (tid >> 3) & 15, v2 = (tid & 7) * 2; f32x2 sum = *(const LAS f32x2*)(O2s + (c * 16 + t) * 16 + v2);
#pragma unroll
          for (int w = 0; w < 8; ++w) sum += *(const LAS f32x2*)(Pp + ((c * 8 + w) * 16 + t) * 16 + v2);
          const int row = hgrn_row((s0 + 128) + c * 16 + t, dir, b); *(unsigned*)(Od + (size_t)row * 512 + h * 128 + vs * 16 + v2) = cvt_pk_bf16(sum[0], sum[1]); }

      }
      {
        { const int c = st >> 4, sl = st & 15;
          *(LAS u32x4*)(Qs + st * 136 + kc) = pq0D; *(LAS u32x4*)(Qs + st * 136 + kc + 8) = pq1D; *(LAS u32x4*)(Ks + st * 136 + kc) = pk0D; *(LAS u32x4*)(Ks + st * 136 + kc + 8) = pk1D;
          Ds[tid] = pdD; }
        if (tid < 128) { const unsigned vw[4] = {piD.x, piD.y, piD.z, piD.w}; const int tk = tid >> 1, c = tk >> 4, sl = tk & 15;
#pragma unroll
            for (int e = 0; e < 4; ++e) { VT[(c * 16 + (tid & 1) * 8 + 2 * e) * 40 + sl] = (bf16_t)(vw[e] & 0xffffu); VT[(c * 16 + (tid & 1) * 8 + 2 * e + 1) * 40 + sl] = (bf16_t)(vw[e] >> 16); } }
        __syncthreads();
        if (s0 + 192 + 256 < NSTEP) HG_LOAD(s0 + 192 + 256, D)
        if (wave >= 1 && wave <= 4) { const int c = wave - 1;
            f32x4v sc = (f32x4v){0.f, 0.f, 0.f, 0.f};
#pragma unroll
            for (int ks = 0; ks < 4; ++ks) { const bf16x8 af = *(const LAS bf16x8*)(Qs + (c * 16 + l15) * 136 + 32 * ks + 8 * g4), kfv = *(const LAS bf16x8*)(Ks + (c * 16 + l15) * 136 + 32 * ks + 8 * g4);
                sc = __builtin_amdgcn_mfma_f32_16x16x32_bf16(af, kfv, sc, 0, 0, 0); }
#pragma unroll
            for (int rg = 0; rg < 4; ++rg) { const int t = 4 * g4 + rg; As[(c * 16 + t) * 40 + l15] = f2bf(l15 <= t ? sc[rg] : 0.f); }
            asm volatile("s_waitcnt lgkmcnt(0)" ::: "memory");
            const bf16x8 af2 = *(const LAS bf16x8*)(As + (c * 16 + l15) * 40 + 8 * g4), vfv = *(const LAS bf16x8*)(VT + (c * 16 + l15) * 40 + 8 * g4);
            f32x4v o2 = (f32x4v){0.f, 0.f, 0.f, 0.f}; o2 = __builtin_amdgcn_mfma_f32_16x16x32_bf16(af2, vfv, o2, 0, 0, 0);
#pragma unroll
            for (int rg = 0; rg < 4; ++rg) O2s[(c * 16 + 4 * g4 + rg) * 16 + l15] = o2[rg];
        }
        __syncthreads();
#pragma unroll 1
        for (int c = 0; c < 4; ++c) {
            { const u32x2 qa = *(const LAS u32x2*)(Qs + (c * 16 + l15) * 136 + 16 * wave + 4 * g4);
              const bf16x8 af = __builtin_bit_cast(bf16x8, ((u32x4){qa.x, qa.y, 0u, 0u})), sfv = __builtin_bit_cast(bf16x8, ((u32x4){cvt_pk_bf16_sw(accS[0], accS[1]), cvt_pk_bf16_sw(accS[2], accS[3]), 0u, 0u}));
              f32x4v po = (f32x4v){0.f, 0.f, 0.f, 0.f}; po = __builtin_amdgcn_mfma_f32_16x16x32_bf16(af, sfv, po, 0, 0, 0);
#pragma unroll
              for (int rg = 0; rg < 4; ++rg) Pp[((c * 8 + wave) * 16 + 4 * g4 + rg) * 16 + l15] = po[rg]; }
            { const LAS bf16_t* kg_ = Ks + (c * 16 + 8 * (g4 & 1)) * 136 + 16 * wave + l15;
              const unsigned m_ = g4 < 2 ? 0xffffffffu : 0u;
              const u32x4 aw_ = (u32x4){((unsigned)kg_[0] | ((unsigned)kg_[136] << 16)) & m_, ((unsigned)kg_[2 * 136] | ((unsigned)kg_[3 * 136] << 16)) & m_, ((unsigned)kg_[4 * 136] | ((unsigned)kg_[5 * 136] << 16)) & m_, ((unsigned)kg_[6 * 136] | ((unsigned)kg_[7 * 136] << 16)) & m_};
              const bf16x8 af = __builtin_bit_cast(bf16x8, aw_), bfv = *(const LAS bf16x8*)(VT + (c * 16 + l15) * 40 + 8 * g4);
              const f32x4v dv = *(const LAS f32x4v*)(Ds + c * 128 + 16 * wave + 4 * g4);
              accS = __builtin_amdgcn_mfma_f32_16x16x32_bf16(af, bfv, accS, 0, 0, 0); accS = accS * dv; }
        }
        __syncthreads();
        { const int c = tid >> 7, t = (tid >> 3) & 15, v2 = (tid & 7) * 2; f32x2 sum = *(const LAS f32x2*)(O2s + (c * 16 + t) * 16 + v2);
#pragma unroll
          for (int w = 0; w < 8; ++w) sum += *(const LAS f32x2*)(Pp + ((c * 8 + w) * 16 + t) * 16 + v2);
          const int row = hgrn_row((s0 + 192) + c * 16 + t, dir, b); *(unsigned*)(Od + (size_t)row * 512 + h * 128 + vs * 16 + v2) = cvt_pk_bf16(sum[0], sum[1]); }

      }
    }
#undef HG_LOAD
}
__device__ __forceinline__ void phase_readout(const bf16_t* PAC, bf16_t* OF, const bf16_t* OB, const float* nw, int rows, int bid, int G) {
    const int tid_ = otid(); const int lane = tid_ & 63, wv = tid_ >> 6;
    for (int r = bid * 8 + wv; r < rows; r += G * 8) {
        float a[8], c[8], gg[8];
        unpack8(*(const u32x4*)(OF + (size_t)r * 512 + lane * 8), a); unpack8(*(const u32x4*)(OB + (size_t)r * 512 + lane * 8), c); unpack8(*(const u32x4*)(PAC + (size_t)r * NAC + 1024 + lane * 8), gg);
        float q = 0.f;
#pragma unroll
        for (int j = 0; j < 8; ++j) { a[j] += c[j]; q += a[j] * a[j]; }
        q += __shfl_xor(q, 1); q += __shfl_xor(q, 2); q += __shfl_xor(q, 4); q += __shfl_xor(q, 8);
        const float rs = rsqrtf(q * (1.0f / 128.0f) + 1e-6f);
#pragma unroll
        for (int j = 0; j < 8; ++j) a[j] = a[j] * rs * nw[lane * 8 + j] * silu(gg[j]);
        *(u32x4*)(OF + (size_t)r * 512 + lane * 8) = pack8(a);
    }
}

__device__ __forceinline__ void attn_item(LAS unsigned char* L, int item, const bf16_t* PAC, const float* tab, const float* sink, bf16_t* YC) {
    const bool isctx = item >= 1024;
    int n, hk, b;
    if (!isctx) { n = item & 255; hk = (item >> 8) & 1; b = item >> 9; } else { const int j = item - 1024; n = j & 3; hk = (j >> 2) & 1; b = j >> 3; }
    LAS bf16_t* Ks = (LAS bf16_t*)L;
    LAS bf16_t* Vt = Ks + 64 * 72;
    const int tid = otid(), wave = tid >> 6, lane = tid & 63, c32 = lane & 31, hi = lane >> 5;
    const int g = wave >> 1, qt = wave & 1, head = hk * 4 + g;
    const float qscale = 0.125f * 1.44269504089f;
    const int qi = n * 64 + qt * 32 + c32;
    const int qrow = isctx ? NLAT + b * LCTX + qi : b * SEQ + qi;
    bf16x8 qf[4];
    {
        const bf16_t* qp = PAC + (size_t)qrow * NAC + 2560 + head * 64 + 8 * hi;
        float x0[8], x1[8], x2[8], x3[8];
        unpack8(*(const u32x4*)(qp), x0); unpack8(*(const u32x4*)(qp + 16), x1); unpack8(*(const u32x4*)(qp + 32), x2); unpack8(*(const u32x4*)(qp + 48), x3);
        if (!isctx) {
            const float* tr = tab + ((qi >> 6) * 16 + 8 * hi) * 2; const float* tc = tab + ((qi & 63) * 16 + 8 * hi) * 2;
#pragma unroll
            for (int j = 0; j < 8; ++j) { const float cr = tr[2 * j], sr = tr[2 * j + 1], cc = tc[2 * j], scn = tc[2 * j + 1];
                const float a0 = x0[j], a1 = x1[j], b0 = x2[j], b1 = x3[j];
                x0[j] = a0 * cr - a1 * sr; x1[j] = a1 * cr + a0 * sr; x2[j] = b0 * cc - b1 * scn; x3[j] = b1 * cc + b0 * scn; }
        }
#pragma unroll
        for (int j = 0; j < 8; ++j) { x0[j] *= qscale; x1[j] *= qscale; x2[j] *= qscale; x3[j] *= qscale; }
        qf[0] = __builtin_bit_cast(bf16x8, pack8(x0)); qf[1] = __builtin_bit_cast(bf16x8, pack8(x1)); qf[2] = __builtin_bit_cast(bf16x8, pack8(x2)); qf[3] = __builtin_bit_cast(bf16x8, pack8(x3));
    }
    float m_ = sink[head] * 1.44269504089f, l_ = hi == 0 ? 1.f : 0.f;
    f32x16 O0, O1;
#pragma unroll
    for (int e = 0; e < 16; ++e) { O0[e] = 0.f; O1[e] = 0.f; }
    const int nch = isctx ? 4 : 9;
    for (int ci = 0; ci < nch; ++ci) {
        bool kctx; int kbase;
        if (isctx) { kctx = true; kbase = ci * 64; }
        else if (ci < 5) { kctx = false; kbase = (n - 2 + ci) * 64; if (kbase < 0 || kbase >= SEQ) continue; }
        else { kctx = true; kbase = (ci - 5) * 64; }
        __syncthreads();
        { const int key = tid >> 3, sub = tid & 7, a = sub >> 2, f0 = (sub & 3) * 4;
          const int krow = kctx ? NLAT + b * LCTX + kbase + key : b * SEQ + kbase + key;
          const bf16_t* kp = PAC + (size_t)krow * NAC + 3072 + hk * 64 + a * 32 + f0;
          const u32x2 w1 = *(const u32x2*)kp, w2 = *(const u32x2*)(kp + 16);
          float y1[4] = {bflo(w1.x), bfhi(w1.x), bflo(w1.y), bfhi(w1.y)}, y2[4] = {bflo(w2.x), bfhi(w2.x), bflo(w2.y), bfhi(w2.y)};
          if (!kctx) { const int pos = kbase + key; const int idx = a ? (pos & 63) : (pos >> 6); const float* tp = tab + (idx * 16 + f0) * 2;
#pragma unroll
              for (int j = 0; j < 4; ++j) { const float c = tp[2 * j], s = tp[2 * j + 1]; const float u0 = y1[j], u1 = y2[j]; y1[j] = u0 * c - u1 * s; y2[j] = u1 * c + u0 * s; } }
          u32x2 o1, o2; o1.x = cvt_pk_bf16(y1[0], y1[1]); o1.y = cvt_pk_bf16(y1[2], y1[3]); o2.x = cvt_pk_bf16(y2[0], y2[1]); o2.y = cvt_pk_bf16(y2[2], y2[3]);
          *(LAS u32x2*)(Ks + key * 72 + a * 32 + f0) = o1; *(LAS u32x2*)(Ks + key * 72 + a * 32 + 16 + f0) = o2;
          const u32x4 vw = *(const u32x4*)(PAC + (size_t)krow * NAC + 3200 + hk * 64 + sub * 8);
          Vt[(sub * 8 + 0) * 68 + key] = (bf16_t)(vw.x & 0xffffu); Vt[(sub * 8 + 1) * 68 + key] = (bf16_t)(vw.x >> 16);
          Vt[(sub * 8 + 2) * 68 + key] = (bf16_t)(vw.y & 0xffffu); Vt[(sub * 8 + 3) * 68 + key] = (bf16_t)(vw.y >> 16);
          Vt[(sub * 8 + 4) * 68 + key] = (bf16_t)(vw.z & 0xffffu); Vt[(sub * 8 + 5) * 68 + key] = (bf16_t)(vw.z >> 16);
          Vt[(sub * 8 + 6) * 68 + key] = (bf16_t)(vw.w & 0xffffu); Vt[(sub * 8 + 7) * 68 + key] = (bf16_t)(vw.w >> 16); }
        __syncthreads();
        f32x16 S0, S1;
#pragma unroll
        for (int e = 0; e < 16; ++e) { S0[e] = 0.f; S1[e] = 0.f; }
#pragma unroll
        for (int ks = 0; ks < 4; ++ks) {
            const bf16x8 k0 = *(const LAS bf16x8*)(Ks + (c32) * 72 + ks * 16 + hi * 8), k1 = *(const LAS bf16x8*)(Ks + (32 + c32) * 72 + ks * 16 + hi * 8);
            S0 = __builtin_amdgcn_mfma_f32_32x32x16_bf16(k0, qf[ks], S0, 0, 0, 0); S1 = __builtin_amdgcn_mfma_f32_32x32x16_bf16(k1, qf[ks], S1, 0, 0, 0); }
        float mx = -1e30f;
        if (!kctx) {
#pragma unroll
            for (int e = 0; e < 16; ++e) { const int kp0 = kbase + (e & 3) + 8 * (e >> 2) + 4 * hi; const int d0 = qi - kp0, d1 = d0 - 32;
                if (d0 > 128 || d0 < -128) S0[e] = -1e30f; if (d1 > 128 || d1 < -128) S1[e] = -1e30f; }
        }
#pragma unroll
        for (int e = 0; e < 16; ++e) mx = fmaxf(mx, fmaxf(S0[e], S1[e]));
        mx = fmaxf(mx, __shfl_xor(mx, 32));
        const float mnew = fmaxf(m_, mx), alpha = __builtin_amdgcn_exp2f(m_ - mnew); m_ = mnew;
        float ps = 0.f;
#pragma unroll
        for (int e = 0; e < 16; ++e) { S0[e] = __builtin_amdgcn_exp2f(S0[e] - mnew); S1[e] = __builtin_amdgcn_exp2f(S1[e] - mnew); ps += S0[e] + S1[e]; }
        l_ = l_ * alpha + ps;
#pragma unroll
        for (int e = 0; e < 16; ++e) { O0[e] *= alpha; O1[e] *= alpha; }
#pragma unroll
        for (int kt = 0; kt < 2; ++kt)
#pragma unroll
            for (int s2 = 0; s2 < 2; ++s2) {
                u32x4 w;
                if (kt == 0) { w.x = cvt_pk_bf16_sw(S0[8 * s2 + 0], S0[8 * s2 + 1]); w.y = cvt_pk_bf16_sw(S0[8 * s2 + 2], S0[8 * s2 + 3]); w.z = cvt_pk_bf16_sw(S0[8 * s2 + 4], S0[8 * s2 + 5]); w.w = cvt_pk_bf16_sw(S0[8 * s2 + 6], S0[8 * s2 + 7]); }
                else { w.x = cvt_pk_bf16_sw(S1[8 * s2 + 0], S1[8 * s2 + 1]); w.y = cvt_pk_bf16_sw(S1[8 * s2 + 2], S1[8 * s2 + 3]); w.z = cvt_pk_bf16_sw(S1[8 * s2 + 4], S1[8 * s2 + 5]); w.w = cvt_pk_bf16_sw(S1[8 * s2 + 6], S1[8 * s2 + 7]); }
                const bf16x8 pf = __builtin_bit_cast(bf16x8, w);
                const LAS bf16_t* vp0 = Vt + (c32) * 68 + kt * 32 + 16 * s2 + 4 * hi; const LAS bf16_t* vp1 = vp0 + 32 * 68;
                const u32x2 a0 = *(const LAS u32x2*)vp0, a1 = *(const LAS u32x2*)(vp0 + 8), b0 = *(const LAS u32x2*)vp1, b1 = *(const LAS u32x2*)(vp1 + 8);
                const bf16x8 vf0 = __builtin_bit_cast(bf16x8, ((u32x4){a0.x, a0.y, a1.x, a1.y})), vf1 = __builtin_bit_cast(bf16x8, ((u32x4){b0.x, b0.y, b1.x, b1.y}));
                O0 = __builtin_amdgcn_mfma_f32_32x32x16_bf16(vf0, pf, O0, 0, 0, 0); O1 = __builtin_amdgcn_mfma_f32_32x32x16_bf16(vf1, pf, O1, 0, 0, 0);
            }
    }
    {
        const float lt = l_ + __shfl_xor(l_, 32); const float inv = 1.f / lt;
        bf16_t* yp = YC + (size_t)qrow * 512 + head * 64 + 4 * hi;
#pragma unroll
        for (int i = 0; i < 4; ++i) { u32x2 w; w.x = cvt_pk_bf16(O0[4 * i] * inv, O0[4 * i + 1] * inv); w.y = cvt_pk_bf16(O0[4 * i + 2] * inv, O0[4 * i + 3] * inv); *(u32x2*)(yp + 8 * i) = w;
            u32x2 w2; w2.x = cvt_pk_bf16(O1[4 * i] * inv, O1[4 * i + 1] * inv); w2.y = cvt_pk_bf16(O1[4 * i + 2] * inv, O1[4 * i + 3] * inv); *(u32x2*)(yp + 32 + 8 * i) = w2; }
    }
    __syncthreads();
}

__device__ __forceinline__ void filt_item(LAS unsigned char* L, int item, int Lseq, bool latent, const float* w1, const float* b1, const float* f1, const float* w2, const float* b2, const float* f2, const float* w3, float* l1acc, bf16_t* FR, float* fc) {
    const int tid = otid(), p0 = item * 64;
    LAS float* feats = (LAS float*)L; LAS float* h1 = feats + 64 * 36; LAS float* h2 = h1 + 64 * 64;
    __syncthreads();
    for (int e = tid; e < 64 * 33; e += 512) { const int p = e / 33, j = e % 33; const float pos = (float)(p0 + p);
        float val;
        if (j == 0) val = pos / (float)(Lseq - 1);
        else { const int bi = (j - 1) & 15; const float band = 1e-4f + (float)bi * ((15.0f - 1e-4f) / 15.0f); const float w = 2.0f * 3.14159265358979f * pos / (float)Lseq;
            val = j <= 16 ? __cosf(w * band) : -__sinf(w * band); }
        feats[p * 36 + j] = val; }
    __syncthreads();
    { const int nn = tid & 63, pg = tid >> 6;
      float acc[8];
#pragma unroll
      for (int i = 0; i < 8; ++i) acc[i] = 0.f;
      for (int j = 0; j < 33; ++j) { const float wv = w1[j * 64 + nn];
#pragma unroll
          for (int i = 0; i < 8; ++i) acc[i] += feats[(pg * 8 + i) * 36 + j] * wv; }
      const float bb = b1[nn], ff = f1[nn];
#pragma unroll
      for (int i = 0; i < 8; ++i) h1[(pg * 8 + i) * 64 + nn] = __sinf(ff * (acc[i] + bb)); }
    __syncthreads();
    { const int nn = tid & 63, pg = tid >> 6;
      float acc[8];
#pragma unroll
      for (int i = 0; i < 8; ++i) acc[i] = 0.f;
      for (int j = 0; j < 64; ++j) { const float wv = w2[j * 64 + nn];
#pragma unroll
          for (int i = 0; i < 8; ++i) acc[i] += h1[(pg * 8 + i) * 64 + j] * wv; }
      const float bb = b2[nn], ff = f2[nn];
#pragma unroll
      for (int i = 0; i < 8; ++i) h2[(pg * 8 + i) * 64 + nn] = __sinf(ff * (acc[i] + bb)); }
    __syncthreads();
    for (int jj = 0; jj < 4; ++jj) {
        const int c = tid + 512 * jj;
        const int dirn = c >> 10, ord = (c >> 9) & 1, ch = c & 511;
        const float rate = fabsf(-3.0701134573f + (float)ch * ((-15.350567286f + 3.0701134573f) / 511.0f));
        float asum = 0.f;
        for (int pgp = 0; pgp < 4; ++pgp) {
            float acc[16];
#pragma unroll
            for (int p = 0; p < 16; ++p) acc[p] = 0.f;
            for (int k4 = 0; k4 < 16; ++k4) {
                const float wa = w3[(size_t)(4 * k4) * 2048 + c], wb = w3[(size_t)(4 * k4 + 1) * 2048 + c], wc = w3[(size_t)(4 * k4 + 2) * 2048 + c], wd = w3[(size_t)(4 * k4 + 3) * 2048 + c];
#pragma unroll
                for (int p = 0; p < 16; ++p) { const f32x4 hv = *(const LAS f32x4*)(h2 + (pgp * 16 + p) * 64 + 4 * k4); acc[p] += (hv[0] * wa + hv[1] * wb) + (hv[2] * wc + hv[3] * wd); }
            }
#pragma unroll
            for (int p = 0; p < 16; ++p) { const int pos = p0 + pgp * 16 + p; const float t = (float)pos / (float)(Lseq - 1); const float val = acc[p] * __expf(-t * rate);
                if (!(dirn == 1 && pos == 0)) { asum += fabsf(val);
                    if (latent) { const int m = dirn == 0 ? FRC - pos : FRC + pos; FR[(size_t)(ord * 512 + ch) * FRLEN + m] = f2bf(val); } }
                if (!latent) fc[(size_t)pos * 2048 + c] = val; }
        }
        atomicAdd(l1acc + ord * 512 + ch, asum);
    }
    if (latent) {
        for (int e = tid; e < 4 * 129; e += 512) { const int rr = item * 4 + e / 129, q = e % 129; const int m = q < 64 ? q : (FRC + SEQ + (q - 64)); FR[(size_t)rr * FRLEN + m] = 0; }
    }
}
__device__ __forceinline__ void hyprep_phase(LAS unsigned char* L, const bf16_t* PB, const float* cw, const float* cb, bf16_t* T, int bid, int G) {
    LAS float* xs = (LAS float*)L;
    const int tid = otid();
    u32x4 p0 = (u32x4){0, 0, 0, 0}, p1 = (u32x4){0, 0, 0, 0};
#define HP_LOAD(IT) { const int tt_ = (IT) / 24, ct_ = (IT) % 24; const int r0_ = tt_ * 64, c0_ = ct_ * 64; const int b_ = r0_ >> 14, t0_ = r0_ & (SEQ - 1); \
        { const int rr = tid >> 3, ck = (tid & 7) * 8; const int t = t0_ - 1 + rr; p0 = (t >= 0 && t < SEQ) ? *(const u32x4*)(PB + (size_t)(b_ * SEQ + t) * NPB + c0_ + ck) : (u32x4){0, 0, 0, 0}; } \
        if (tid < 16) { const int rr = 64 + (tid >> 3), ck = (tid & 7) * 8; const int t = t0_ - 1 + rr; p1 = (t >= 0 && t < SEQ) ? *(const u32x4*)(PB + (size_t)(b_ * SEQ + t) * NPB + c0_ + ck) : (u32x4){0, 0, 0, 0}; } }
    int it = bid;
    if (it < 512 * 24) HP_LOAD(it)
    for (; it < 512 * 24; it += G) {
        const int tt = it / 24, ct = it % 24; const int r0 = tt * 64, c0 = ct * 64; const int b = r0 >> 14, t0 = r0 & (SEQ - 1);
        __syncthreads();
        { float f[8]; unpack8(p0, f); const int rr = tid >> 3, ck = (tid & 7) * 8;
#pragma unroll
          for (int j = 0; j < 8; ++j) xs[rr * 65 + ck + j] = f[j];
          if (tid < 16) { unpack8(p1, f); const int rr2 = 64 + (tid >> 3);
#pragma unroll
              for (int j = 0; j < 8; ++j) xs[rr2 * 65 + ck + j] = f[j]; } }
        __syncthreads();
        if (it + G < 512 * 24) HP_LOAD(it + G)
        { const int cl = tid >> 3, tc = (tid & 7) * 8, c = c0 + cl; const float w0 = cw[c], w1 = cw[NPB + c], w2 = cw[2 * NPB + c], bb = cb[c]; float o[8];
#pragma unroll
          for (int j = 0; j < 8; ++j) o[j] = xs[(tc + j) * 65 + cl] * w0 + xs[(tc + j + 1) * 65 + cl] * w1 + xs[(tc + j + 2) * 65 + cl] * w2 + bb;
          *(u32x4*)(T + ((size_t)c * 2 + b) * SEQ + t0 + tc) = pack8(o); }
    }
#undef HP_LOAD
}
__device__ __forceinline__ void hyconv_item(LAS unsigned char* L, int ch, bf16_t* T, const bf16_t* FR, const float* l1acc, const float* hbias) {
    LAS bf16_t* zs = (LAS bf16_t*)L; LAS bf16_t* fr = zs + 2 * ZP;
    const int tid = otid(), wave = tid >> 6, lane = tid & 63, r = lane & 31, h = lane >> 5;
    const int b = wave >> 2, tt0 = (wave & 3) * 4;
    __syncthreads();
    for (int e = tid; e < 2 * 2048; e += 512) { const int bb = e >> 11, ck = e & 2047; const u32x4 w = *(const u32x4*)(T + ((size_t)ch * 2 + bb) * SEQ + ck * 8); const int i = 1024 + ck * 8;
        *(LAS u32x4*)(zs + bb * ZP + (i >> 5) * 40 + (i & 31)) = w; }
    for (int e = tid; e < 2 * 64 * 5; e += 512) { const int bb = e / 320, q = e % 320, blk = q / 5, part = q % 5; const int bk = blk < 32 ? blk : 512 + blk;
        *(LAS u32x4*)(zs + bb * ZP + bk * 40 + part * 8) = (u32x4){0, 0, 0, 0}; }
    for (int ord = 0; ord < 2; ++ord) {
        const bf16_t* frg = FR + (size_t)(ord * 512 + ch) * FRLEN;
        for (int e = tid; e < FRLEN / 8; e += 512) *(LAS u32x4*)(fr + e * 8) = *(const u32x4*)(frg + e * 8);
        __syncthreads();
        f32x16 acc[4];
#pragma unroll
        for (int i = 0; i < 4; ++i)
#pragma unroll
            for (int e = 0; e < 16; ++e) acc[i][e] = 0.f;
        const int s_lo = 64 * tt0 - 1023, s_hi = 64 * (tt0 + 3) + 62;
        const LAS unsigned char* zb = (const LAS unsigned char*)(zs + b * ZP);
#define HY_A(off) ({ const LAS unsigned* ap_ = (const LAS unsigned*)(abase + (off)); const unsigned e0 = ap_[0], e1 = ap_[1], e2 = ap_[2], e3 = ap_[3], e4 = ap_[4]; \
            __builtin_bit_cast(bf16x8, ((u32x4){__builtin_amdgcn_alignbit(e1, e0, shb), __builtin_amdgcn_alignbit(e2, e1, shb), __builtin_amdgcn_alignbit(e3, e2, shb), __builtin_amdgcn_alignbit(e4, e3, shb)})); })
#define HY_MM(i, OFF, AF) acc[i] = __builtin_amdgcn_mfma_f32_32x32x16_bf16(AF, *(const LAS bf16x8*)(bbase + 2560 * (i) + (OFF)), acc[i], 0, 0, 0);
#define HY_SEG(SB, NP, T0, T1, T2, T3) { const int sb_ = (SB); const int m0b = FRC - 16 * sb_ - r + 8 * h; \
            const LAS unsigned char* abase = (const LAS unsigned char*)fr + ((2 * m0b) & ~3) - 32; \
            const LAS unsigned char* bbase = zb + (((32 - ((sb_ + 1) >> 1)) + 32 * tt0 + r) * 40 + 8 * h) * 2; \
            _Pragma("unroll 1") for (int p = 0; p < (NP); ++p) { const bf16x8 a_o = HY_A(32), a_e = HY_A(0); \
                if (T0) HY_MM(0, 32, a_o) if (T1) HY_MM(1, 32, a_o) if (T2) HY_MM(2, 32, a_o) if (T3) HY_MM(3, 32, a_o) \
                if (T0) HY_MM(0, 0, a_e) if (T1) HY_MM(1, 0, a_e) if (T2) HY_MM(2, 0, a_e) if (T3) HY_MM(3, 0, a_e) \
                abase -= 64; bbase -= 80; } }
        const unsigned shb = ((FRC - r) & 1) * 16;
        HY_SEG(s_lo, 32, 1, 0, 0, 0) HY_SEG(s_lo + 64, 32, 1, 1, 0, 0) HY_SEG(s_lo + 128, 32, 1, 1, 1, 0)
        HY_SEG(s_lo + 192, 447, 1, 1, 1, 1)
        HY_SEG(s_lo + 1086, 32, 0, 1, 1, 1) HY_SEG(s_lo + 1150, 32, 0, 0, 1, 1) HY_SEG(s_lo + 1214, 32, 0, 0, 0, 1)
#undef HY_A
#undef HY_MM
#undef HY_SEG
        __syncthreads();
        const float inv = 1.0f / l1acc[ord * 512 + ch], bs = hbias[ord * 512 + ch];
        bf16_t* xg = T + ((size_t)((ord + 1) * 512 + ch) * 2 + b) * SEQ;
#pragma unroll
        for (int i = 0; i < 4; ++i) { const int col = 32 * (tt0 + i) + r;
#pragma unroll
            for (int gq = 0; gq < 4; ++gq) { const int t = 32 * col + 8 * gq + 4 * h; const int iz = 1024 + t;
                LAS u32x2* zp = (LAS u32x2*)(zs + b * ZP + (iz >> 5) * 40 + (iz & 31));
                const u32x2 zw = *zp; const u32x2 xw = *(const u32x2*)(xg + t);
                const float z0 = bflo(zw.x), z1 = bfhi(zw.x), z2 = bflo(zw.y), z3 = bfhi(zw.y);
                const float o0 = bflo(xw.x) * (acc[i][4 * gq] * inv + bs * z0), o1 = bfhi(xw.x) * (acc[i][4 * gq + 1] * inv + bs * z1);
                const float o2 = bflo(xw.y) * (acc[i][4 * gq + 2] * inv + bs * z2), o3 = bfhi(xw.y) * (acc[i][4 * gq + 3] * inv + bs * z3);
                u32x2 ow; ow.x = cvt_pk_bf16(o0, o1); ow.y = cvt_pk_bf16(o2, o3);
                if (ord == 0) *zp = ow; else *(u32x2*)(xg + t) = ow; } }
        __syncthreads();
    }
}
__device__ __forceinline__ void hytrb_phase(LAS unsigned char* L, const bf16_t* T2, bf16_t* YB, int bid, int G) {
    LAS bf16_t* tl = (LAS bf16_t*)L;
    const int tid = otid(); const int cl = tid >> 3, tc = (tid & 7) * 8;
    int it = bid;
    if (it >= 512 * 8) return;
    u32x4 pv;
#define TRB_LOAD(IT) { const int tt_ = (IT) >> 3, ct_ = (IT) & 7; const int r0_ = tt_ * 64, c0_ = ct_ * 64, b_ = r0_ >> 14, t0_ = r0_ & (SEQ - 1); pv = *(const u32x4*)(T2 + ((size_t)(c0_ + cl) * 2 + b_) * SEQ + t0_ + tc); }
    TRB_LOAD(it)
    for (; it < 512 * 8; it += G) {
        const int tt = it >> 3, ct = it & 7; const int r0 = tt * 64, c0 = ct * 64;
        __syncthreads();
        *(LAS u32x4*)(tl + cl * 72 + tc) = pv;
        __syncthreads();
        if (it + G < 512 * 8) TRB_LOAD(it + G)
        { const int tl_ = tid >> 3, cc = (tid & 7) * 8; unsigned w[4];
#pragma unroll
          for (int j = 0; j < 4; ++j) w[j] = (unsigned)tl[(cc + 2 * j) * 72 + tl_] | ((unsigned)tl[(cc + 2 * j + 1) * 72 + tl_] << 16);
          *(u32x4*)(YB + (size_t)(r0 + tl_) * 512 + c0 + cc) = (u32x4){w[0], w[1], w[2], w[3]}; }
    }
#undef TRB_LOAD
    __syncthreads();
}
__device__ __forceinline__ void hyctx_shortconv(const bf16_t* PB, const float* cw, const float* cb, float* SC, int bid, int G) {
    for (int e = bid * 512 + otid(); e < NCTX * NPB; e += G * 512) { const int r = e / NPB, c = e % NPB, t = r & 255;
        const bf16_t* p = PB + (size_t)(NLAT + r) * NPB + c;
        const float xm = t > 0 ? bf2f(p[-NPB]) : 0.f, x0 = bf2f(p[0]), xp = t < 255 ? bf2f(p[NPB]) : 0.f;
        SC[e] = xm * cw[c] + x0 * cw[NPB + c] + xp * cw[2 * NPB + c] + cb[c]; }
}
__device__ __forceinline__ void hyctx_conv(int ord, const float* SC, const float* zin, int ldz, const float* fc, const float* l1c, const float* hbias, float* z1c, bf16_t* YB, int bid, int G) {
    for (int e = bid * 512 + otid(); e < NCTX * 512; e += G * 512) { const int r = e >> 9, ch = e & 511, b = r >> 8, t = r & 255;
        float s = 0.f;
        for (int j = 0; j < 256; ++j) { const int x = t - j; const float fv = x >= 0 ? fc[(size_t)x * 2048 + ord * 512 + ch] : fc[(size_t)(-x) * 2048 + 1024 + ord * 512 + ch];
            s += fv * zin[(size_t)(b * 256 + j) * ldz + ch]; }
        const float zt = zin[(size_t)r * ldz + ch];
        const float o = SC[(size_t)r * NPB + (ord + 1) * 512 + ch] * (s / l1c[ord * 512 + ch] + hbias[ord * 512 + ch] * zt);
        if (ord == 0) z1c[e] = o; else YB[(size_t)(NLAT + r) * 512 + ch] = f2bf(o); }
}

constexpr int NPHASE = 2 + 17 * 2;
#define P_BIG (a.ws + WS_BIG)
#define P_W (a.ws + WS_W)
#define P_U ((bf16_t*)(a.ws + WS_U))
#define P_U2 ((bf16_t*)(P_BIG + (size_t)MROWS * D * 2))
#define P_HC ((float*)(a.ws + WS_HC))
#define P_MODS ((float*)(a.ws + WS_MISC + MI_MODS))
#define P_TAB ((const float*)(a.ws + WS_MISC + MI_TAB))
#define P_ACT ((bf16_t*)(P_BIG + ((sp >= 14 || sp <= 2) ? B_Y : B_ACT)))
#define P_Y ((bf16_t*)(P_BIG + ((sp >= 14 || sp <= 2) ? (size_t)0 : B_Y)))
#define P_PAC ((bf16_t*)(P_BIG + B_PAC))
#define P_OB ((bf16_t*)(P_BIG + B_OB))
#define P_PB ((bf16_t*)(P_BIG + B_PB))
#define P_T ((bf16_t*)(P_BIG + B_T))
#define P_FR ((bf16_t*)(P_BIG + B_F))
#define P_PG ((bf16_t*)(P_BIG + B_PG))
#define P_YA ((bf16_t*)(P_BIG + B_YA))
#define P_YB ((bf16_t*)(P_BIG + B_YB))
#define P_YC ((bf16_t*)(P_BIG + B_YC))
#define P_L1 ((float*)(a.ws + WS_MISC + MI_L1) + layer * 1024)
#define P_L1C ((float*)(a.ws + WS_MISC + MI_L1C))
#define P_FC ((float*)(a.ws + WS_MISC + MI_FC))
#define P_SC ((float*)(a.ws + WS_MISC + MI_SC))
#define P_Z1C ((float*)(a.ws + WS_MISC + MI_Z1C))
#define HY_W1 (a.in[15] + layer * 33 * 64)
#define HY_B1 (a.in[16] + layer * 64)
#define HY_F1 (a.in[17] + layer * 64)
#define HY_W2 (a.in[18] + layer * 64 * 64)
#define HY_B2 (a.in[19] + layer * 64)
#define HY_F2 (a.in[20] + layer * 64)
#define HY_W3 (a.in[21] + (size_t)layer * 64 * 2048)
#define HY_BIAS (a.in[22] + layer * 1024)
#define HY_CW (a.in[13] + layer * 3 * NPB)
#define HY_CB (a.in[14] + layer * NPB)
#define MODL (P_MODS + (size_t)layer * 3 * NMOD)
#define LNG (a.in[6] + (size_t)layer * 3 * D)
#define LNB (a.in[7] + (size_t)layer * 3 * D)
__global__ void __launch_bounds__(512, 2) mega(Args a) {
    extern __shared__ __attribute__((aligned(16))) unsigned char lds_raw[];
    LAS unsigned char* L = (LAS unsigned char*)lds_raw;
    cg::grid_group grid = cg::this_grid();
    const int bid = blockIdx.x, G = gridDim.x;
    if (a.ph_hi - a.ph_lo > 1) grid.sync();
    for (int ph = a.ph_lo; ph < a.ph_hi; ++ph) {
        bool do_gemm = false; pg8::Gemm gg{}; pg8::EpiAny ep{}; int gM = 0, gN = 0, gbr = 1;
        if (ph == 0) { phase_wconv(L, a, 0, bid, G); phase_mods(L, a, bid, G); }
        else if (ph == 1) { LnP p{a.in[0], a.in[2], nullptr, nullptr, nullptr, 0, nullptr, 0, 0.f, nullptr, nullptr, P_MODS, 0, P_U, MROWS, 0}; phase_ln(p, bid, G); }
        else {
            const int layer = (ph - 2) / 17, sp = (ph - 2) % 17;
            const int Mpost = layer == 1 ? NLAT : MROWS;
            switch (sp) {
            case 0: case 14: {
                const int f = sp == 0 ? 1 : 0; const bf16_t* Wt = (const bf16_t*)(P_W + W_IN) + (size_t)f * NFF2 * D;
                gg = pg8::Gemm{sp == 0 ? P_U : P_U2, Wt, 0, 0, D, D, D}; gM = sp == 0 ? MROWS : Mpost; gN = NFF2; ep = pg8::EpiAny{1, P_ACT, DFF, nullptr, nullptr}; do_gemm = true; } break;
            case 1: case 15: {
                const int f = sp == 1 ? 1 : 0; const bf16_t* Wt = (const bf16_t*)(P_W + W_OUT) + (size_t)f * D * DFF;
                gg = pg8::Gemm{P_ACT, Wt, 0, 0, DFF, DFF, DFF}; gM = sp == 1 ? MROWS : Mpost; gN = D; ep = pg8::EpiAny{0, P_Y, D, nullptr, nullptr}; do_gemm = true; } break;
            case 2: { const bool first = layer == 0;
                LnP p{first ? a.in[0] : a.out, first ? a.in[2] : P_HC, a.out, P_HC, P_Y, D, MODL, 2, 0.5f, LNG, LNB, MODL, 3, P_U, MROWS, 1}; phase_ln(p, bid, G); } break;
            case 3: { const bf16_t* Wt = (const bf16_t*)(P_W + W_MIX);
                gg = pg8::Gemm{P_U, Wt, 0, 0, D, D, D}; gM = MROWS; gN = NAC; ep = pg8::EpiAny{0, P_PAC, NAC, nullptr, nullptr}; do_gemm = true; } break;
            case 4: {
                bf16_t* QB = (bf16_t*)(P_BIG + B_QB); float* DB = (float*)(P_BIG + B_DB);
                hgrn_prepass(P_PAC, QB, DB, a.in[11], layer, bid, G);
                {
                    __syncthreads();
                    if (threadIdx.x < 64) {
                        __builtin_amdgcn_fence(__ATOMIC_RELEASE, "agent"); asm volatile("s_waitcnt vmcnt(0) lgkmcnt(0)" ::: "memory");
                        if (threadIdx.x == 0) { unsigned* bar2 = (unsigned*)(a.ws + WS_MISC + MI_BAR) + 16;
                            __hip_atomic_fetch_add(bar2, 1u, __ATOMIC_RELAXED, __HIP_MEMORY_SCOPE_AGENT);
                            const unsigned target = (unsigned)(layer + 1) * (unsigned)G;
                            while (__hip_atomic_load(bar2, __ATOMIC_RELAXED, __HIP_MEMORY_SCOPE_AGENT) < target) __builtin_amdgcn_s_sleep(1); }
                        __builtin_amdgcn_fence(__ATOMIC_ACQUIRE, "agent"); asm volatile("s_waitcnt vmcnt(0) lgkmcnt(0)" ::: "memory"); }
                    __syncthreads();
                }
                const int nh = G >= 256 ? 128 : G / 2;
                if (bid < nh) { for (int it = bid; it < 128; it += nh) hgrn_scan_item(L, it, P_PAC, QB, DB, P_YA, P_OB); }
                else { const int nitem = layer == 0 ? 1040 : 1024; for (int it = bid - nh; it < nitem; it += G - nh) attn_item(L, it, P_PAC, P_TAB, a.in[23] + layer * 8, P_YC); }
            } break;
            case 5: phase_readout(P_PAC, P_YA, P_OB, a.in[12] + layer * 512, Mpost, bid, G); break;
            case 6: { const bf16_t* Wt = (const bf16_t*)(P_W + W_MIX) + (size_t)NAC * D;
                gg = pg8::Gemm{P_U, Wt, 0, 0, D, D, D}; gM = Mpost; gN = NPB; ep = pg8::EpiAny{0, P_PB, NPB, nullptr, nullptr}; do_gemm = true; } break;
            case 7: {
                for (int it = bid; it < 256; it += G) filt_item(L, it, SEQ, true, HY_W1, HY_B1, HY_F1, HY_W2, HY_B2, HY_F2, HY_W3, P_L1, P_FR, nullptr);
                if (layer == 0) { for (int it = bid; it < 4; it += G) filt_item(L, it, LCTX, false, HY_W1, HY_B1, HY_F1, HY_W2, HY_B2, HY_F2, HY_W3, P_L1C, nullptr, P_FC);
                    hyctx_shortconv(P_PB, HY_CW, HY_CB, P_SC, bid, G); }
                hyprep_phase(L, P_PB, HY_CW, HY_CB, P_T, bid, G);
            } break;
            case 8: {
                for (int ch = bid; ch < 512; ch += G) hyconv_item(L, ch, P_T, P_FR, P_L1, HY_BIAS);
                if (layer == 0) hyctx_conv(0, P_SC, P_SC, NPB, P_FC, P_L1C, HY_BIAS, P_Z1C, P_YB, bid, G);
            } break;
            case 9: {
                hytrb_phase(L, P_T + (size_t)2 * 512 * 2 * SEQ, P_YB, bid, G);
                if (layer == 0) hyctx_conv(1, P_SC, P_Z1C, 512, P_FC, P_L1C, HY_BIAS, P_Z1C, P_YB, bid, G);
            } break;
            case 10: { const bf16_t* Wt = (const bf16_t*)(P_W + W_MIX) + (size_t)(NAC + NPB) * D;
                gg = pg8::Gemm{P_U, Wt, 0, 0, D, D, D}; gM = Mpost; gN = NPG; ep = pg8::EpiAny{0, P_PG, NPG, nullptr, nullptr}; do_gemm = true; } break;
            case 11: { const bf16_t* Wt = (const bf16_t*)(P_W + W_BR);
                gg = pg8::Gemm{P_YA, Wt, YSZ, (size_t)D * 512 * 2, 512, 512, 512}; gM = Mpost; gN = D; gbr = 3;
                ep = pg8::EpiAny{2, P_PG, NPG, P_PG, (float*)(P_BIG + B_SCR) + (size_t)bid * 65536}; do_gemm = true; } break;
            case 12: { const bf16_t* Wt = (const bf16_t*)(P_W + W_O);
                gg = pg8::Gemm{P_PG, Wt, 0, 0, NPG, D, D}; gM = Mpost; gN = D; ep = pg8::EpiAny{0, P_Y, D, nullptr, nullptr}; do_gemm = true; } break;
            case 13: { LnP p{a.out, P_HC, a.out, P_HC, P_Y, D, MODL, 5, 1.0f, LNG + D, LNB + D, MODL, 6, P_U2, Mpost, 1}; phase_ln(p, bid, G); } break;
            case 16: {
                LnP p{a.out, P_HC, a.out, P_HC, P_Y, D, MODL, 8, 0.5f, LNG + 2 * D, LNB + 2 * D, P_MODS + (size_t)(layer + 1) * 3 * NMOD, 0, P_U, Mpost, layer == 0 ? 1 : 2}; phase_ln(p, bid, G);
                if (layer == 0) phase_wconv(L, a, 1, bid, G);
            } break;
            }
        }
        if (do_gemm) { pg8::Order S; S.init(gM, gN, G, bid, gbr); pg8::gemm_phase(L, gg, S, ep); }
        if (ph + 1 < a.ph_hi) {
            __syncthreads();
            if (threadIdx.x < 64) {
                __builtin_amdgcn_fence(__ATOMIC_RELEASE, "agent"); asm volatile("s_waitcnt vmcnt(0) lgkmcnt(0)" ::: "memory");
                if (threadIdx.x == 0) {
                    unsigned* bar = (unsigned*)(a.ws + WS_MISC + MI_BAR);
                    const unsigned k = (unsigned)(ph - a.ph_lo + 1);
                    if ((G & 7) == 0) {
                        unsigned* grp = (unsigned*)(a.ws + WS_MISC + MI_BAR2) + (bid & 7) * 16;
                        const unsigned old = __hip_atomic_fetch_add(grp, 1u, __ATOMIC_RELAXED, __HIP_MEMORY_SCOPE_AGENT);
                        if (old + 1u == k * (unsigned)(G >> 3)) __hip_atomic_fetch_add(bar, 1u, __ATOMIC_RELAXED, __HIP_MEMORY_SCOPE_AGENT);
                        while (__hip_atomic_load(bar, __ATOMIC_RELAXED, __HIP_MEMORY_SCOPE_AGENT) < 8u * k) __builtin_amdgcn_s_sleep(1);
                    } else {
                        __hip_atomic_fetch_add(bar, 1u, __ATOMIC_RELAXED, __HIP_MEMORY_SCOPE_AGENT);
                        while (__hip_atomic_load(bar, __ATOMIC_RELAXED, __HIP_MEMORY_SCOPE_AGENT) < k * (unsigned)G) __builtin_amdgcn_s_sleep(1);
                    }
                }
                __builtin_amdgcn_fence(__ATOMIC_ACQUIRE, "agent"); asm volatile("s_waitcnt vmcnt(0) lgkmcnt(0)" ::: "memory");
            }
            __syncthreads();
        }
    }
}

extern "C" void kernel_launch(void* const* d_in, const int* in_sizes, int n_in, void* d_out, int out_size, void* d_ws, size_t ws_size, hipStream_t stream) {
    static int grid = 0;
    if (grid == 0) {
        if (n_in != 26 || ws_size < WS_TOTAL) { fprintf(stderr, "kernel_launch: needs 26 inputs and >= %zu bytes of workspace (got %d, %zu)\n", (size_t)WS_TOTAL, n_in, ws_size); grid = -1; return; }
        int dev = 0, cus = 0, per_cu = 0;
        (void)hipGetDevice(&dev);
        (void)hipDeviceGetAttribute(&cus, hipDeviceAttributeMultiprocessorCount, dev);
        (void)hipFuncSetAttribute((const void*)mega, hipFuncAttributeMaxDynamicSharedMemorySize, LDS_BYTES);
        (void)hipOccupancyMaxActiveBlocksPerMultiprocessor(&per_cu, (const void*)mega, 512, LDS_BYTES);
        if (per_cu < 1) per_cu = 1;
        grid = cus * per_cu;
        if (grid > 256) grid = 256;
    }
    if (grid < 0) return;
    Args a{};
    for (int i = 0; i < 26; ++i) a.in[i] = (const float*)d_in[i];
    a.out = (float*)d_out; a.ws = (unsigned char*)d_ws;
#ifndef ONE_LAUNCH
#define ONE_LAUNCH 1
#endif
    if (ONE_LAUNCH) {
        a.ph_lo = 0; a.ph_hi = NPHASE;
        void* args[] = {&a};
        (void)hipMemsetAsync((unsigned char*)d_ws + WS_MISC + MI_BAR, 0, 768, stream);
        hipError_t e = hipLaunchCooperativeKernel((const void*)mega, dim3(grid), dim3(512), args, LDS_BYTES, stream);
        if (e != hipSuccess) fprintf(stderr, "cooperative launch failed: %s (grid %d)\n", hipGetErrorString(e), grid);
    } else {
        for (int ph = 0; ph < NPHASE; ++ph) { a.ph_lo = ph; a.ph_hi = ph + 1; hipLaunchKernelGGL(mega, dim3(grid), dim3(512), LDS_BYTES, stream, a); }
    }
}
```

```cpp
#include <hip/hip_runtime.h>
#include <hip/hip_cooperative_groups.h>
#include <cstdio>
namespace cg = cooperative_groups;
#define LAS __attribute__((address_space(3)))
typedef unsigned short bf16_t;
typedef short bf16x8 __attribute__((ext_vector_type(8)));
typedef float f32x4 __attribute__((ext_vector_type(4)));
typedef float f32x2 __attribute__((ext_vector_type(2)));
typedef float f32x16 __attribute__((ext_vector_type(16)));
typedef unsigned u32x4 __attribute__((ext_vector_type(4)));
typedef unsigned u32x2 __attribute__((ext_vector_type(2)));

constexpr int D = 1024, SEQ = 16384, NLAT = 32768, LCTX = 256, NCTX = 512, MROWS = 33280;
constexpr int DFF = 2816, NFF2 = 5632;
constexpr int NAC = 3328, NPB = 1536, NPG = 3072, NMIX = 7936;
constexpr int NMOD = 9216;
constexpr int FRLEN = 2 * SEQ + 128, FRC = SEQ + 63;
constexpr int ZP = ((SEQ + 2048) / 32) * 40;
constexpr int LDS_BYTES = 2 * ZP * 2 + FRLEN * 2 + 256;
constexpr float DN_ALPHA = 1.41421356237f;

constexpr size_t WS_U = 0;
constexpr size_t WS_HC = WS_U + (size_t)MROWS * D * 2;
constexpr size_t WS_W = WS_HC + (size_t)NCTX * D * 4;
constexpr size_t W_IN = 0, W_OUT = W_IN + (size_t)2 * NFF2 * D * 2, W_MIX = W_OUT + (size_t)2 * D * DFF * 2, W_BR = W_MIX + (size_t)NMIX * D * 2, W_O = W_BR + (size_t)3 * D * 512 * 2, W_END = W_O + (size_t)D * D * 2;
constexpr size_t WS_MISC = WS_W + W_END;
constexpr size_t MI_MODS = 0, MI_TAB = MI_MODS + (size_t)2 * 3 * NMOD * 4, MI_L1 = MI_TAB + 256 * 16 * 2 * 4, MI_L1C = MI_L1 + 2 * 1024 * 4, MI_FC = MI_L1C + 1024 * 4,
                 MI_SC = MI_FC + (size_t)256 * 2048 * 4, MI_Z1C = MI_SC + (size_t)NCTX * 1536 * 4, MI_BAR = MI_Z1C + (size_t)NCTX * 512 * 4, MI_BAR2 = MI_BAR + 256, MI_END = MI_BAR2 + 512;
constexpr size_t WS_BIG = WS_MISC + 8388608;
static_assert(MI_END <= 8388608, "misc");
constexpr size_t WS_TOTAL = 536870912;
constexpr size_t BIG_SIZE = WS_TOTAL - WS_BIG;
constexpr size_t YSZ = (size_t)MROWS * 512 * 2;
constexpr size_t B_PAC = 0, B_OB = (size_t)MROWS * NAC * 2, B_ACT = 0, B_PG = 0, B_Y = (size_t)MROWS * NPG * 2, B_PB = 0, B_T = (size_t)MROWS * NPB * 2,
                 B_F = B_T + (size_t)3 * 512 * 2 * SEQ * 2, B_SCR = B_Y, B_QB = B_OB + YSZ, B_DB = B_QB + YSZ, B_YA = BIG_SIZE - 3 * YSZ, B_YB = B_YA + YSZ, B_YC = B_YB + YSZ;
static_assert(B_DB + (size_t)2 * (MROWS / 16) * 512 * 4 <= B_YA && B_OB + YSZ <= B_YA && B_F + (size_t)1024 * FRLEN * 2 <= B_YA && B_Y + (size_t)MROWS * D * 2 <= B_YA && B_SCR + (size_t)256 * 65536 * 4 <= B_YA && (size_t)MROWS * DFF * 2 <= B_Y, "big region");

struct Args { const float* in[26]; float* out; unsigned char* ws; int ph_lo, ph_hi; };

__device__ __forceinline__ float bf2f(unsigned b) { return __uint_as_float(b << 16); }
__device__ __forceinline__ float bflo(unsigned w) { return __uint_as_float(w << 16); }
__device__ __forceinline__ float bfhi(unsigned w) { return __uint_as_float(w & 0xffff0000u); }
typedef __bf16 bf16x2_hw __attribute__((ext_vector_type(2)));
__device__ __forceinline__ unsigned cvt_pk_bf16(float lo, float hi) { const f32x2 v = (f32x2){lo, hi}; return __builtin_bit_cast(unsigned, __builtin_convertvector(v, bf16x2_hw)); }
__device__ __forceinline__ unsigned cvt_pk_bf16_sw(float lo, float hi) { return cvt_pk_bf16(lo, hi); }
__device__ __forceinline__ bf16_t f2bf(float f) { return (bf16_t)(cvt_pk_bf16(f, 0.f) & 0xffffu); }
__device__ __forceinline__ int otid() { int t = threadIdx.x; asm volatile("" : "+v"(t)); return t; }
__device__ __forceinline__ f32x4 zero4() { float z; asm volatile("v_mov_b32 %0, 0" : "=v"(z)); return (f32x4){z, z, z, z}; }
__device__ __forceinline__ float sigm(float x) { return __builtin_amdgcn_rcpf(1.f + __builtin_amdgcn_exp2f(-1.44269504089f * x)); }
__device__ __forceinline__ float silu(float x) { return x * __builtin_amdgcn_rcpf(1.f + __builtin_amdgcn_exp2f(-1.44269504089f * x)); }
__device__ __forceinline__ void unpack8(u32x4 w, float* f) { f[0] = bflo(w.x); f[1] = bfhi(w.x); f[2] = bflo(w.y); f[3] = bfhi(w.y); f[4] = bflo(w.z); f[5] = bfhi(w.z); f[6] = bflo(w.w); f[7] = bfhi(w.w); }
__device__ __forceinline__ u32x4 pack8(const float* f) { u32x4 w; w.x = cvt_pk_bf16(f[0], f[1]); w.y = cvt_pk_bf16(f[2], f[3]); w.z = cvt_pk_bf16(f[4], f[5]); w.w = cvt_pk_bf16(f[6], f[7]); return w; }

namespace pg8 {
constexpr int BM = 256, BK = 64, HALF = 128, HTB = HALF * BK * 2, STAGE_BYTES = 8 * HTB, NXCD = 8, WGM = 8;
__device__ __forceinline__ int lds_byte(int r, int c) { const int st = (r >> 4) * 2 + (c >> 5), rr = r & 15, cc = c & 31, ob = rr * 64 + cc * 2; return st * 1024 + (ob ^ (((ob >> 9) & 1) << 5)); }
__device__ __forceinline__ void stage_rc(int b, int& R, int& C) { const int st = b / 1024, sb = b % 1024, swz = sb ^ (((sb >> 9) & 1) << 5); R = (st >> 1) * 16 + swz / 64; C = (st & 1) * 32 + (swz % 64) / 2; }
__device__ __forceinline__ int perm32(int rho) { const int n = rho >> 4, i = rho & 15; return 8 * (i >> 2) + 4 * n + (i & 3); }
struct Unit { int pm, pn, br; };
struct Gemm { const bf16_t* A; const bf16_t* Bt; size_t sA, sB; int lda, ldb, K;
    __device__ __forceinline__ const char* a(int br) const { return (const char*)A + (size_t)br * sA; }
    __device__ __forceinline__ const char* b(int br) const { return (const char*)Bt + (size_t)br * sB; } };
struct Order {
    int nM, nN, nwg, G, c, nbr;
    __device__ void init(int M, int N, int G_, int c_, int nbr_) { nM = M / BM; nN = N / BM; nwg = nM * nN; G = G_; c = c_; nbr = nbr_; }
    __device__ bool next(int i, Unit& u) const {
        const int ti = i / nbr; u.br = i - ti * nbr;
        const long L = (long)ti * G + c; if (L >= nwg) return false;
        int wgid = (int)L; { const int q = nwg / NXCD, r = nwg % NXCD, xcd = wgid % NXCD, off = wgid / NXCD; wgid = (xcd < r ? xcd * (q + 1) : r * (q + 1) + (xcd - r) * q) + off; }
        const int nig = WGM * nN, gid = wgid / nig, fm = gid * WGM, gsz = (nM - fm) < WGM ? (nM - fm) : WGM;
        u.pm = fm + ((wgid % nig) % gsz); u.pn = (wgid % nig) / gsz; return true;
    }
};
struct EpiAny {
    int kind; bf16_t* O; int ldc; const bf16_t* PG; float* scr;
    __device__ __forceinline__ void operator()(const f32x4 (&acc)[2][2][4][2], const Unit& u, int wr, int wc, int fr, int fq) const {
        asm volatile("" : "+v"(fr), "+v"(fq));
        if (kind == 0) {
            const int row0 = u.pm * BM + wr * 64 + fr, col0 = u.pn * BM + wc * 32 + 8 * fq;
#pragma unroll
            for (int ai = 0; ai < 2; ++ai)
#pragma unroll
                for (int m = 0; m < 4; ++m) { bf16_t* rowp = O + (size_t)(row0 + ai * HALF + m * 16) * ldc + col0;
#pragma unroll
                    for (int bj = 0; bj < 2; ++bj) { const f32x4 v0 = acc[ai][bj][m][0], v1 = acc[ai][bj][m][1];
                        u32x4 w; w.x = cvt_pk_bf16(v0[0], v0[1]); w.y = cvt_pk_bf16(v0[2], v0[3]); w.z = cvt_pk_bf16(v1[0], v1[1]); w.w = cvt_pk_bf16(v1[2], v1[3]);
                        *(u32x4*)(rowp + bj * HALF) = w; } }
        } else if (kind == 1) {
            const int row0 = u.pm * BM + wr * 64 + fr, col0 = u.pn * HALF + wc * 32 + 8 * fq;
#pragma unroll
            for (int ai = 0; ai < 2; ++ai)
#pragma unroll
                for (int m = 0; m < 4; ++m) { bf16_t* rowp = O + (size_t)(row0 + ai * HALF + m * 16) * ldc + col0;
                    const f32x4 a0 = acc[ai][0][m][0], a1 = acc[ai][0][m][1], b0 = acc[ai][1][m][0], b1 = acc[ai][1][m][1];
                    u32x4 w; w.x = cvt_pk_bf16(silu(a0[0]) * b0[0], silu(a0[1]) * b0[1]); w.y = cvt_pk_bf16(silu(a0[2]) * b0[2], silu(a0[3]) * b0[3]);
                    w.z = cvt_pk_bf16(silu(a1[0]) * b1[0], silu(a1[1]) * b1[1]); w.w = cvt_pk_bf16(silu(a1[2]) * b1[2], silu(a1[3]) * b1[3]);
                    *(u32x4*)rowp = w; }
        } else {
            const int rl0 = wr * 64 + fr, cl0 = wc * 32 + 8 * fq;
            const bf16_t* gbase = PG + (size_t)u.pm * BM * ldc + u.pn * BM + u.br * 1024; bf16_t* obase = O + (size_t)u.pm * BM * ldc + u.pn * BM;
#define MERGE_LOOP(BODY) _Pragma("unroll") for (int ai = 0; ai < 2; ++ai) _Pragma("unroll") for (int m = 0; m < 4; ++m) { _Pragma("unroll") for (int bj = 0; bj < 2; ++bj) _Pragma("unroll") for (int n = 0; n < 2; ++n) { \
                const unsigned rl = rl0 + ai * HALF + m * 16, cl = cl0 + bj * HALF + 4 * n; const unsigned go = rl * (unsigned)ldc + cl, so = rl * 256u + cl; \
                const u32x2 gw = *(const u32x2*)(gbase + go); f32x4 v = acc[ai][bj][m][n]; \
                v[0] *= sigm(bflo(gw.x)); v[1] *= sigm(bfhi(gw.x)); v[2] *= sigm(bflo(gw.y)); v[3] *= sigm(bfhi(gw.y)); BODY } __builtin_amdgcn_sched_barrier(0); }
            if (u.br == 0) { MERGE_LOOP({ *(f32x4*)(scr + so) = v; }) }
            else if (u.br == 1) { MERGE_LOOP({ v += *(const f32x4*)(scr + so); *(f32x4*)(scr + so) = v; }) }
            else { MERGE_LOOP({ v += *(const f32x4*)(scr + so); u32x2 w; w.x = cvt_pk_bf16(v[0], v[1]); w.y = cvt_pk_bf16(v[2], v[3]); *(u32x2*)(obase + go) = w; }) }
#undef MERGE_LOOP
        }
    }
};

template <class Epi>
__device__ __forceinline__ void gemm_phase(LAS unsigned char* lds, const Gemm g, const Order& S, const Epi& E) {
    const int tid = otid(), wid = __builtin_amdgcn_readfirstlane(tid >> 6), lane = tid & 63, wr = wid >> 2, wc = wid & 3, fr = lane & 15, fq = lane >> 4;
    const int K = g.K, nt = K / BK;
    unsigned voffA[2], voffB[2];
#pragma unroll
    for (int i = 0; i < 2; ++i) { int R, C; stage_rc(tid * 16 + i * 8192, R, C); const int Rb = (R & ~31) + perm32(R & 31);
        voffA[i] = (unsigned)(R * g.lda + C) * 2u; voffB[i] = (unsigned)(Rb * g.ldb + C) * 2u; }
    const size_t kstep = (size_t)(BK * 2);
    const size_t hstepA = (size_t)HALF * g.lda * 2, hstepB = (size_t)HALF * g.ldb * 2;
    const size_t tstepA = 2 * hstepA, tstepB = 2 * hstepB;
    const unsigned ldsw = (unsigned)wid * 1024u;
    const int aoff = lds_byte(wr * 64 + fr, fq * 8), boff = lds_byte(wc * 32 + fr, fq * 8);
#define PG8_SA(b, h) (((b) * 2 + (h)) * HTB)
#define PG8_SB(b, h) ((4 + (b) * 2 + (h)) * HTB)
#define PG8_STAGE(bufoff, gbase, voff) do { _Pragma("unroll") for (int _i = 0; _i < 2; ++_i) \
        __builtin_amdgcn_global_load_lds((const unsigned*)((const char*)(gbase) + (voff)[_i]), (LAS unsigned*)(lds + (bufoff) + ldsw + _i * 8192), 16, 0, 0); } while (0)
#define PG8_LDA(dst, b, h) do { _Pragma("unroll") for (int m = 0; m < 4; ++m) _Pragma("unroll") for (int k = 0; k < 2; ++k) dst[m][k] = *(const LAS bf16x8*)(lds + PG8_SA(b, h) + aoff + m * 2048 + k * 1024); } while (0)
#define PG8_LDB(dst, b, h) do { _Pragma("unroll") for (int n = 0; n < 2; ++n) _Pragma("unroll") for (int k = 0; k < 2; ++k) dst[n][k] = *(const LAS bf16x8*)(lds + PG8_SB(b, h) + boff + n * 2048 + k * 1024); } while (0)
#define PG8_MMA(ai, bj, At, Bt) do { __builtin_amdgcn_s_setprio(1); _Pragma("unroll") for (int m = 0; m < 4; ++m) _Pragma("unroll") for (int n = 0; n < 2; ++n) _Pragma("unroll") for (int k = 0; k < 2; ++k) \
        acc[ai][bj][m][n] = __builtin_amdgcn_mfma_f32_16x16x32_bf16(Bt[n][k], At[m][k], acc[ai][bj][m][n], 0, 0, 0); __builtin_amdgcn_s_setprio(0); } while (0)
#define PG8_WAIT_V(n) asm volatile("s_waitcnt vmcnt(" #n ")" ::: "memory")
#define PG8_WAIT_L(n) asm volatile("s_waitcnt lgkmcnt(" #n ")" ::: "memory")
#define PG8_BAR __builtin_amdgcn_s_barrier()
#define PG8_SCHED __builtin_amdgcn_sched_barrier(0)
    Unit cur, nxt; int ui = 0;
    if (!S.next(0, cur)) return;
    f32x4 acc[2][2][4][2];
#pragma unroll
    for (int a = 0; a < 2; ++a)
#pragma unroll
        for (int b = 0; b < 2; ++b)
#pragma unroll
            for (int m = 0; m < 4; ++m)
#pragma unroll
                for (int n = 0; n < 2; ++n) acc[a][b][m][n] = (f32x4){0.f, 0.f, 0.f, 0.f};
    bf16x8 At[4][2], B0[2][2], B1[2][2];
    const char* cA = g.a(cur.br) + (size_t)cur.pm * tstepA; const char* cB = g.b(cur.br) + (size_t)cur.pn * tstepB;
    PG8_STAGE(PG8_SB(0, 0), cB, voffB); PG8_STAGE(PG8_SA(0, 0), cA, voffA); PG8_STAGE(PG8_SB(0, 1), cB + hstepB, voffB); PG8_STAGE(PG8_SA(0, 1), cA + hstepA, voffA);
    if (wr == 1) PG8_BAR;
    PG8_WAIT_V(4); PG8_BAR;
    PG8_STAGE(PG8_SB(1, 0), cB + kstep, voffB); PG8_STAGE(PG8_SA(1, 0), cA + kstep, voffA); PG8_STAGE(PG8_SB(1, 1), cB + hstepB + kstep, voffB);
    PG8_WAIT_V(6); PG8_BAR;
    for (;;) {
        const bool has_next = S.next(ui + 1, nxt);
        const char* nA = has_next ? g.a(nxt.br) + (size_t)nxt.pm * tstepA : cA; const char* nB = has_next ? g.b(nxt.br) + (size_t)nxt.pn * tstepB : cB;
        for (int t = 0; t < nt; t += 2) {
            const bool last = (t == nt - 2);
            const char* a1 = cA + (size_t)(t + 1) * kstep;
            const char* a2 = last ? nA : cA + (size_t)(t + 2) * kstep; const char* b2 = last ? nB : cB + (size_t)(t + 2) * kstep;
            const char* a3 = a2 + kstep; const char* b3 = b2 + kstep;
            PG8_LDB(B0, 0, 0); PG8_SCHED; PG8_LDA(At, 0, 0); PG8_STAGE(PG8_SA(1, 1), a1 + hstepA, voffA);
            PG8_WAIT_L(8); PG8_BAR; PG8_WAIT_L(0); PG8_MMA(0, 0, At, B0); PG8_BAR; PG8_SCHED;
            PG8_LDB(B1, 0, 1); PG8_STAGE(PG8_SB(0, 0), b2, voffB);
            PG8_BAR; PG8_WAIT_L(0); PG8_MMA(0, 1, At, B1); PG8_BAR;
            PG8_LDA(At, 0, 1); PG8_STAGE(PG8_SA(0, 0), a2, voffA);
            PG8_BAR; PG8_WAIT_L(0); PG8_MMA(1, 0, At, B0); PG8_BAR; PG8_SCHED;
            PG8_STAGE(PG8_SB(0, 1), b2 + hstepB, voffB);
            PG8_WAIT_V(6); PG8_BAR; PG8_MMA(1, 1, At, B1); PG8_BAR;
            PG8_LDB(B0, 1, 0); PG8_SCHED; PG8_LDA(At, 1, 0); PG8_STAGE(PG8_SA(0, 1), a2 + hstepA, voffA);
            PG8_WAIT_L(8); PG8_BAR; PG8_WAIT_L(0); PG8_MMA(0, 0, At, B0); PG8_BAR; PG8_SCHED;
            PG8_LDB(B1, 1, 1); PG8_STAGE(PG8_SB(1, 0), b3, voffB);
            PG8_BAR; PG8_WAIT_L(0); PG8_MMA(0, 1, At, B1); PG8_BAR;
            PG8_LDA(At, 1, 1); PG8_STAGE(PG8_SA(1, 0), a3, voffA);
            PG8_BAR; PG8_WAIT_L(0); PG8_MMA(1, 0, At, B0); PG8_BAR; PG8_SCHED;
            PG8_STAGE(PG8_SB(1, 1), b3 + hstepB, voffB);
            PG8_WAIT_V(6); PG8_BAR; PG8_MMA(1, 1, At, B1); PG8_BAR;
        }
        E(acc, cur, wr, wc, fr, fq);
        if (!has_next) break;
#pragma unroll
        for (int a = 0; a < 2; ++a)
#pragma unroll
            for (int b = 0; b < 2; ++b)
#pragma unroll
                for (int m = 0; m < 4; ++m)
#pragma unroll
                    for (int n = 0; n < 2; ++n) acc[a][b][m][n] = (f32x4){0.f, 0.f, 0.f, 0.f};
        cur = nxt; cA = nA; cB = nB; ++ui;
    }
    PG8_WAIT_V(0);
    if (wr == 0) PG8_BAR;
    PG8_BAR;
#undef PG8_SA
#undef PG8_SB
#undef PG8_STAGE
#undef PG8_LDA
#undef PG8_LDB
#undef PG8_MMA
#undef PG8_WAIT_V
#undef PG8_WAIT_L
#undef PG8_BAR
#undef PG8_SCHED
}
}

struct WTile { const float* s; int lds_; bf16_t* d; int ldd; };
__device__ __forceinline__ WTile wconv_decode(const Args& a, int layer, int it) {
    unsigned char* W = a.ws + WS_W;
    const float* w_in = a.in[8] + (size_t)layer * 2 * D * NFF2; const float* w_out = a.in[9] + (size_t)layer * 2 * DFF * D;
    const float* w_mix = a.in[10] + (size_t)layer * D * NMIX; const float* w_br = a.in[24] + (size_t)layer * 3 * 512 * D; const float* w_o = a.in[25] + (size_t)layer * D * D;
    WTile t;
    if (it < 2816) { const int f = it / 1408, r = it % 1408, kt = r / 88, ntile = r % 88, n0 = ntile * 64, tq = n0 >> 8, rr = n0 & 255;
        const int c0 = rr < 128 ? 128 * tq + rr : DFF + 128 * tq + (rr - 128);
        t.s = w_in + (size_t)f * D * NFF2 + (size_t)kt * 64 * NFF2 + c0; t.lds_ = NFF2; t.d = (bf16_t*)(W + W_IN) + (size_t)(1 - f) * NFF2 * D + (size_t)n0 * D + kt * 64; t.ldd = D; }
    else if (it < 4224) { const int j = it - 2816, f = j / 704, r = j % 704, kt = r / 16, ntile = r % 16;
        t.s = w_out + (size_t)f * DFF * D + (size_t)kt * 64 * D + ntile * 64; t.lds_ = D; t.d = (bf16_t*)(W + W_OUT) + (size_t)(1 - f) * D * DFF + (size_t)ntile * 64 * DFF + kt * 64; t.ldd = DFF; }
    else if (it < 6208) { const int j = it - 4224, kt = j / 124, ntile = j % 124, n0 = ntile * 64;
        const int c0 = n0 < 2560 ? n0 : (n0 < 3328 ? 4096 + (n0 - 2560) : (n0 < 4864 ? 2560 + (n0 - 3328) : n0));
        t.s = w_mix + (size_t)kt * 64 * NMIX + c0; t.lds_ = NMIX; t.d = (bf16_t*)(W + W_MIX) + (size_t)n0 * D + kt * 64; t.ldd = D; }
    else if (it < 6592) { const int j = it - 6208, br = j / 128, r = j % 128, kt = r / 16, ntile = r % 16;
        t.s = w_br + (size_t)br * 512 * D + (size_t)kt * 64 * D + ntile * 64; t.lds_ = D; t.d = (bf16_t*)(W + W_BR) + (size_t)br * D * 512 + (size_t)ntile * 64 * 512 + kt * 64; t.ldd = 512; }
    else { const int j = it - 6592, kt = j / 16, ntile = j % 16;
        t.s = w_o + (size_t)kt * 64 * D + ntile * 64; t.lds_ = D; t.d = (bf16_t*)(W + W_O) + (size_t)ntile * 64 * D + kt * 64; t.ldd = D; }
    return t;
}
__device__ __forceinline__ void phase_wconv(LAS unsigned char* L, const Args& a, int layer, int bid, int G) {
    LAS float* tl = (LAS float*)L;
    const int tid = otid(); const int r0 = tid >> 4, c4 = (tid & 15) * 4;
    int it = bid;
    if (it >= 6848) return;
    WTile cur = wconv_decode(a, layer, it);
    f32x4 v0 = *(const f32x4*)(cur.s + (size_t)r0 * cur.lds_ + c4), v1 = *(const f32x4*)(cur.s + (size_t)(r0 + 32) * cur.lds_ + c4);
    for (; it < 6848; it += G) {
        __syncthreads();
        tl[r0 * 65 + c4] = v0[0]; tl[r0 * 65 + c4 + 1] = v0[1]; tl[r0 * 65 + c4 + 2] = v0[2]; tl[r0 * 65 + c4 + 3] = v0[3];
        tl[(r0 + 32) * 65 + c4] = v1[0]; tl[(r0 + 32) * 65 + c4 + 1] = v1[1]; tl[(r0 + 32) * 65 + c4 + 2] = v1[2]; tl[(r0 + 32) * 65 + c4 + 3] = v1[3];
        __syncthreads();
        WTile nxt = cur;
        if (it + G < 6848) { nxt = wconv_decode(a, layer, it + G); v0 = *(const f32x4*)(nxt.s + (size_t)r0 * nxt.lds_ + c4); v1 = *(const f32x4*)(nxt.s + (size_t)(r0 + 32) * nxt.lds_ + c4); }
        { const int n = tid >> 3, kc = (tid & 7) * 8; float f[8];
#pragma unroll
          for (int j = 0; j < 8; ++j) f[j] = tl[(kc + j) * 65 + n];
          *(u32x4*)(cur.d + (size_t)n * cur.ldd + kc) = pack8(f); }
        cur = nxt;
    }
    __syncthreads();
}

__device__ __forceinline__ void phase_mods(LAS unsigned char* L, const Args& a, int bid, int G) {
    LAS float* sc = (LAS float*)L;
    LAS float* red = sc + 3 * 1024;
    const int tid = otid();
    float* mods = (float*)(a.ws + WS_MISC + MI_MODS);
    for (int e = tid; e < 3 * 1024; e += 512) { const int v = e >> 10, k = e & 1023; const float x = v < 2 ? a.in[1][v * 1024 + k] : a.in[3][k]; sc[e] = silu(x); }
    __syncthreads();
    for (int it = bid; it < 288; it += G) {
        const int layer = it / 144, n = (it % 144) * 64 + (tid & 63), kq = tid >> 6;
        const float* w = a.in[4] + (size_t)layer * D * NMOD + n;
        float s0 = 0.f, s1 = 0.f, s2 = 0.f;
#pragma unroll 8
        for (int k = kq * 128; k < kq * 128 + 128; ++k) { const float wv = w[(size_t)k * NMOD]; s0 += sc[k] * wv; s1 += sc[1024 + k] * wv; s2 += sc[2048 + k] * wv; }
        red[(kq * 3 + 0) * 64 + (tid & 63)] = s0; red[(kq * 3 + 1) * 64 + (tid & 63)] = s1; red[(kq * 3 + 2) * 64 + (tid & 63)] = s2;
        __syncthreads();
        if (tid < 192) { const int v = tid >> 6, c = tid & 63; const int nn = (it % 144) * 64 + c; float s = 0.f;
#pragma unroll
            for (int q = 0; q < 8; ++q) s += red[(q * 3 + v) * 64 + c];
            mods[((size_t)layer * 3 + v) * NMOD + nn] = s + a.in[5][(size_t)layer * NMOD + nn]; }
        __syncthreads();
    }
    const int gt = bid * 512 + tid;
    if (gt < 4096) { const int pos = gt >> 4, f = gt & 15; const float inv = __builtin_amdgcn_exp2f(-(float)f * (13.287712379549449f / 16.0f)); const float ang = (float)pos * inv;
        float* tab = (float*)(a.ws + WS_MISC + MI_TAB); tab[gt * 2] = __cosf(ang); tab[gt * 2 + 1] = __sinf(ang); }
    if (gt < 3072) ((float*)(a.ws + WS_MISC + MI_L1))[gt] = 0.f;
}

struct LnP { const float* hs_lat; const float* hs_ctx; float* hd_lat; float* hd_ctx; const bf16_t* y; int ldy; const float* mods; int gi; float coef; const float* g; const float* b; const float* mods_u; int si; bf16_t* u; int rows; int mode; };
__device__ __forceinline__ void phase_ln(const LnP& p, int bid, int G) {
    const int tid_ = otid(); const int lane = tid_ & 63, wv = tid_ >> 6;
    const int nw = G * 8, wid = bid * 8 + wv;
    const int per = (MROWS + nw - 1) / nw;
    const int r0 = wid * per, r1 = min(p.rows, r0 + per);
    if (r0 >= r1) return;
    f32x4 t[4], tn[4]; u32x2 yw[4], ywn[4];
#define LN_LOAD(R, T_, Y_) { const int rr = (R); const float* hs = rr < NLAT ? p.hs_lat + (size_t)rr * D : p.hs_ctx + (size_t)(rr - NLAT) * D; \
        _Pragma("unroll") for (int i = 0; i < 4; ++i) { T_[i] = *(const f32x4*)(hs + 4 * lane + 256 * i); Y_[i] = p.mode != 0 ? *(const u32x2*)(p.y + (size_t)rr * p.ldy + 4 * lane + 256 * i) : *(const u32x2*)(hs + 4 * lane + 256 * i); } }
    LN_LOAD(r0, t, yw)
    for (int r = r0; r < r1; ++r) {
        if (r + 1 < r1) LN_LOAD(r + 1, tn, ywn)
        const int v = r < SEQ ? 0 : (r < NLAT ? 1 : 2);
        if (p.mode != 0) {
            const float* gate = p.mods + (size_t)v * NMOD + p.gi * 1024;
            float s = 0.f;
#pragma unroll
            for (int i = 0; i < 4; ++i) { const f32x4 gv = *(const f32x4*)(gate + 4 * lane + 256 * i);
                t[i][0] = DN_ALPHA * t[i][0] + p.coef * gv[0] * bflo(yw[i].x); t[i][1] = DN_ALPHA * t[i][1] + p.coef * gv[1] * bfhi(yw[i].x);
                t[i][2] = DN_ALPHA * t[i][2] + p.coef * gv[2] * bflo(yw[i].y); t[i][3] = DN_ALPHA * t[i][3] + p.coef * gv[3] * bfhi(yw[i].y);
                s += (t[i][0] + t[i][1]) + (t[i][2] + t[i][3]); }
#pragma unroll
            for (int o = 32; o >= 1; o >>= 1) s += __shfl_xor(s, o);
            const float mean = s * (1.0f / 1024.0f); float q = 0.f;
#pragma unroll
            for (int i = 0; i < 4; ++i) { const f32x4 d = t[i] - mean; q += (d[0] * d[0] + d[1] * d[1]) + (d[2] * d[2] + d[3] * d[3]); }
#pragma unroll
            for (int o = 32; o >= 1; o >>= 1) q += __shfl_xor(q, o);
            const float rstd = rsqrtf(q * (1.0f / 1024.0f) + 1e-5f);
            float* hd = r < NLAT ? p.hd_lat + (size_t)r * D : p.hd_ctx + (size_t)(r - NLAT) * D;
#pragma unroll
            for (int i = 0; i < 4; ++i) { const int c = 4 * lane + 256 * i; const f32x4 gv = *(const f32x4*)(p.g + c), bv = *(const f32x4*)(p.b + c);
                t[i] = (t[i] - mean) * rstd * gv + bv; *(f32x4*)(hd + c) = t[i]; }
        }
        if (p.mode != 2) {
            const float* sh = p.mods_u + (size_t)v * NMOD + p.si * 1024; const float* scl = sh + 1024;
#pragma unroll
            for (int i = 0; i < 4; ++i) { const int c = 4 * lane + 256 * i; const f32x4 sv = *(const f32x4*)(sh + c), cv = *(const f32x4*)(scl + c);
                const f32x4 o = t[i] * (1.0f + cv) + sv; u32x2 w; w.x = cvt_pk_bf16(o[0], o[1]); w.y = cvt_pk_bf16(o[2], o[3]);
                *(u32x2*)(p.u + (size_t)r * D + c) = w; }
        }
#pragma unroll
        for (int i = 0; i < 4; ++i) { t[i] = tn[i]; yw[i] = ywn[i]; }
    }
#undef LN_LOAD
}

__device__ __forceinline__ int hgrn_row(int s, int dir, int b) {
    if (s < LCTX) { const int c = dir ? (LCTX - 1 - s) : s; return NLAT + b * LCTX + c; }
    const int t = s - LCTX; const int pos = dir ? (SEQ - 1 - t) : t; return b * SEQ + pos;
}
typedef float f32x4v __attribute__((ext_vector_type(4)));
constexpr int NGRP = MROWS / 16;
__device__ __forceinline__ void hgrn_prepass(bf16_t* PAC, bf16_t* QB, float* DB, const float* lbsrc, int layer, int bid, int G) {
    const int col = otid();
    float lbf = 0.f, lbb = 0.f;
    if (layer == 1) { const float a0 = lbsrc[(0 * 2 + 0) * 512 + col], a1 = lbsrc[(1 * 2 + 0) * 512 + col], c0 = lbsrc[(0 * 2 + 1) * 512 + col], c1 = lbsrc[(1 * 2 + 1) * 512 + col];
        lbf = 1.f / (1.f + __expf(a0 - a1)); lbb = 1.f / (1.f + __expf(c0 - c1)); }
    for (int g = bid; g < NGRP; g += G) {
        bf16_t* base = PAC + (size_t)g * 16 * NAC;
        float q[16], ff[16], fb[16];
#pragma unroll
        for (int t = 0; t < 16; ++t) { const bf16_t* rp = base + (size_t)t * NAC; q[t] = bf2f(rp[col]); ff[t] = lbf + (1.f - lbf) * sigm(bf2f(rp[1536 + col])); fb[t] = lbb + (1.f - lbb) * sigm(bf2f(rp[2048 + col])); }
        float p = 1.f;
#pragma unroll
        for (int t = 0; t < 16; ++t) { p *= ff[t]; const float E = fmaxf(p, 1e-30f); bf16_t* rp = base + (size_t)t * NAC; rp[col] = f2bf(q[t] * E); rp[1536 + col] = f2bf((1.f - ff[t]) * __builtin_amdgcn_rcpf(E)); }
        DB[(size_t)g * 512 + col] = p;
        p = 1.f;
#pragma unroll
        for (int t = 15; t >= 0; --t) { p *= fb[t]; const float E = fmaxf(p, 1e-30f); bf16_t* rp = base + (size_t)t * NAC; QB[((size_t)g * 16 + t) * 512 + col] = f2bf(q[t] * E); rp[2048 + col] = f2bf((1.f - fb[t]) * __builtin_amdgcn_rcpf(E)); }
        DB[((size_t)NGRP + g) * 512 + col] = p;
    }
}
__device__ __forceinline__ void hgrn_scan_item(LAS unsigned char* L, int item, const bf16_t* PAC, const bf16_t* QB, const float* DB, bf16_t* OF, bf16_t* OB) {
    const int vs = item & 7, h = (item >> 3) & 3, b = (item >> 5) & 1, dir = item >> 6;
    const int tid = otid(), wave = tid >> 6, lane = tid & 63, l15 = lane & 15, g4 = lane >> 4;
    LAS bf16_t* Qs = (LAS bf16_t*)L;
    LAS bf16_t* Ks = Qs + 64 * 136;
    LAS bf16_t* KT = Ks + 64 * 136;
    LAS bf16_t* VT = KT + 4 * 128 * 40;
    LAS bf16_t* As = VT + 4 * 16 * 40;
    LAS float* Ds = (LAS float*)(As + 4 * 16 * 40);
    LAS float* O2s = Ds + 4 * 128;
    LAS float* Pp = O2s + 4 * 256;
    __syncthreads();
    for (int e2 = tid; e2 < (4 * 128 * 40 + 4 * 16 * 40 + 4 * 16 * 40) / 2; e2 += 512) ((LAS unsigned*)KT)[e2] = 0u;
    __syncthreads();
    f32x4v accS = (f32x4v){0.f, 0.f, 0.f, 0.f};
    bf16_t* Od = dir ? OB : OF;
    const bf16_t* Qsrc = dir ? QB : PAC; const int qld = dir ? 512 : NAC;
    const int kcol = (dir ? 2048 : 1536) + h * 128, qcol = h * 128, icol = 512 + h * 128 + vs * 16;
    const int st = tid >> 3, kc = (tid & 7) * 16;
    constexpr int NSTEP = LCTX + SEQ;
    u32x4 pq0A, pq1A, pk0A, pk1A, piA = (u32x4){0, 0, 0, 0}, pq0B, pq1B, pk0B, pk1B, piB = (u32x4){0, 0, 0, 0}, pq0C, pq1C, pk0C, pk1C, piC = (u32x4){0, 0, 0, 0}, pq0D, pq1D, pk0D, pk1D, piD = (u32x4){0, 0, 0, 0}; float pdA = 0.f, pdB = 0.f, pdC = 0.f, pdD = 0.f;
#define HG_LOAD(S0_, X) { const int row = hgrn_row((S0_) + st, dir, b); const bf16_t* qp = Qsrc + (size_t)row * qld + qcol + kc; const bf16_t* kp = PAC + (size_t)row * NAC + kcol + kc; \
      pq0##X = *(const u32x4*)qp; pq1##X = *(const u32x4*)(qp + 8); pk0##X = *(const u32x4*)kp; pk1##X = *(const u32x4*)(kp + 8); \
      if (tid < 128) { const int row2 = hgrn_row((S0_) + (tid >> 1), dir, b); pi##X = *(const u32x4*)(PAC + (size_t)row2 * NAC + icol + (tid & 1) * 8); } \
      { const int rowc = hgrn_row((S0_) + (tid >> 7) * 16, dir, b); pd##X = DB[((size_t)dir * NGRP + (rowc >> 4)) * 512 + h * 128 + (tid & 127)]; } }
    HG_LOAD(0, A) HG_LOAD(64, B) HG_LOAD(128, C) HG_LOAD(192, D)
    for (int s0 = 0; s0 < NSTEP; s0 += 256) {
      {
        { const int c = st >> 4, sl = st & 15;
          *(LAS u32x4*)(Qs + st * 136 + kc) = pq0A; *(LAS u32x4*)(Qs + st * 136 + kc + 8) = pq1A; *(LAS u32x4*)(Ks + st * 136 + kc) = pk0A; *(LAS u32x4*)(Ks + st * 136 + kc + 8) = pk1A;
          Ds[tid] = pdA; }
        if (tid < 128) { const unsigned vw[4] = {piA.x, piA.y, piA.z, piA.w}; const int tk = tid >> 1, c = tk >> 4, sl = tk & 15;
#pragma unroll
            for (int e = 0; e < 4; ++e) { VT[(c * 16 + (tid & 1) * 8 + 2 * e) * 40 + sl] = (bf16_t)(vw[e] & 0xffffu); VT[(c * 16 + (tid & 1) * 8 + 2 * e + 1) * 40 + sl] = (bf16_t)(vw[e] >> 16); } }
        __syncthreads();
        if (s0 + 0 + 256 < NSTEP) HG_LOAD(s0 + 0 + 256, A)
        if (wave >= 1 && wave <= 4) { const int c = wave - 1;
            f32x4v sc = (f32x4v){0.f, 0.f, 0.f, 0.f};
#pragma unroll
            for (int ks = 0; ks < 4; ++ks) { const bf16x8 af = *(const LAS bf16x8*)(Qs + (c * 16 + l15) * 136 + 32 * ks + 8 * g4), kfv = *(const LAS bf16x8*)(Ks + (c * 16 + l15) * 136 + 32 * ks + 8 * g4);
                sc = __builtin_amdgcn_mfma_f32_16x16x32_bf16(af, kfv, sc, 0, 0, 0); }
#pragma unroll
            for (int rg = 0; rg < 4; ++rg) { const int t = 4 * g4 + rg; As[(c * 16 + t) * 40 + l15] = f2bf(l15 <= t ? sc[rg] : 0.f); }
            asm volatile("s_waitcnt lgkmcnt(0)" ::: "memory");
            const bf16x8 af2 = *(const LAS bf16x8*)(As + (c * 16 + l15) * 40 + 8 * g4), vfv = *(const LAS bf16x8*)(VT + (c * 16 + l15) * 40 + 8 * g4);
            f32x4v o2 = (f32x4v){0.f, 0.f, 0.f, 0.f}; o2 = __builtin_amdgcn_mfma_f32_16x16x32_bf16(af2, vfv, o2, 0, 0, 0);
#pragma unroll
            for (int rg = 0; rg < 4; ++rg) O2s[(c * 16 + 4 * g4 + rg) * 16 + l15] = o2[rg];
        }
        __syncthreads();
#pragma unroll 1
        for (int c = 0; c < 4; ++c) {
            { const u32x2 qa = *(const LAS u32x2*)(Qs + (c * 16 + l15) * 136 + 16 * wave + 4 * g4);
              const bf16x8 af = __builtin_bit_cast(bf16x8, ((u32x4){qa.x, qa.y, 0u, 0u})), sfv = __builtin_bit_cast(bf16x8, ((u32x4){cvt_pk_bf16_sw(accS[0], accS[1]), cvt_pk_bf16_sw(accS[2], accS[3]), 0u, 0u}));
              f32x4v po = (f32x4v){0.f, 0.f, 0.f, 0.f}; po = __builtin_amdgcn_mfma_f32_16x16x32_bf16(af, sfv, po, 0, 0, 0);
#pragma unroll
              for (int rg = 0; rg < 4; ++rg) Pp[((c * 8 + wave) * 16 + 4 * g4 + rg) * 16 + l15] = po[rg]; }
            { const LAS bf16_t* kg_ = Ks + (c * 16 + 8 * (g4 & 1)) * 136 + 16 * wave + l15;
              const unsigned m_ = g4 < 2 ? 0xffffffffu : 0u;
              const u32x4 aw_ = (u32x4){((unsigned)kg_[0] | ((unsigned)kg_[136] << 16)) & m_, ((unsigned)kg_[2 * 136] | ((unsigned)kg_[3 * 136] << 16)) & m_, ((unsigned)kg_[4 * 136] | ((unsigned)kg_[5 * 136] << 16)) & m_, ((unsigned)kg_[6 * 136] | ((unsigned)kg_[7 * 136] << 16)) & m_};
              const bf16x8 af = __builtin_bit_cast(bf16x8, aw_), bfv = *(const LAS bf16x8*)(VT + (c * 16 + l15) * 40 + 8 * g4);
              const f32x4v dv = *(const LAS f32x4v*)(Ds + c * 128 + 16 * wave + 4 * g4);
              accS = __builtin_amdgcn_mfma_f32_16x16x32_bf16(af, bfv, accS, 0, 0, 0); accS = accS * dv; }
        }
        __syncthreads();
        { const int c = tid >> 7, t = (tid >> 3) & 15, v2 = (tid & 7) * 2; f32x2 sum = *(const LAS f32x2*)(O2s + (c * 16 + t) * 16 + v2);
#pragma unroll
          for (int w = 0; w < 8; ++w) sum += *(const LAS f32x2*)(Pp + ((c * 8 + w) * 16 + t) * 16 + v2);
          const int row = hgrn_row((s0 + 0) + c * 16 + t, dir, b); *(unsigned*)(Od + (size_t)row * 512 + h * 128 + vs * 16 + v2) = cvt_pk_bf16(sum[0], sum[1]); }

      }
      {
        { const int c = st >> 4, sl = st & 15;
          *(LAS u32x4*)(Qs + st * 136 + kc) = pq0B; *(LAS u32x4*)(Qs + st * 136 + kc + 8) = pq1B; *(LAS u32x4*)(Ks + st * 136 + kc) = pk0B; *(LAS u32x4*)(Ks + st * 136 + kc + 8) = pk1B;
          Ds[tid] = pdB; }
        if (tid < 128) { const unsigned vw[4] = {piB.x, piB.y, piB.z, piB.w}; const int tk = tid >> 1, c = tk >> 4, sl = tk & 15;
#pragma unroll
            for (int e = 0; e < 4; ++e) { VT[(c * 16 + (tid & 1) * 8 + 2 * e) * 40 + sl] = (bf16_t)(vw[e] & 0xffffu); VT[(c * 16 + (tid & 1) * 8 + 2 * e + 1) * 40 + sl] = (bf16_t)(vw[e] >> 16); } }
        __syncthreads();
        if (s0 + 64 + 256 < NSTEP) HG_LOAD(s0 + 64 + 256, B)
        if (wave >= 1 && wave <= 4) { const int c = wave - 1;
            f32x4v sc = (f32x4v){0.f, 0.f, 0.f, 0.f};
#pragma unroll
            for (int ks = 0; ks < 4; ++ks) { const bf16x8 af = *(const LAS bf16x8*)(Qs + (c * 16 + l15) * 136 + 32 * ks + 8 * g4), kfv = *(const LAS bf16x8*)(Ks + (c * 16 + l15) * 136 + 32 * ks + 8 * g4);
                sc = __builtin_amdgcn_mfma_f32_16x16x32_bf16(af, kfv, sc, 0, 0, 0); }
#pragma unroll
            for (int rg = 0; rg < 4; ++rg) { const int t = 4 * g4 + rg; As[(c * 16 + t) * 40 + l15] = f2bf(l15 <= t ? sc[rg] : 0.f); }
            asm volatile("s_waitcnt lgkmcnt(0)" ::: "memory");
            const bf16x8 af2 = *(const LAS bf16x8*)(As + (c * 16 + l15) * 40 + 8 * g4), vfv = *(const LAS bf16x8*)(VT + (c * 16 + l15) * 40 + 8 * g4);
            f32x4v o2 = (f32x4v){0.f, 0.f, 0.f, 0.f}; o2 = __builtin_amdgcn_mfma_f32_16x16x32_bf16(af2, vfv, o2, 0, 0, 0);
#pragma unroll
            for (int rg = 0; rg < 4; ++rg) O2s[(c * 16 + 4 * g4 + rg) * 16 + l15] = o2[rg];
        }
        __syncthreads();
#pragma unroll 1
        for (int c = 0; c < 4; ++c) {
            { const u32x2 qa = *(const LAS u32x2*)(Qs + (c * 16 + l15) * 136 + 16 * wave + 4 * g4);
              const bf16x8 af = __builtin_bit_cast(bf16x8, ((u32x4){qa.x, qa.y, 0u, 0u})), sfv = __builtin_bit_cast(bf16x8, ((u32x4){cvt_pk_bf16_sw(accS[0], accS[1]), cvt_pk_bf16_sw(accS[2], accS[3]), 0u, 0u}));
              f32x4v po = (f32x4v){0.f, 0.f, 0.f, 0.f}; po = __builtin_amdgcn_mfma_f32_16x16x32_bf16(af, sfv, po, 0, 0, 0);
#pragma unroll
              for (int rg = 0; rg < 4; ++rg) Pp[((c * 8 + wave) * 16 + 4 * g4 + rg) * 16 + l15] = po[rg]; }
            { const LAS bf16_t* kg_ = Ks + (c * 16 + 8 * (g4 & 1)) * 136 + 16 * wave + l15;
              const unsigned m_ = g4 < 2 ? 0xffffffffu : 0u;
              const u32x4 aw_ = (u32x4){((unsigned)kg_[0] | ((unsigned)kg_[136] << 16)) & m_, ((unsigned)kg_[2 * 136] | ((unsigned)kg_[3 * 136] << 16)) & m_, ((unsigned)kg_[4 * 136] | ((unsigned)kg_[5 * 136] << 16)) & m_, ((unsigned)kg_[6 * 136] | ((unsigned)kg_[7 * 136] << 16)) & m_};
              const bf16x8 af = __builtin_bit_cast(bf16x8, aw_), bfv = *(const LAS bf16x8*)(VT + (c * 16 + l15) * 40 + 8 * g4);
              const f32x4v dv = *(const LAS f32x4v*)(Ds + c * 128 + 16 * wave + 4 * g4);
              accS = __builtin_amdgcn_mfma_f32_16x16x32_bf16(af, bfv, accS, 0, 0, 0); accS = accS * dv; }
        }
        __syncthreads();
        { const int c = tid >> 7, t = (tid >> 3) & 15, v2 = (tid & 7) * 2; f32x2 sum = *(const LAS f32x2*)(O2s + (c * 16 + t) * 16 + v2);
#pragma unroll
          for (int w = 0; w < 8; ++w) sum += *(const LAS f32x2*)(Pp + ((c * 8 + w) * 16 + t) * 16 + v2);
          const int row = hgrn_row((s0 + 64) + c * 16 + t, dir, b); *(unsigned*)(Od + (size_t)row * 512 + h * 128 + vs * 16 + v2) = cvt_pk_bf16(sum[0], sum[1]); }

      }
      {
        { const int c = st >> 4, sl = st & 15;
          *(LAS u32x4*)(Qs + st * 136 + kc) = pq0C; *(LAS u32x4*)(Qs + st * 136 + kc + 8) = pq1C; *(LAS u32x4*)(Ks + st * 136 + kc) = pk0C; *(LAS u32x4*)(Ks + st * 136 + kc + 8) = pk1C;
          Ds[tid] = pdC; }
        if (tid < 128) { const unsigned vw[4] = {piC.x, piC.y, piC.z, piC.w}; const int tk = tid >> 1, c = tk >> 4, sl = tk & 15;
#pragma unroll
            for (int e = 0; e < 4; ++e) { VT[(c * 16 + (tid & 1) * 8 + 2 * e) * 40 + sl] = (bf16_t)(vw[e] & 0xffffu); VT[(c * 16 + (tid & 1) * 8 + 2 * e + 1) * 40 + sl] = (bf16_t)(vw[e] >> 16); } }
        __syncthreads();
        if (s0 + 128 + 256 < NSTEP) HG_LOAD(s0 + 128 + 256, C)
        if (wave >= 1 && wave <= 4) { const int c = wave - 1;
            f32x4v sc = (f32x4v){0.f, 0.f, 0.f, 0.f};
#pragma unroll
            for (int ks = 0; ks < 4; ++ks) { const bf16x8 af = *(const LAS bf16x8*)(Qs + (c * 16 + l15) * 136 + 32 * ks + 8 * g4), kfv = *(const LAS bf16x8*)(Ks + (c * 16 + l15) * 136 + 32 * ks + 8 * g4);
                sc = __builtin_amdgcn_mfma_f32_16x16x32_bf16(af, kfv, sc, 0, 0, 0); }
#pragma unroll
            for (int rg = 0; rg < 4; ++rg) { const int t = 4 * g4 + rg; As[(c * 16 + t) * 40 + l15] = f2bf(l15 <= t ? sc[rg] : 0.f); }
            asm volatile("s_waitcnt lgkmcnt(0)" ::: "memory");
            const bf16x8 af2 = *(const LAS bf16x8*)(As + (c * 16 + l15) * 40 + 8 * g4), vfv = *(const LAS bf16x8*)(VT + (c * 16 + l15) * 40 + 8 * g4);
            f32x4v o2 = (f32x4v){0.f, 0.f, 0.f, 0.f}; o2 = __builtin_amdgcn_mfma_f32_16x16x32_bf16(af2, vfv, o2, 0, 0, 0);
#pragma unroll
            for (int rg = 0; rg < 4; ++rg) O2s[(c * 16 + 4 * g4 + rg) * 16 + l15] = o2[rg];
        }
        __syncthreads();
#pragma unroll 1
        for (int c = 0; c < 4; ++c) {
            { const u32x2 qa = *(const LAS u32x2*)(Qs + (c * 16 + l15) * 136 + 16 * wave + 4 * g4);
              const bf16x8 af = __builtin_bit_cast(bf16x8, ((u32x4){qa.x, qa.y, 0u, 0u})), sfv = __builtin_bit_cast(bf16x8, ((u32x4){cvt_pk_bf16_sw(accS[0], accS[1]), cvt_pk_bf16_sw(accS[2], accS[3]), 0u, 0u}));
              f32x4v po = (f32x4v){0.f, 0.f, 0.f, 0.f}; po = __builtin_amdgcn_mfma_f32_16x16x32_bf16(af, sfv, po, 0, 0, 0);
#pragma unroll
              for (int rg = 0; rg < 4; ++rg) Pp[((c * 8 + wave) * 16 + 4 * g4 + rg) * 16 + l15] = po[rg]; }
            { const LAS bf16_t* kg_ = Ks + (c * 16 + 8 * (g4 & 1)) * 136 + 16 * wave + l15;
              const unsigned m_ = g4 < 2 ? 0xffffffffu : 0u;
              const u32x4 aw_ = (u32x4){((unsigned)kg_[0] | ((unsigned)kg_[136] << 16)) & m_, ((unsigned)kg_[2 * 136] | ((unsigned)kg_[3 * 136] << 16)) & m_, ((unsigned)kg_[4 * 136] | ((unsigned)kg_[5 * 136] << 16)) & m_, ((unsigned)kg_[6 * 136] | ((unsigned)kg_[7 * 136] << 16)) & m_};
              const bf16x8 af = __builtin_bit_cast(bf16x8, aw_), bfv = *(const LAS bf16x8*)(VT + (c * 16 + l15) * 40 + 8 * g4);
              const f32x4v dv = *(const LAS f32x4v*)(Ds + c * 128 + 16 * wave + 4 * g4);
              accS = __builtin_amdgcn_mfma_f32_16x16x32_bf16(af, bfv, accS, 0, 0, 0); accS = accS * dv; }
        }
        __syncthreads();
        { const int c = tid >> 7, t = (tid >> 3) & 15, v2 = (tid & 7) * 2; f32x2 sum = *(const LAS f32x2*)(O2s + (c * 16 + t) * 16 + v2);
#pragma unroll
          for (int w = 0; w < 8; ++w) sum += *(const LAS f32x2*)(Pp + ((c * 8 + w) * 16 + t) * 16 + v2);
          const int row = hgrn_row((s0 + 128) + c * 16 + t, dir, b); *(unsigned*)(Od + (size_t)row * 512 + h * 128 + vs * 16 + v2) = cvt_pk_bf16(sum[0], sum[1]); }

      }
      {
        { const int c = st >> 4, sl = st & 15;
          *(LAS u32x4*)(Qs + st * 136 + kc) = pq0D; *(LAS u32x4*)(Qs + st * 136 + kc + 8) = pq1D; *(LAS u32x4*)(Ks + st * 136 + kc) = pk0D; *(LAS u32x4*)(Ks + st * 136 + kc + 8) = pk1D;
          Ds[tid] = pdD; }
        if (tid < 128) { const unsigned vw[4] = {piD.x, piD.y, piD.z, piD.w}; const int tk = tid >> 1, c = tk >> 4, sl = tk & 15;
#pragma unroll
            for (int e = 0; e < 4; ++e) { VT[(c * 16 + (tid & 1) * 8 + 2 * e) * 40 + sl] = (bf16_t)(vw[e] & 0xffffu); VT[(c * 16 + (tid & 1) * 8 + 2 * e + 1) * 40 + sl] = (bf16_t)(vw[e] >> 16); } }
        __syncthreads();
        if (s0 + 192 + 256 < NSTEP) HG_LOAD(s0 + 192 + 256, D)
        if (wave >= 1 && wave <= 4) { const int c = wave - 1;
            f32x4v sc = (f32x4v){0.f, 0.f, 0.f, 0.f};
#pragma unroll
            for (int ks = 0; ks < 4; ++ks) { const bf16x8 af = *(const LAS bf16x8*)(Qs + (c * 16 + l15) * 136 + 32 * ks + 8 * g4), kfv = *(const LAS bf16x8*)(Ks + (c * 16 + l15) * 136 + 32 * ks + 8 * g4);
                sc = __builtin_amdgcn_mfma_f32_16x16x32_bf16(af, kfv, sc, 0, 0, 0); }
#pragma unroll
            for (int rg = 0; rg < 4; ++rg) { const int t = 4 * g4 + rg; As[(c * 16 + t) * 40 + l15] = f2bf(l15 <= t ? sc[rg] : 0.f); }
            asm volatile("s_waitcnt lgkmcnt(0)" ::: "memory");
            const bf16x8 af2 = *(const LAS bf16x8*)(As + (c * 16 + l15) * 40 + 8 * g4), vfv = *(const LAS bf16x8*)(VT + (c * 16 + l15) * 40 + 8 * g4);
            f32x4v o2 = (f32x4v){0.f, 0.f, 0.f, 0.f}; o2 = __builtin_amdgcn_mfma_f32_16x16x32_bf16(af2, vfv, o2, 0, 0, 0);
#pragma unroll
            for (int rg = 0; rg < 4; ++rg) O2s[(c * 16 + 4 * g4 + rg) * 16 + l15] = o2[rg];
        }
        __syncthreads();
#pragma unroll 1
        for (int c = 0; c < 4; ++c) {
            { const u32x2 qa = *(const LAS u32x2*)(Qs + (c * 16 + l15) * 136 + 16 * wave + 4 * g4);
              const bf16x8 af = __builtin_bit_cast(bf16x8, ((u32x4){qa.x, qa.y, 0u, 0u})), sfv = __builtin_bit_cast(bf16x8, ((u32x4){cvt_pk_bf16_sw(accS[0], accS[1]), cvt_pk_bf16_sw(accS[2], accS[3]), 0u, 0u}));
              f32x4v po = (f32x4v){0.f, 0.f, 0.f, 0.f}; po = __builtin_amdgcn_mfma_f32_16x16x32_bf16(af, sfv, po, 0, 0, 0);
#pragma unroll
              for (int rg = 0; rg < 4; ++rg) Pp[((c * 8 + wave) * 16 + 4 * g4 + rg) * 16 + l15] = po[rg]; }
            { const LAS bf16_t* kg_ = Ks + (c * 16 + 8 * (g4 & 1)) * 136 + 16 * wave + l15;
              const unsigned m_ = g4 < 2 ? 0xffffffffu : 0u;
              const u32x4 aw_ = (u32x4){((unsigned)kg_[0] | ((unsigned)kg_[136] << 16)) & m_, ((unsigned)kg_[2 * 136] | ((unsigned)kg_[3 * 136] << 16)) & m_, ((unsigned)kg_[4 * 136] | ((unsigned)kg_[5 * 136] << 16)) & m_, ((unsigned)kg_[6 * 136] | ((unsigned)kg_[7 * 136] << 16)) & m_};
              const bf16x8 af = __builtin_bit_cast(bf16x8, aw_), bfv = *(const LAS bf16x8*)(VT + (c * 16 + l15) * 40 + 8 * g4);
              const f32x4v dv = *(const LAS f32x4v*)(Ds + c * 128 + 16 * wave + 4 * g4);
              accS = __builtin_amdgcn_mfma_f32_16x16x32_bf16(af, bfv, accS, 0, 0, 0); accS = accS * dv; }
        }
        __syncthreads();
        { const int c = tid >> 7, t = (tid >> 3) & 15, v2 = (tid & 7) * 2; f32x2 sum = *(const LAS f32x2*)(O2s + (c * 16 + t) * 16 + v2);
#pragma unroll
          for (int w = 0; w < 8; ++w) sum += *(const LAS f32x2*)(Pp + ((c * 8 + w) * 16 + t) * 16 + v2);
          const int row = hgrn_row((s0 + 192) + c * 16 + t, dir, b); *(unsigned*)(Od + (size_t)row * 512 + h * 128 + vs * 16 + v2) = cvt_pk_bf16(sum[0], sum[1]); }

      }
    }
#undef HG_LOAD
}
__device__ __forceinline__ void phase_readout(const bf16_t* PAC, bf16_t* OF, const bf16_t* OB, const float* nw, int rows, int bid, int G) {
    const int tid_ = otid(); const int lane = tid_ & 63, wv = tid_ >> 6;
    for (int r = bid * 8 + wv; r < rows; r += G * 8) {
        float a[8], c[8], gg[8];
        unpack8(*(const u32x4*)(OF + (size_t)r * 512 + lane * 8), a); unpack8(*(const u32x4*)(OB + (size_t)r * 512 + lane * 8), c); unpack8(*(const u32x4*)(PAC + (size_t)r * NAC + 1024 + lane * 8), gg);
        float q = 0.f;
#pragma unroll
        for (int j = 0; j < 8; ++j) { a[j] += c[j]; q += a[j] * a[j]; }
        q += __shfl_xor(q, 1); q += __shfl_xor(q, 2); q += __shfl_xor(q, 4); q += __shfl_xor(q, 8);
        const float rs = rsqrtf(q * (1.0f / 128.0f) + 1e-6f);
#pragma unroll
        for (int j = 0; j < 8; ++j) a[j] = a[j] * rs * nw[lane * 8 + j] * silu(gg[j]);
        *(u32x4*)(OF + (size_t)r * 512 + lane * 8) = pack8(a);
    }
}

__device__ __forceinline__ void attn_item(LAS unsigned char* L, int item, const bf16_t* PAC, const float* tab, const float* sink, bf16_t* YC) {
    const bool isctx = item >= 1024;
    int n, hk, b;
    if (!isctx) { n = item & 255; hk = (item >> 8) & 1; b = item >> 9; } else { const int j = item - 1024; n = j & 3; hk = (j >> 2) & 1; b = j >> 3; }
    LAS bf16_t* Ks = (LAS bf16_t*)L;
    LAS bf16_t* Vt = Ks + 64 * 72;
    const int tid = otid(), wave = tid >> 6, lane = tid & 63, c32 = lane & 31, hi = lane >> 5;
    const int g = wave >> 1, qt = wave & 1, head = hk * 4 + g;
    const float qscale = 0.125f * 1.44269504089f;
    const int qi = n * 64 + qt * 32 + c32;
    const int qrow = isctx ? NLAT + b * LCTX + qi : b * SEQ + qi;
    bf16x8 qf[4];
    {
        const bf16_t* qp = PAC + (size_t)qrow * NAC + 2560 + head * 64 + 8 * hi;
        float x0[8], x1[8], x2[8], x3[8];
        unpack8(*(const u32x4*)(qp), x0); unpack8(*(const u32x4*)(qp + 16), x1); unpack8(*(const u32x4*)(qp + 32), x2); unpack8(*(const u32x4*)(qp + 48), x3);
        if (!isctx) {
            const float* tr = tab + ((qi >> 6) * 16 + 8 * hi) * 2; const float* tc = tab + ((qi & 63) * 16 + 8 * hi) * 2;
#pragma unroll
            for (int j = 0; j < 8; ++j) { const float cr = tr[2 * j], sr = tr[2 * j + 1], cc = tc[2 * j], scn = tc[2 * j + 1];
                const float a0 = x0[j], a1 = x1[j], b0 = x2[j], b1 = x3[j];
                x0[j] = a0 * cr - a1 * sr; x1[j] = a1 * cr + a0 * sr; x2[j] = b0 * cc - b1 * scn; x3[j] = b1 * cc + b0 * scn; }
        }
#pragma unroll
        for (int j = 0; j < 8; ++j) { x0[j] *= qscale; x1[j] *= qscale; x2[j] *= qscale; x3[j] *= qscale; }
        qf[0] = __builtin_bit_cast(bf16x8, pack8(x0)); qf[1] = __builtin_bit_cast(bf16x8, pack8(x1)); qf[2] = __builtin_bit_cast(bf16x8, pack8(x2)); qf[3] = __builtin_bit_cast(bf16x8, pack8(x3));
    }
    float m_ = sink[head] * 1.44269504089f, l_ = hi == 0 ? 1.f : 0.f;
    f32x16 O0, O1;
#pragma unroll
    for (int e = 0; e < 16; ++e) { O0[e] = 0.f; O1[e] = 0.f; }
    const int nch = isctx ? 4 : 9;
    for (int ci = 0; ci < nch; ++ci) {
        bool kctx; int kbase;
        if (isctx) { kctx = true; kbase = ci * 64; }
        else if (ci < 5) { kctx = false; kbase = (n - 2 + ci) * 64; if (kbase < 0 || kbase >= SEQ) continue; }
        else { kctx = true; kbase = (ci - 5) * 64; }
        __syncthreads();
        { const int key = tid >> 3, sub = tid & 7, a = sub >> 2, f0 = (sub & 3) * 4;
          const int krow = kctx ? NLAT + b * LCTX + kbase + key : b * SEQ + kbase + key;
          const bf16_t* kp = PAC + (size_t)krow * NAC + 3072 + hk * 64 + a * 32 + f0;
          const u32x2 w1 = *(const u32x2*)kp, w2 = *(const u32x2*)(kp + 16);
          float y1[4] = {bflo(w1.x), bfhi(w1.x), bflo(w1.y), bfhi(w1.y)}, y2[4] = {bflo(w2.x), bfhi(w2.x), bflo(w2.y), bfhi(w2.y)};
          if (!kctx) { const int pos = kbase + key; const int idx = a ? (pos & 63) : (pos >> 6); const float* tp = tab + (idx * 16 + f0) * 2;
#pragma unroll
              for (int j = 0; j < 4; ++j) { const float c = tp[2 * j], s = tp[2 * j + 1]; const float u0 = y1[j], u1 = y2[j]; y1[j] = u0 * c - u1 * s; y2[j] = u1 * c + u0 * s; } }
          u32x2 o1, o2; o1.x = cvt_pk_bf16(y1[0], y1[1]); o1.y = cvt_pk_bf16(y1[2], y1[3]); o2.x = cvt_pk_bf16(y2[0], y2[1]); o2.y = cvt_pk_bf16(y2[2], y2[3]);
          *(LAS u32x2*)(Ks + key * 72 + a * 32 + f0) = o1; *(LAS u32x2*)(Ks + key * 72 + a * 32 + 16 + f0) = o2;
          const u32x4 vw = *(const u32x4*)(PAC + (size_t)krow * NAC + 3200 + hk * 64 + sub * 8);
          Vt[(sub * 8 + 0) * 68 + key] = (bf16_t)(vw.x & 0xffffu); Vt[(sub * 8 + 1) * 68 + key] = (bf16_t)(vw.x >> 16);
          Vt[(sub * 8 + 2) * 68 + key] = (bf16_t)(vw.y & 0xffffu); Vt[(sub * 8 + 3) * 68 + key] = (bf16_t)(vw.y >> 16);
          Vt[(sub * 8 + 4) * 68 + key] = (bf16_t)(vw.z & 0xffffu); Vt[(sub * 8 + 5) * 68 + key] = (bf16_t)(vw.z >> 16);
          Vt[(sub * 8 + 6) * 68 + key] = (bf16_t)(vw.w & 0xffffu); Vt[(sub * 8 + 7) * 68 + key] = (bf16_t)(vw.w >> 16); }
        __syncthreads();
        f32x16 S0, S1;
#pragma unroll
        for (int e = 0; e < 16; ++e) { S0[e] = 0.f; S1[e] = 0.f; }
#pragma unroll
        for (int ks = 0; ks < 4; ++ks) {
            const bf16x8 k0 = *(const LAS bf16x8*)(Ks + (c32) * 72 + ks * 16 + hi * 8), k1 = *(const LAS bf16x8*)(Ks + (32 + c32) * 72 + ks * 16 + hi * 8);
            S0 = __builtin_amdgcn_mfma_f32_32x32x16_bf16(k0, qf[ks], S0, 0, 0, 0); S1 = __builtin_amdgcn_mfma_f32_32x32x16_bf16(k1, qf[ks], S1, 0, 0, 0); }
        float mx = -1e30f;
        if (!kctx) {
#pragma unroll
            for (int e = 0; e < 16; ++e) { const int kp0 = kbase + (e & 3) + 8 * (e >> 2) + 4 * hi; const int d0 = qi - kp0, d1 = d0 - 32;
                if (d0 > 128 || d0 < -128) S0[e] = -1e30f; if (d1 > 128 || d1 < -128) S1[e] = -1e30f; }
        }
#pragma unroll
        for (int e = 0; e < 16; ++e) mx = fmaxf(mx, fmaxf(S0[e], S1[e]));
        mx = fmaxf(mx, __shfl_xor(mx, 32));
        const float mnew = fmaxf(m_, mx), alpha = __builtin_amdgcn_exp2f(m_ - mnew); m_ = mnew;
        float ps = 0.f;
#pragma unroll
        for (int e = 0; e < 16; ++e) { S0[e] = __builtin_amdgcn_exp2f(S0[e] - mnew); S1[e] = __builtin_amdgcn_exp2f(S1[e] - mnew); ps += S0[e] + S1[e]; }
        l_ = l_ * alpha + ps;
#pragma unroll
        for (int e = 0; e < 16; ++e) { O0[e] *= alpha; O1[e] *= alpha; }
#pragma unroll
        for (int kt = 0; kt < 2; ++kt)
#pragma unroll
            for (int s2 = 0; s2 < 2; ++s2) {
                u32x4 w;
                if (kt == 0) { w.x = cvt_pk_bf16_sw(S0[8 * s2 + 0], S0[8 * s2 + 1]); w.y = cvt_pk_bf16_sw(S0[8 * s2 + 2], S0[8 * s2 + 3]); w.z = cvt_pk_bf16_sw(S0[8 * s2 + 4], S0[8 * s2 + 5]); w.w = cvt_pk_bf16_sw(S0[8 * s2 + 6], S0[8 * s2 + 7]); }
                else { w.x = cvt_pk_bf16_sw(S1[8 * s2 + 0], S1[8 * s2 + 1]); w.y = cvt_pk_bf16_sw(S1[8 * s2 + 2], S1[8 * s2 + 3]); w.z = cvt_pk_bf16_sw(S1[8 * s2 + 4], S1[8 * s2 + 5]); w.w = cvt_pk_bf16_sw(S1[8 * s2 + 6], S1[8 * s2 + 7]); }
                const bf16x8 pf = __builtin_bit_cast(bf16x8, w);
                const LAS bf16_t* vp0 = Vt + (c32) * 68 + kt * 32 + 16 * s2 + 4 * hi; const LAS bf16_t* vp1 = vp0 + 32 * 68;
                const u32x2 a0 = *(const LAS u32x2*)vp0, a1 = *(const LAS u32x2*)(vp0 + 8), b0 = *(const LAS u32x2*)vp1, b1 = *(const LAS u32x2*)(vp1 + 8);
                const bf16x8 vf0 = __builtin_bit_cast(bf16x8, ((u32x4){a0.x, a0.y, a1.x, a1.y})), vf1 = __builtin_bit_cast(bf16x8, ((u32x4){b0.x, b0.y, b1.x, b1.y}));
                O0 = __builtin_amdgcn_mfma_f32_32x32x16_bf16(vf0, pf, O0, 0, 0, 0); O1 = __builtin_amdgcn_mfma_f32_32x32x16_bf16(vf1, pf, O1, 0, 0, 0);
            }
    }
    {
        const float lt = l_ + __shfl_xor(l_, 32); const float inv = 1.f / lt;
        bf16_t* yp = YC + (size_t)qrow * 512 + head * 64 + 4 * hi;
#pragma unroll
        for (int i = 0; i < 4; ++i) { u32x2 w; w.x = cvt_pk_bf16(O0[4 * i] * inv, O0[4 * i + 1] * inv); w.y = cvt_pk_bf16(O0[4 * i + 2] * inv, O0[4 * i + 3] * inv); *(u32x2*)(yp + 8 * i) = w;
            u32x2 w2; w2.x = cvt_pk_bf16(O1[4 * i] * inv, O1[4 * i + 1] * inv); w2.y = cvt_pk_bf16(O1[4 * i + 2] * inv, O1[4 * i + 3] * inv); *(u32x2*)(yp + 32 + 8 * i) = w2; }
    }
    __syncthreads();
}

__device__ __forceinline__ void filt_item(LAS unsigned char* L, int item, int Lseq, bool latent, const float* w1, const float* b1, const float* f1, const float* w2, const float* b2, const float* f2, const float* w3, float* l1acc, bf16_t* FR, float* fc) {
    const int tid = otid(), p0 = item * 64;
    LAS float* feats = (LAS float*)L; LAS float* h1 = feats + 64 * 36; LAS float* h2 = h1 + 64 * 64;
    __syncthreads();
    for (int e = tid; e < 64 * 33; e += 512) { const int p = e / 33, j = e % 33; const float pos = (float)(p0 + p);
        float val;
        if (j == 0) val = pos / (float)(Lseq - 1);
        else { const int bi = (j - 1) & 15; const float band = 1e-4f + (float)bi * ((15.0f - 1e-4f) / 15.0f); const float w = 2.0f * 3.14159265358979f * pos / (float)Lseq;
            val = j <= 16 ? __cosf(w * band) : -__sinf(w * band); }
        feats[p * 36 + j] = val; }
    __syncthreads();
    { const int nn = tid & 63, pg = tid >> 6;
      float acc[8];
#pragma unroll
      for (int i = 0; i < 8; ++i) acc[i] = 0.f;
      for (int j = 0; j < 33; ++j) { const float wv = w1[j * 64 + nn];
#pragma unroll
          for (int i = 0; i < 8; ++i) acc[i] += feats[(pg * 8 + i) * 36 + j] * wv; }
      const float bb = b1[nn], ff = f1[nn];
#pragma unroll
      for (int i = 0; i < 8; ++i) h1[(pg * 8 + i) * 64 + nn] = __sinf(ff * (acc[i] + bb)); }
    __syncthreads();
    { const int nn = tid & 63, pg = tid >> 6;
      float acc[8];
#pragma unroll
      for (int i = 0; i < 8; ++i) acc[i] = 0.f;
      for (int j = 0; j < 64; ++j) { const float wv = w2[j * 64 + nn];
#pragma unroll
          for (int i = 0; i < 8; ++i) acc[i] += h1[(pg * 8 + i) * 64 + j] * wv; }
      const float bb = b2[nn], ff = f2[nn];
#pragma unroll
      for (int i = 0; i < 8; ++i) h2[(pg * 8 + i) * 64 + nn] = __sinf(ff * (acc[i] + bb)); }
    __syncthreads();
    for (int jj = 0; jj < 4; ++jj) {
        const int c = tid + 512 * jj;
        const int dirn = c >> 10, ord = (c >> 9) & 1, ch = c & 511;
        const float rate = fabsf(-3.0701134573f + (float)ch * ((-15.350567286f + 3.0701134573f) / 511.0f));
        float asum = 0.f;
        for (int pgp = 0; pgp < 4; ++pgp) {
            float acc[16];
#pragma unroll
            for (int p = 0; p < 16; ++p) acc[p] = 0.f;
            for (int k4 = 0; k4 < 16; ++k4) {
                const float wa = w3[(size_t)(4 * k4) * 2048 + c], wb = w3[(size_t)(4 * k4 + 1) * 2048 + c], wc = w3[(size_t)(4 * k4 + 2) * 2048 + c], wd = w3[(size_t)(4 * k4 + 3) * 2048 + c];
#pragma unroll
                for (int p = 0; p < 16; ++p) { const f32x4 hv = *(const LAS f32x4*)(h2 + (pgp * 16 + p) * 64 + 4 * k4); acc[p] += (hv[0] * wa + hv[1] * wb) + (hv[2] * wc + hv[3] * wd); }
            }
#pragma unroll
            for (int p = 0; p < 16; ++p) { const int pos = p0 + pgp * 16 + p; const float t = (float)pos / (float)(Lseq - 1); const float val = acc[p] * __expf(-t * rate);
                if (!(dirn == 1 && pos == 0)) { asum += fabsf(val);
                    if (latent) { const int m = dirn == 0 ? FRC - pos : FRC + pos; FR[(size_t)(ord * 512 + ch) * FRLEN + m] = f2bf(val); } }
                if (!latent) fc[(size_t)pos * 2048 + c] = val; }
        }
        atomicAdd(l1acc + ord * 512 + ch, asum);
    }
    if (latent) {
        for (int e = tid; e < 4 * 129; e += 512) { const int rr = item * 4 + e / 129, q = e % 129; const int m = q < 64 ? q : (FRC + SEQ + (q - 64)); FR[(size_t)rr * FRLEN + m] = 0; }
    }
}
__device__ __forceinline__ void hyprep_phase(LAS unsigned char* L, const bf16_t* PB, const float* cw, const float* cb, bf16_t* T, int bid, int G) {
    LAS float* xs = (LAS float*)L;
    const int tid = otid();
    u32x4 p0 = (u32x4){0, 0, 0, 0}, p1 = (u32x4){0, 0, 0, 0};
#define HP_LOAD(IT) { const int tt_ = (IT) / 24, ct_ = (IT) % 24; const int r0_ = tt_ * 64, c0_ = ct_ * 64; const int b_ = r0_ >> 14, t0_ = r0_ & (SEQ - 1); \
        { const int rr = tid >> 3, ck = (tid & 7) * 8; const int t = t0_ - 1 + rr; p0 = (t >= 0 && t < SEQ) ? *(const u32x4*)(PB + (size_t)(b_ * SEQ + t) * NPB + c0_ + ck) : (u32x4){0, 0, 0, 0}; } \
        if (tid < 16) { const int rr = 64 + (tid >> 3), ck = (tid & 7) * 8; const int t = t0_ - 1 + rr; p1 = (t >= 0 && t < SEQ) ? *(const u32x4*)(PB + (size_t)(b_ * SEQ + t) * NPB + c0_ + ck) : (u32x4){0, 0, 0, 0}; } }
    int it = bid;
    if (it < 512 * 24) HP_LOAD(it)
    for (; it < 512 * 24; it += G) {
        const int tt = it / 24, ct = it % 24; const int r0 = tt * 64, c0 = ct * 64; const int b = r0 >> 14, t0 = r0 & (SEQ - 1);
        __syncthreads();
        { float f[8]; unpack8(p0, f); const int rr = tid >> 3, ck = (tid & 7) * 8;
#pragma unroll
          for (int j = 0; j < 8; ++j) xs[rr * 65 + ck + j] = f[j];
          if (tid < 16) { unpack8(p1, f); const int rr2 = 64 + (tid >> 3);
#pragma unroll
              for (int j = 0; j < 8; ++j) xs[rr2 * 65 + ck + j] = f[j]; } }
        __syncthreads();
        if (it + G < 512 * 24) HP_LOAD(it + G)
        { const int cl = tid >> 3, tc = (tid & 7) * 8, c = c0 + cl; const float w0 = cw[c], w1 = cw[NPB + c], w2 = cw[2 * NPB + c], bb = cb[c]; float o[8];
#pragma unroll
          for (int j = 0; j < 8; ++j) o[j] = xs[(tc + j) * 65 + cl] * w0 + xs[(tc + j + 1) * 65 + cl] * w1 + xs[(tc + j + 2) * 65 + cl] * w2 + bb;
          *(u32x4*)(T + ((size_t)c * 2 + b) * SEQ + t0 + tc) = pack8(o); }
    }
#undef HP_LOAD
}
__device__ __forceinline__ void hyconv_item(LAS unsigned char* L, int ch, bf16_t* T, const bf16_t* FR, const float* l1acc, const float* hbias) {
    LAS bf16_t* zs = (LAS bf16_t*)L; LAS bf16_t* fr = zs + 2 * ZP;
    const int tid = otid(), wave = tid >> 6, lane = tid & 63, r = lane & 31, h = lane >> 5;
    const int b = wave >> 2, tt0 = (wave & 3) * 4;
    __syncthreads();
    for (int e = tid; e < 2 * 2048; e += 512) { const int bb = e >> 11, ck = e & 2047; const u32x4 w = *(const u32x4*)(T + ((size_t)ch * 2 + bb) * SEQ + ck * 8); const int i = 1024 + ck * 8;
        *(LAS u32x4*)(zs + bb * ZP + (i >> 5) * 40 + (i & 31)) = w; }
    for (int e = tid; e < 2 * 64 * 5; e += 512) { const int bb = e / 320, q = e % 320, blk = q / 5, part = q % 5; const int bk = blk < 32 ? blk : 512 + blk;
        *(LAS u32x4*)(zs + bb * ZP + bk * 40 + part * 8) = (u32x4){0, 0, 0, 0}; }
    for (int ord = 0; ord < 2; ++ord) {
        const bf16_t* frg = FR + (size_t)(ord * 512 + ch) * FRLEN;
        for (int e = tid; e < FRLEN / 8; e += 512) *(LAS u32x4*)(fr + e * 8) = *(const u32x4*)(frg + e * 8);
        __syncthreads();
        f32x16 acc[4];
#pragma unroll
        for (int i = 0; i < 4; ++i)
#pragma unroll
            for (int e = 0; e < 16; ++e) acc[i][e] = 0.f;
        const int s_lo = 64 * tt0 - 1023, s_hi = 64 * (tt0 + 3) + 62;
        const LAS unsigned char* zb = (const LAS unsigned char*)(zs + b * ZP);
#define HY_A(off) ({ const LAS unsigned* ap_ = (const LAS unsigned*)(abase + (off)); const unsigned e0 = ap_[0], e1 = ap_[1], e2 = ap_[2], e3 = ap_[3], e4 = ap_[4]; \
            __builtin_bit_cast(bf16x8, ((u32x4){__builtin_amdgcn_alignbit(e1, e0, shb), __builtin_amdgcn_alignbit(e2, e1, shb), __builtin_amdgcn_alignbit(e3, e2, shb), __builtin_amdgcn_alignbit(e4, e3, shb)})); })
#define HY_MM(i, OFF, AF) acc[i] = __builtin_amdgcn_mfma_f32_32x32x16_bf16(AF, *(const LAS bf16x8*)(bbase + 2560 * (i) + (OFF)), acc[i], 0, 0, 0);
#define HY_SEG(SB, NP, T0, T1, T2, T3) { const int sb_ = (SB); const int m0b = FRC - 16 * sb_ - r + 8 * h; \
            const LAS unsigned char* abase = (const LAS unsigned char*)fr + ((2 * m0b) & ~3) - 32; \
            const LAS unsigned char* bbase = zb + (((32 - ((sb_ + 1) >> 1)) + 32 * tt0 + r) * 40 + 8 * h) * 2; \
            _Pragma("unroll 1") for (int p = 0; p < (NP); ++p) { const bf16x8 a_o = HY_A(32), a_e = HY_A(0); \
                if (T0) HY_MM(0, 32, a_o) if (T1) HY_MM(1, 32, a_o) if (T2) HY_MM(2, 32, a_o) if (T3) HY_MM(3, 32, a_o) \
                if (T0) HY_MM(0, 0, a_e) if (T1) HY_MM(1, 0, a_e) if (T2) HY_MM(2, 0, a_e) if (T3) HY_MM(3, 0, a_e) \
                abase -= 64; bbase -= 80; } }
        const unsigned shb = ((FRC - r) & 1) * 16;
        HY_SEG(s_lo, 32, 1, 0, 0, 0) HY_SEG(s_lo + 64, 32, 1, 1, 0, 0) HY_SEG(s_lo + 128, 32, 1, 1, 1, 0)
        HY_SEG(s_lo + 192, 447, 1, 1, 1, 1)
        HY_SEG(s_lo + 1086, 32, 0, 1, 1, 1) HY_SEG(s_lo + 1150, 32, 0, 0, 1, 1) HY_SEG(s_lo + 1214, 32, 0, 0, 0, 1)
#undef HY_A
#undef HY_MM
#undef HY_SEG
        __syncthreads();
        const float inv = 1.0f / l1acc[ord * 512 + ch], bs = hbias[ord * 512 + ch];
        bf16_t* xg = T + ((size_t)((ord + 1) * 512 + ch) * 2 + b) * SEQ;
#pragma unroll
        for (int i = 0; i < 4; ++i) { const int col = 32 * (tt0 + i) + r;
#pragma unroll
            for (int gq = 0; gq < 4; ++gq) { const int t = 32 * col + 8 * gq + 4 * h; const int iz = 1024 + t;
                LAS u32x2* zp = (LAS u32x2*)(zs + b * ZP + (iz >> 5) * 40 + (iz & 31));
                const u32x2 zw = *zp; const u32x2 xw = *(const u32x2*)(xg + t);
                const float z0 = bflo(zw.x), z1 = bfhi(zw.x), z2 = bflo(zw.y), z3 = bfhi(zw.y);
                const float o0 = bflo(xw.x) * (acc[i][4 * gq] * inv + bs * z0), o1 = bfhi(xw.x) * (acc[i][4 * gq + 1] * inv + bs * z1);
                const float o2 = bflo(xw.y) * (acc[i][4 * gq + 2] * inv + bs * z2), o3 = bfhi(xw.y) * (acc[i][4 * gq + 3] * inv + bs * z3);
                u32x2 ow; ow.x = cvt_pk_bf16(o0, o1); ow.y = cvt_pk_bf16(o2, o3);
                if (ord == 0) *zp = ow; else *(u32x2*)(xg + t) = ow; } }
        __syncthreads();
    }
}
__device__ __forceinline__ void hytrb_phase(LAS unsigned char* L, const bf16_t* T2, bf16_t* YB, int bid, int G) {
    LAS bf16_t* tl = (LAS bf16_t*)L;
    const int tid = otid(); const int cl = tid >> 3, tc = (tid & 7) * 8;
    int it = bid;
    if (it >= 512 * 8) return;
    u32x4 pv;
#define TRB_LOAD(IT) { const int tt_ = (IT) >> 3, ct_ = (IT) & 7; const int r0_ = tt_ * 64, c0_ = ct_ * 64, b_ = r0_ >> 14, t0_ = r0_ & (SEQ - 1); pv = *(const u32x4*)(T2 + ((size_t)(c0_ + cl) * 2 + b_) * SEQ + t0_ + tc); }
    TRB_LOAD(it)
    for (; it < 512 * 8; it += G) {
        const int tt = it >> 3, ct = it & 7; const int r0 = tt * 64, c0 = ct * 64;
        __syncthreads();
        *(LAS u32x4*)(tl + cl * 72 + tc) = pv;
        __syncthreads();
        if (it + G < 512 * 8) TRB_LOAD(it + G)
        { const int tl_ = tid >> 3, cc = (tid & 7) * 8; unsigned w[4];
#pragma unroll
          for (int j = 0; j < 4; ++j) w[j] = (unsigned)tl[(cc + 2 * j) * 72 + tl_] | ((unsigned)tl[(cc + 2 * j + 1) * 72 + tl_] << 16);
          *(u32x4*)(YB + (size_t)(r0 + tl_) * 512 + c0 + cc) = (u32x4){w[0], w[1], w[2], w[3]}; }
    }
#undef TRB_LOAD
    __syncthreads();
}
__device__ __forceinline__ void hyctx_shortconv(const bf16_t* PB, const float* cw, const float* cb, float* SC, int bid, int G) {
    for (int e = bid * 512 + otid(); e < NCTX * NPB; e += G * 512) { const int r = e / NPB, c = e % NPB, t = r & 255;
        const bf16_t* p = PB + (size_t)(NLAT + r) * NPB + c;
        const float xm = t > 0 ? bf2f(p[-NPB]) : 0.f, x0 = bf2f(p[0]), xp = t < 255 ? bf2f(p[NPB]) : 0.f;
        SC[e] = xm * cw[c] + x0 * cw[NPB + c] + xp * cw[2 * NPB + c] + cb[c]; }
}
__device__ __forceinline__ void hyctx_conv(int ord, const float* SC, const float* zin, int ldz, const float* fc, const float* l1c, const float* hbias, float* z1c, bf16_t* YB, int bid, int G) {
    for (int e = bid * 512 + otid(); e < NCTX * 512; e += G * 512) { const int r = e >> 9, ch = e & 511, b = r >> 8, t = r & 255;
        float s = 0.f;
        for (int j = 0; j < 256; ++j) { const int x = t - j; const float fv = x >= 0 ? fc[(size_t)x * 2048 + ord * 512 + ch] : fc[(size_t)(-x) * 2048 + 1024 + ord * 512 + ch];
            s += fv * zin[(size_t)(b * 256 + j) * ldz + ch]; }
        const float zt = zin[(size_t)r * ldz + ch];
        const float o = SC[(size_t)r * NPB + (ord + 1) * 512 + ch] * (s / l1c[ord * 512 + ch] + hbias[ord * 512 + ch] * zt);
        if (ord == 0) z1c[e] = o; else YB[(size_t)(NLAT + r) * 512 + ch] = f2bf(o); }
}

constexpr int NPHASE = 2 + 17 * 2;
#define P_BIG (a.ws + WS_BIG)
#define P_W (a.ws + WS_W)
#define P_U ((bf16_t*)(a.ws + WS_U))
#define P_U2 ((bf16_t*)(P_BIG + (size_t)MROWS * D * 2))
#define P_HC ((float*)(a.ws + WS_HC))
#define P_MODS ((float*)(a.ws + WS_MISC + MI_MODS))
#define P_TAB ((const float*)(a.ws + WS_MISC + MI_TAB))
#define P_ACT ((bf16_t*)(P_BIG + ((sp >= 14 || sp <= 2) ? B_Y : B_ACT)))
#define P_Y ((bf16_t*)(P_BIG + ((sp >= 14 || sp <= 2) ? (size_t)0 : B_Y)))
#define P_PAC ((bf16_t*)(P_BIG + B_PAC))
#define P_OB ((bf16_t*)(P_BIG + B_OB))
#define P_PB ((bf16_t*)(P_BIG + B_PB))
#define P_T ((bf16_t*)(P_BIG + B_T))
#define P_FR ((bf16_t*)(P_BIG + B_F))
#define P_PG ((bf16_t*)(P_BIG + B_PG))
#define P_YA ((bf16_t*)(P_BIG + B_YA))
#define P_YB ((bf16_t*)(P_BIG + B_YB))
#define P_YC ((bf16_t*)(P_BIG + B_YC))
#define P_L1 ((float*)(a.ws + WS_MISC + MI_L1) + layer * 1024)
#define P_L1C ((float*)(a.ws + WS_MISC + MI_L1C))
#define P_FC ((float*)(a.ws + WS_MISC + MI_FC))
#define P_SC ((float*)(a.ws + WS_MISC + MI_SC))
#define P_Z1C ((float*)(a.ws + WS_MISC + MI_Z1C))
#define HY_W1 (a.in[15] + layer * 33 * 64)
#define HY_B1 (a.in[16] + layer * 64)
#define HY_F1 (a.in[17] + layer * 64)
#define HY_W2 (a.in[18] + layer * 64 * 64)
#define HY_B2 (a.in[19] + layer * 64)
#define HY_F2 (a.in[20] + layer * 64)
#define HY_W3 (a.in[21] + (size_t)layer * 64 * 2048)
#define HY_BIAS (a.in[22] + layer * 1024)
#define HY_CW (a.in[13] + layer * 3 * NPB)
#define HY_CB (a.in[14] + layer * NPB)
#define MODL (P_MODS + (size_t)layer * 3 * NMOD)
#define LNG (a.in[6] + (size_t)layer * 3 * D)
#define LNB (a.in[7] + (size_t)layer * 3 * D)
__global__ void __launch_bounds__(512, 2) mega(Args a) {
    extern __shared__ __attribute__((aligned(16))) unsigned char lds_raw[];
    LAS unsigned char* L = (LAS unsigned char*)lds_raw;
    cg::grid_group grid = cg::this_grid();
    const int bid = blockIdx.x, G = gridDim.x;
    if (a.ph_hi - a.ph_lo > 1) grid.sync();
    for (int ph = a.ph_lo; ph < a.ph_hi; ++ph) {
        bool do_gemm = false; pg8::Gemm gg{}; pg8::EpiAny ep{}; int gM = 0, gN = 0, gbr = 1;
        if (ph == 0) { phase_wconv(L, a, 0, bid, G); phase_mods(L, a, bid, G); }
        else if (ph == 1) { LnP p{a.in[0], a.in[2], nullptr, nullptr, nullptr, 0, nullptr, 0, 0.f, nullptr, nullptr, P_MODS, 0, P_U, MROWS, 0}; phase_ln(p, bid, G); }
        else {
            const int layer = (ph - 2) / 17, sp = (ph - 2) % 17;
            const int Mpost = layer == 1 ? NLAT : MROWS;
            switch (sp) {
            case 0: case 14: {
                const int f = sp == 0 ? 1 : 0; const bf16_t* Wt = (const bf16_t*)(P_W + W_IN) + (size_t)f * NFF2 * D;
                gg = pg8::Gemm{sp == 0 ? P_U : P_U2, Wt, 0, 0, D, D, D}; gM = sp == 0 ? MROWS : Mpost; gN = NFF2; ep = pg8::EpiAny{1, P_ACT, DFF, nullptr, nullptr}; do_gemm = true; } break;
            case 1: case 15: {
                const int f = sp == 1 ? 1 : 0; const bf16_t* Wt = (const bf16_t*)(P_W + W_OUT) + (size_t)f * D * DFF;
                gg = pg8::Gemm{P_ACT, Wt, 0, 0, DFF, DFF, DFF}; gM = sp == 1 ? MROWS : Mpost; gN = D; ep = pg8::EpiAny{0, P_Y, D, nullptr, nullptr}; do_gemm = true; } break;
            case 2: { const bool first = layer == 0;
                LnP p{first ? a.in[0] : a.out, first ? a.in[2] : P_HC, a.out, P_HC, P_Y, D, MODL, 2, 0.5f, LNG, LNB, MODL, 3, P_U, MROWS, 1}; phase_ln(p, bid, G); } break;
            case 3: { const bf16_t* Wt = (const bf16_t*)(P_W + W_MIX);
                gg = pg8::Gemm{P_U, Wt, 0, 0, D, D, D}; gM = MROWS; gN = NAC; ep = pg8::EpiAny{0, P_PAC, NAC, nullptr, nullptr}; do_gemm = true; } break;
            case 4: {
                bf16_t* QB = (bf16_t*)(P_BIG + B_QB); float* DB = (float*)(P_BIG + B_DB);
                hgrn_prepass(P_PAC, QB, DB, a.in[11], layer, bid, G);
                {
                    __syncthreads();
                    if (threadIdx.x < 64) {
                        __builtin_amdgcn_fence(__ATOMIC_RELEASE, "agent"); asm volatile("s_waitcnt vmcnt(0) lgkmcnt(0)" ::: "memory");
                        if (threadIdx.x == 0) { unsigned* bar2 = (unsigned*)(a.ws + WS_MISC + MI_BAR) + 16;
                            __hip_atomic_fetch_add(bar2, 1u, __ATOMIC_RELAXED, __HIP_MEMORY_SCOPE_AGENT);
                            const unsigned target = (unsigned)(layer + 1) * (unsigned)G;
                            while (__hip_atomic_load(bar2, __ATOMIC_RELAXED, __HIP_MEMORY_SCOPE_AGENT) < target) __builtin_amdgcn_s_sleep(1); }
                        __builtin_amdgcn_fence(__ATOMIC_ACQUIRE, "agent"); asm volatile("s_waitcnt vmcnt(0) lgkmcnt(0)" ::: "memory"); }
                    __syncthreads();
                }
                const int nh = G >= 256 ? 128 : G / 2;
                if (bid < nh) { for (int it = bid; it < 128; it += nh) hgrn_scan_item(L, it, P_PAC, QB, DB, P_YA, P_OB); }
                else { const int nitem = layer == 0 ? 1040 : 1024; for (int it = bid - nh; it < nitem; it += G - nh) attn_item(L, it, P_PAC, P_TAB, a.in[23] + layer * 8, P_YC); }
            } break;
            case 5: phase_readout(P_PAC, P_YA, P_OB, a.in[12] + layer * 512, Mpost, bid, G); break;
            case 6: { const bf16_t* Wt = (const bf16_t*)(P_W + W_MIX) + (size_t)NAC * D;
                gg = pg8::Gemm{P_U, Wt, 0, 0, D, D, D}; gM = Mpost; gN = NPB; ep = pg8::EpiAny{0, P_PB, NPB, nullptr, nullptr}; do_gemm = true; } break;
            case 7: {
                for (int it = bid; it < 256; it += G) filt_item(L, it, SEQ, true, HY_W1, HY_B1, HY_F1, HY_W2, HY_B2, HY_F2, HY_W3, P_L1, P_FR, nullptr);
                if (layer == 0) { for (int it = bid; it < 4; it += G) filt_item(L, it, LCTX, false, HY_W1, HY_B1, HY_F1, HY_W2, HY_B2, HY_F2, HY_W3, P_L1C, nullptr, P_FC);
                    hyctx_shortconv(P_PB, HY_CW, HY_CB, P_SC, bid, G); }
                hyprep_phase(L, P_PB, HY_CW, HY_CB, P_T, bid, G);
            } break;
            case 8: {
                for (int ch = bid; ch < 512; ch += G) hyconv_item(L, ch, P_T, P_FR, P_L1, HY_BIAS);
                if (layer == 0) hyctx_conv(0, P_SC, P_SC, NPB, P_FC, P_L1C, HY_BIAS, P_Z1C, P_YB, bid, G);
            } break;
            case 9: {
                hytrb_phase(L, P_T + (size_t)2 * 512 * 2 * SEQ, P_YB, bid, G);
                if (layer == 0) hyctx_conv(1, P_SC, P_Z1C, 512, P_FC, P_L1C, HY_BIAS, P_Z1C, P_YB, bid, G);
            } break;
            case 10: { const bf16_t* Wt = (const bf16_t*)(P_W + W_MIX) + (size_t)(NAC + NPB) * D;
                gg = pg8::Gemm{P_U, Wt, 0, 0, D, D, D}; gM = Mpost; gN = NPG; ep = pg8::EpiAny{0, P_PG, NPG, nullptr, nullptr}; do_gemm = true; } break;
            case 11: { const bf16_t* Wt = (const bf16_t*)(P_W + W_BR);
                gg = pg8::Gemm{P_YA, Wt, YSZ, (size_t)D * 512 * 2, 512, 512, 512}; gM = Mpost; gN = D; gbr = 3;
                ep = pg8::EpiAny{2, P_PG, NPG, P_PG, (float*)(P_BIG + B_SCR) + (size_t)bid * 65536}; do_gemm = true; } break;
            case 12: { const bf16_t* Wt = (const bf16_t*)(P_W + W_O);
                gg = pg8::Gemm{P_PG, Wt, 0, 0, NPG, D, D}; gM = Mpost; gN = D; ep = pg8::EpiAny{0, P_Y, D, nullptr, nullptr}; do_gemm = true; } break;
            case 13: { LnP p{a.out, P_HC, a.out, P_HC, P_Y, D, MODL, 5, 1.0f, LNG + D, LNB + D, MODL, 6, P_U2, Mpost, 1}; phase_ln(p, bid, G); } break;
            case 16: {
                LnP p{a.out, P_HC, a.out, P_HC, P_Y, D, MODL, 8, 0.5f, LNG + 2 * D, LNB + 2 * D, P_MODS + (size_t)(layer + 1) * 3 * NMOD, 0, P_U, Mpost, layer == 0 ? 1 : 2}; phase_ln(p, bid, G);
                if (layer == 0) phase_wconv(L, a, 1, bid, G);
            } break;
            }
        }
        if (do_gemm) { pg8::Order S; S.init(gM, gN, G, bid, gbr); pg8::gemm_phase(L, gg, S, ep); }
        if (ph + 1 < a.ph_hi) {
            __syncthreads();
            if (threadIdx.x < 64) {
                __builtin_amdgcn_fence(__ATOMIC_RELEASE, "agent"); asm volatile("s_waitcnt vmcnt(0) lgkmcnt(0)" ::: "memory");
                if (threadIdx.x == 0) {
                    unsigned* bar = (unsigned*)(a.ws + WS_MISC + MI_BAR);
                    const unsigned k = (unsigned)(ph - a.ph_lo + 1);
                    if ((G & 7) == 0) {
                        unsigned* grp = (unsigned*)(a.ws + WS_MISC + MI_BAR2) + (bid & 7) * 16;
                        const unsigned old = __hip_atomic_fetch_add(grp, 1u, __ATOMIC_RELAXED, __HIP_MEMORY_SCOPE_AGENT);
                        if (old + 1u == k * (unsigned)(G >> 3)) __hip_atomic_fetch_add(bar, 1u, __ATOMIC_RELAXED, __HIP_MEMORY_SCOPE_AGENT);
                        while (__hip_atomic_load(bar, __ATOMIC_RELAXED, __HIP_MEMORY_SCOPE_AGENT) < 8u * k) __builtin_amdgcn_s_sleep(1);
                    } else {
                        __hip_atomic_fetch_add(bar, 1u, __ATOMIC_RELAXED, __HIP_MEMORY_SCOPE_AGENT);
                        while (__hip_atomic_load(bar, __ATOMIC_RELAXED, __HIP_MEMORY_SCOPE_AGENT) < k * (unsigned)G) __builtin_amdgcn_s_sleep(1);
                    }
                }
                __builtin_amdgcn_fence(__ATOMIC_ACQUIRE, "agent"); asm volatile("s_waitcnt vmcnt(0) lgkmcnt(0)" ::: "memory");
            }
            __syncthreads();
        }
    }
}

extern "C" void kernel_launch(void* const* d_in, const int* in_sizes, int n_in, void* d_out, int out_size, void* d_ws, size_t ws_size, hipStream_t stream) {
    static int grid = 0;
    if (grid == 0) {
        if (n_in != 26 || ws_size < WS_TOTAL) { fprintf(stderr, "kernel_launch: needs 26 inputs and >= %zu bytes of workspace (got %d, %zu)\n", (size_t)WS_TOTAL, n_in, ws_size); grid = -1; return; }
        int dev = 0, cus = 0, per_cu = 0;
        (void)hipGetDevice(&dev);
        (void)hipDeviceGetAttribute(&cus, hipDeviceAttributeMultiprocessorCount, dev);
        (void)hipFuncSetAttribute((const void*)mega, hipFuncAttributeMaxDynamicSharedMemorySize, LDS_BYTES);
        (void)hipOccupancyMaxActiveBlocksPerMultiprocessor(&per_cu, (const void*)mega, 512, LDS_BYTES);
        if (per_cu < 1) per_cu = 1;
        grid = cus * per_cu;
        if (grid > 256) grid = 256;
    }
    if (grid < 0) return;
    Args a{};
    for (int i = 0; i < 26; ++i) a.in[i] = (const float*)d_in[i];
    a.out = (float*)d_out; a.ws = (unsigned char*)d_ws;
#ifndef ONE_LAUNCH
#define ONE_LAUNCH 1
#endif
    if (ONE_LAUNCH) {
        a.ph_lo = 0; a.ph_hi = NPHASE;
        void* args[] = {&a};
        (void)hipMemsetAsync((unsigned char*)d_ws + WS_MISC + MI_BAR, 0, 768, stream);
        hipError_t e = hipLaunchCooperativeKernel((const void*)mega, dim3(grid), dim3(512), args, LDS_BYTES, stream);
        if (e != hipSuccess) fprintf(stderr, "cooperative launch failed: %s (grid %d)\n", hipGetErrorString(e), grid);
    } else {
        for (int ph = 0; ph < NPHASE; ++ph) { a.ph_lo = ph; a.ph_hi = ph + 1; hipLaunchKernelGGL(mega, dim3(grid), dim3(512), LDS_BYTES, stream, a); }
    }
}
```

```cpp
#include <hip/hip_runtime.h>
#include <hip/hip_cooperative_groups.h>
#include <cstdio>
namespace cg = cooperative_groups;
#define LAS __attribute__((address_space(3)))
typedef unsigned short bf16_t;
typedef short bf16x8 __attribute__((ext_vector_type(8)));
typedef float f32x4 __attribute__((ext_vector_type(4)));
typedef float f32x2 __attribute__((ext_vector_type(2)));
typedef float f32x16 __attribute__((ext_vector_type(16)));
typedef unsigned u32x4 __attribute__((ext_vector_type(4)));
typedef unsigned u32x2 __attribute__((ext_vector_type(2)));

constexpr int D = 1024, SEQ = 16384, NLAT = 32768, LCTX = 256, NCTX = 512, MROWS = 33280;
constexpr int DFF = 2816, NFF2 = 5632;
constexpr int NAC = 3328, NPB = 1536, NPG = 3072, NMIX = 7936;
constexpr int NMOD = 9216;
constexpr int FRLEN = 2 * SEQ + 128, FRC = SEQ + 63;
constexpr int ZP = ((SEQ + 2048) / 32) * 40;
constexpr int LDS_BYTES = 2 * ZP * 2 + FRLEN * 2 + 256;
constexpr float DN_ALPHA = 1.41421356237f;

constexpr size_t WS_U = 0;
constexpr size_t WS_HC = WS_U + (size_t)MROWS * D * 2;
constexpr size_t WS_W = WS_HC + (size_t)NCTX * D * 4;
constexpr size_t W_IN = 0, W_OUT = W_IN + (size_t)2 * NFF2 * D * 2, W_MIX = W_OUT + (size_t)2 * D * DFF * 2, W_BR = W_MIX + (size_t)NMIX * D * 2, W_O = W_BR + (size_t)3 * D * 512 * 2, W_END = W_O + (size_t)D * D * 2;
constexpr size_t WS_MISC = WS_W + W_END;
constexpr size_t MI_MODS = 0, MI_TAB = MI_MODS + (size_t)2 * 3 * NMOD * 4, MI_L1 = MI_TAB + 256 * 16 * 2 * 4, MI_L1C = MI_L1 + 2 * 1024 * 4, MI_FC = MI_L1C + 1024 * 4,
                 MI_SC = MI_FC + (size_t)256 * 2048 * 4, MI_Z1C = MI_SC + (size_t)NCTX * 1536 * 4, MI_BAR = MI_Z1C + (size_t)NCTX * 512 * 4, MI_BAR2 = MI_BAR + 256, MI_END = MI_BAR2 + 512;
constexpr size_t WS_BIG = WS_MISC + 8388608;
static_assert(MI_END <= 8388608, "misc");
constexpr size_t WS_TOTAL = 536870912;
constexpr size_t BIG_SIZE = WS_TOTAL - WS_BIG;
constexpr size_t YSZ = (size_t)MROWS * 512 * 2;
constexpr size_t B_PAC = 0, B_OB = (size_t)MROWS * NAC * 2, B_ACT = 0, B_PG = 0, B_Y = (size_t)MROWS * NPG * 2, B_PB = 0, B_T = (size_t)MROWS * NPB * 2,
                 B_F = B_T + (size_t)3 * 512 * 2 * SEQ * 2, B_SCR = B_Y, B_QB = B_OB + YSZ, B_DB = B_QB + YSZ, B_YA = BIG_SIZE - 3 * YSZ, B_YB = B_YA + YSZ, B_YC = B_YB + YSZ;
static_assert(B_DB + (size_t)2 * (MROWS / 16) * 512 * 4 <= B_YA && B_OB + YSZ <= B_YA && B_F + (size_t)1024 * FRLEN * 2 <= B_YA && B_Y + (size_t)MROWS * D * 2 <= B_YA && B_SCR + (size_t)256 * 65536 * 4 <= B_YA && (size_t)MROWS * DFF * 2 <= B_Y, "big region");

struct Args { const float* in[26]; float* out; unsigned char* ws; int ph_lo, ph_hi; };

__device__ __forceinline__ float bf2f(unsigned b) { return __uint_as_float(b << 16); }
__device__ __forceinline__ float bflo(unsigned w) { return __uint_as_float(w << 16); }
__device__ __forceinline__ float bfhi(unsigned w) { return __uint_as_float(w & 0xffff0000u); }
typedef __bf16 bf16x2_hw __attribute__((ext_vector_type(2)));
__device__ __forceinline__ unsigned cvt_pk_bf16(float lo, float hi) { const f32x2 v = (f32x2){lo, hi}; return __builtin_bit_cast(unsigned, __builtin_convertvector(v, bf16x2_hw)); }
__device__ __forceinline__ unsigned cvt_pk_bf16_sw(float lo, float hi) { return cvt_pk_bf16(lo, hi); }
__device__ __forceinline__ bf16_t f2bf(float f) { return (bf16_t)(cvt_pk_bf16(f, 0.f) & 0xffffu); }
__device__ __forceinline__ int otid() { int t = threadIdx.x; asm volatile("" : "+v"(t)); return t; }
__device__ __forceinline__ f32x4 zero4() { float z; asm volatile("v_mov_b32 %0, 0" : "=v"(z)); return (f32x4){z, z, z, z}; }
__device__ __forceinline__ float sigm(float x) { return __builtin_amdgcn_rcpf(1.f + __builtin_amdgcn_exp2f(-1.44269504089f * x)); }
__device__ __forceinline__ float silu(float x) { return x * __builtin_amdgcn_rcpf(1.f + __builtin_amdgcn_exp2f(-1.44269504089f * x)); }
__device__ __forceinline__ void unpack8(u32x4 w, float* f) { f[0] = bflo(w.x); f[1] = bfhi(w.x); f[2] = bflo(w.y); f[3] = bfhi(w.y); f[4] = bflo(w.z); f[5] = bfhi(w.z); f[6] = bflo(w.w); f[7] = bfhi(w.w); }
__device__ __forceinline__ u32x4 pack8(const float* f) { u32x4 w; w.x = cvt_pk_bf16(f[0], f[1]); w.y = cvt_pk_bf16(f[2], f[3]); w.z = cvt_pk_bf16(f[4], f[5]); w.w = cvt_pk_bf16(f[6], f[7]); return w; }

namespace pg8 {
constexpr int BM = 256, BK = 64, HALF = 128, HTB = HALF * BK * 2, STAGE_BYTES = 8 * HTB, NXCD = 8, WGM = 8;
__device__ __forceinline__ int lds_byte(int r, int c) { const int st = (r >> 4) * 2 + (c >> 5), rr = r & 15, cc = c & 31, ob = rr * 64 + cc * 2; return st * 1024 + (ob ^ (((ob >> 9) & 1) << 5)); }
__device__ __forceinline__ void stage_rc(int b, int& R, int& C) { const int st = b / 1024, sb = b % 1024, swz = sb ^ (((sb >> 9) & 1) << 5); R = (st >> 1) * 16 + swz / 64; C = (st & 1) * 32 + (swz % 64) / 2; }
__device__ __forceinline__ int perm32(int rho) { const int n = rho >> 4, i = rho & 15; return 8 * (i >> 2) + 4 * n + (i & 3); }
struct Unit { int pm, pn, br; };
struct Gemm { const bf16_t* A; const bf16_t* Bt; size_t sA, sB; int lda, ldb, K;
    __device__ __forceinline__ const char* a(int br) const { return (const char*)A + (size_t)br * sA; }
    __device__ __forceinline__ const char* b(int br) const { return (const char*)Bt + (size_t)br * sB; } };
struct Order {
    int nM, nN, nwg, G, c, nbr;
    __device__ void init(int M, int N, int G_, int c_, int nbr_) { nM = M / BM; nN = N / BM; nwg = nM * nN; G = G_; c = c_; nbr = nbr_; }
    __device__ bool next(int i, Unit& u) const {
        const int ti = i / nbr; u.br = i - ti * nbr;
        const long L = (long)ti * G + c; if (L >= nwg) return false;
        int wgid = (int)L; { const int q = nwg / NXCD, r = nwg % NXCD, xcd = wgid % NXCD, off = wgid / NXCD; wgid = (xcd < r ? xcd * (q + 1) : r * (q + 1) + (xcd - r) * q) + off; }
        const int nig = WGM * nN, gid = wgid / nig, fm = gid * WGM, gsz = (nM - fm) < WGM ? (nM - fm) : WGM;
        u.pm = fm + ((wgid % nig) % gsz); u.pn = (wgid % nig) / gsz; return true;
    }
};
struct EpiAny {
    int kind; bf16_t* O; int ldc; const bf16_t* PG; float* scr;
    __device__ __forceinline__ void operator()(const f32x4 (&acc)[2][2][4][2], const Unit& u, int wr, int wc, int fr, int fq) const {
        asm volatile("" : "+v"(fr), "+v"(fq));
        if (kind == 0) {
            const int row0 = u.pm * BM + wr * 64 + fr, col0 = u.pn * BM + wc * 32 + 8 * fq;
#pragma unroll
            for (int ai = 0; ai < 2; ++ai)
#pragma unroll
                for (int m = 0; m < 4; ++m) { bf16_t* rowp = O + (size_t)(row0 + ai * HALF + m * 16) * ldc + col0;
#pragma unroll
                    for (int bj = 0; bj < 2; ++bj) { const f32x4 v0 = acc[ai][bj][m][0], v1 = acc[ai][bj][m][1];
                        u32x4 w; w.x = cvt_pk_bf16(v0[0], v0[1]); w.y = cvt_pk_bf16(v0[2], v0[3]); w.z = cvt_pk_bf16(v1[0], v1[1]); w.w = cvt_pk_bf16(v1[2], v1[3]);
                        *(u32x4*)(rowp + bj * HALF) = w; } }
        } else if (kind == 1) {
            const int row0 = u.pm * BM + wr * 64 + fr, col0 = u.pn * HALF + wc * 32 + 8 * fq;
#pragma unroll
            for (int ai = 0; ai < 2; ++ai)
#pragma unroll
                for (int m = 0; m < 4; ++m) { bf16_t* rowp = O + (size_t)(row0 + ai * HALF + m * 16) * ldc + col0;
                    const f32x4 a0 = acc[ai][0][m][0], a1 = acc[ai][0][m][1], b0 = acc[ai][1][m][0], b1 = acc[ai][1][m][1];
                    u32x4 w; w.x = cvt_pk_bf16(silu(a0[0]) * b0[0], silu(a0[1]) * b0[1]); w.y = cvt_pk_bf16(silu(a0[2]) * b0[2], silu(a0[3]) * b0[3]);
                    w.z = cvt_pk_bf16(silu(a1[0]) * b1[0], silu(a1[1]) * b1[1]); w.w = cvt_pk_bf16(silu(a1[2]) * b1[2], silu(a1[3]) * b1[3]);
                    *(u32x4*)rowp = w; }
        } else {
            const int rl0 = wr * 64 + fr, cl0 = wc * 32 + 8 * fq;
            const bf16_t* gbase = PG + (size_t)u.pm * BM * ldc + u.pn * BM + u.br * 1024; bf16_t* obase = O + (size_t)u.pm * BM * ldc + u.pn * BM;
#define MERGE_LOOP(BODY) _Pragma("unroll") for (int ai = 0; ai < 2; ++ai) _Pragma("unroll") for (int m = 0; m < 4; ++m) { _Pragma("unroll") for (int bj = 0; bj < 2; ++bj) _Pragma("unroll") for (int n = 0; n < 2; ++n) { \
                const unsigned rl = rl0 + ai * HALF + m * 16, cl = cl0 + bj * HALF + 4 * n; const unsigned go = rl * (unsigned)ldc + cl, so = rl * 256u + cl; \
                const u32x2 gw = *(const u32x2*)(gbase + go); f32x4 v = acc[ai][bj][m][n]; \
                v[0] *= sigm(bflo(gw.x)); v[1] *= sigm(bfhi(gw.x)); v[2] *= sigm(bflo(gw.y)); v[3] *= sigm(bfhi(gw.y)); BODY } __builtin_amdgcn_sched_barrier(0); }
            if (u.br == 0) { MERGE_LOOP({ *(f32x4*)(scr + so) = v; }) }
            else if (u.br == 1) { MERGE_LOOP({ v += *(const f32x4*)(scr + so); *(f32x4*)(scr + so) = v; }) }
            else { MERGE_LOOP({ v += *(const f32x4*)(scr + so); u32x2 w; w.x = cvt_pk_bf16(v[0], v[1]); w.y = cvt_pk_bf16(v[2], v[3]); *(u32x2*)(obase + go) = w; }) }
#undef MERGE_LOOP
        }
    }
};

template <class Epi>
__device__ __forceinline__ void gemm_phase(LAS unsigned char* lds, const Gemm g, const Order& S, const Epi& E) {
    const int tid = otid(), wid = __builtin_amdgcn_readfirstlane(tid >> 6), lane = tid & 63, wr = wid >> 2, wc = wid & 3, fr = lane & 15, fq = lane >> 4;
    const int K = g.K, nt = K / BK;
    unsigned voffA[2], voffB[2];
#pragma unroll
    for (int i = 0; i < 2; ++i) { int R, C; stage_rc(tid * 16 + i * 8192, R, C); const int Rb = (R & ~31) + perm32(R & 31);
        voffA[i] = (unsigned)(R * g.lda + C) * 2u; voffB[i] = (unsigned)(Rb * g.ldb + C) * 2u; }
    const size_t kstep = (size_t)(BK * 2);
    const size_t hstepA = (size_t)HALF * g.lda * 2, hstepB = (size_t)HALF * g.ldb * 2;
    const size_t tstepA = 2 * hstepA, tstepB = 2 * hstepB;
    const unsigned ldsw = (unsigned)wid * 1024u;
    const int aoff = lds_byte(wr * 64 + fr, fq * 8), boff = lds_byte(wc * 32 + fr, fq * 8);
#define PG8_SA(b, h) (((b) * 2 + (h)) * HTB)
#define PG8_SB(b, h) ((4 + (b) * 2 + (h)) * HTB)
#define PG8_STAGE(bufoff, gbase, voff) do { _Pragma("unroll") for (int _i = 0; _i < 2; ++_i) \
        __builtin_amdgcn_global_load_lds((const unsigned*)((const char*)(gbase) + (voff)[_i]), (LAS unsigned*)(lds + (bufoff) + ldsw + _i * 8192), 16, 0, 0); } while (0)
#define PG8_LDA(dst, b, h) do { _Pragma("unroll") for (int m = 0; m < 4; ++m) _Pragma("unroll") for (int k = 0; k < 2; ++k) dst[m][k] = *(const LAS bf16x8*)(lds + PG8_SA(b, h) + aoff + m * 2048 + k * 1024); } while (0)
#define PG8_LDB(dst, b, h) do { _Pragma("unroll") for (int n = 0; n < 2; ++n) _Pragma("unroll") for (int k = 0; k < 2; ++k) dst[n][k] = *(const LAS bf16x8*)(lds + PG8_SB(b, h) + boff + n * 2048 + k * 1024); } while (0)
#define PG8_MMA(ai, bj, At, Bt) do { __builtin_amdgcn_s_setprio(1); _Pragma("unroll") for (int m = 0; m < 4; ++m) _Pragma("unroll") for (int n = 0; n < 2; ++n) _Pragma("unroll") for (int k = 0; k < 2; ++k) \
        acc[ai][bj][m][n] = __builtin_amdgcn_mfma_f32_16x16x32_bf16(Bt[n][k], At[m][k], acc[ai][bj][m][n], 0, 0, 0); __builtin_amdgcn_s_setprio(0); } while (0)
#define PG8_WAIT_V(n) asm volatile("s_waitcnt vmcnt(" #n ")" ::: "memory")
#define PG8_WAIT_L(n) asm volatile("s_waitcnt lgkmcnt(" #n ")" ::: "memory")
#define PG8_BAR __builtin_amdgcn_s_barrier()
#define PG8_SCHED __builtin_amdgcn_sched_barrier(0)
    Unit cur, nxt; int ui = 0;
    if (!S.next(0, cur)) return;
    f32x4 acc[2][2][4][2];
#pragma unroll
    for (int a = 0; a < 2; ++a)
#pragma unroll
        for (int b = 0; b < 2; ++b)
#pragma unroll
            for (int m = 0; m < 4; ++m)
#pragma unroll
                for (int n = 0; n < 2; ++n) acc[a][b][m][n] = (f32x4){0.f, 0.f, 0.f, 0.f};
    bf16x8 At[4][2], B0[2][2], B1[2][2];
    const char* cA = g.a(cur.br) + (size_t)cur.pm * tstepA; const char* cB = g.b(cur.br) + (size_t)cur.pn * tstepB;
    PG8_STAGE(PG8_SB(0, 0), cB, voffB); PG8_STAGE(PG8_SA(0, 0), cA, voffA); PG8_STAGE(PG8_SB(0, 1), cB + hstepB, voffB); PG8_STAGE(PG8_SA(0, 1), cA + hstepA, voffA);
    if (wr == 1) PG8_BAR;
    PG8_WAIT_V(4); PG8_BAR;
    PG8_STAGE(PG8_SB(1, 0), cB + kstep, voffB); PG8_STAGE(PG8_SA(1, 0), cA + kstep, voffA); PG8_STAGE(PG8_SB(1, 1), cB + hstepB + kstep, voffB);
    PG8_WAIT_V(6); PG8_BAR;
    for (;;) {
        const bool has_next = S.next(ui + 1, nxt);
        const char* nA = has_next ? g.a(nxt.br) + (size_t)nxt.pm * tstepA : cA; const char* nB = has_next ? g.b(nxt.br) + (size_t)nxt.pn * tstepB : cB;
        for (int t = 0; t < nt; t += 2) {
            const bool last = (t == nt - 2);
            const char* a1 = cA + (size_t)(t + 1) * kstep;
            const char* a2 = last ? nA : cA + (size_t)(t + 2) * kstep; const char* b2 = last ? nB : cB + (size_t)(t + 2) * kstep;
            const char* a3 = a2 + kstep; const char* b3 = b2 + kstep;
            PG8_LDB(B0, 0, 0); PG8_SCHED; PG8_LDA(At, 0, 0); PG8_STAGE(PG8_SA(1, 1), a1 + hstepA, voffA);
            PG8_WAIT_L(8); PG8_BAR; PG8_WAIT_L(0); PG8_MMA(0, 0, At, B0); PG8_BAR; PG8_SCHED;
            PG8_LDB(B1, 0, 1); PG8_STAGE(PG8_SB(0, 0), b2, voffB);
            PG8_BAR; PG8_WAIT_L(0); PG8_MMA(0, 1, At, B1); PG8_BAR;
            PG8_LDA(At, 0, 1); PG8_STAGE(PG8_SA(0, 0), a2, voffA);
            PG8_BAR; PG8_WAIT_L(0); PG8_MMA(1, 0, At, B0); PG8_BAR; PG8_SCHED;
            PG8_STAGE(PG8_SB(0, 1), b2 + hstepB, voffB);
            PG8_WAIT_V(6); PG8_BAR; PG8_MMA(1, 1, At, B1); PG8_BAR;
            PG8_LDB(B0, 1, 0); PG8_SCHED; PG8_LDA(At, 1, 0); PG8_STAGE(PG8_SA(0, 1), a2 + hstepA, voffA);
            PG8_WAIT_L(8); PG8_BAR; PG8_WAIT_L(0); PG8_MMA(0, 0, At, B0); PG8_BAR; PG8_SCHED;
            PG8_LDB(B1, 1, 1); PG8_STAGE(PG8_SB(1, 0), b3, voffB);
            PG8_BAR; PG8_WAIT_L(0); PG8_MMA(0, 1, At, B1); PG8_BAR;
            PG8_LDA(At, 1, 1); PG8_STAGE(PG8_SA(1, 0), a3, voffA);
            PG8_BAR; PG8_WAIT_L(0); PG8_MMA(1, 0, At, B0); PG8_BAR; PG8_SCHED;
            PG8_STAGE(PG8_SB(1, 1), b3 + hstepB, voffB);
            PG8_WAIT_V(6); PG8_BAR; PG8_MMA(1, 1, At, B1); PG8_BAR;
        }
        E(acc, cur, wr, wc, fr, fq);
        if (!has_next) break;
#pragma unroll
        for (int a = 0; a < 2; ++a)
#pragma unroll
            for (int b = 0; b < 2; ++b)
#pragma unroll
                for (int m = 0; m < 4; ++m)
#pragma unroll
                    for (int n = 0; n < 2; ++n) acc[a][b][m][n] = (f32x4){0.f, 0.f, 0.f, 0.f};
        cur = nxt; cA = nA; cB = nB; ++ui;
    }
    PG8_WAIT_V(0);
    if (wr == 0) PG8_BAR;
    PG8_BAR;
#undef PG8_SA
#undef PG8_SB
#undef PG8_STAGE
#undef PG8_LDA
#undef PG8_LDB
#undef PG8_MMA
#undef PG8_WAIT_V
#undef PG8_WAIT_L
#undef PG8_BAR
#undef PG8_SCHED
}
}

struct WTile { const float* s; int lds_; bf16_t* d; int ldd; };
__device__ __forceinline__ WTile wconv_decode(const Args& a, int layer, int it) {
    unsigned char* W = a.ws + WS_W;
    const float* w_in = a.in[8] + (size_t)layer * 2 * D * NFF2; const float* w_out = a.in[9] + (size_t)layer * 2 * DFF * D;
    const float* w_mix = a.in[10] + (size_t)layer * D * NMIX; const float* w_br = a.in[24] + (size_t)layer * 3 * 512 * D; const float* w_o = a.in[25] + (size_t)layer * D * D;
    WTile t;
    if (it < 2816) { const int f = it / 1408, r = it % 1408, kt = r / 88, ntile = r % 88, n0 = ntile * 64, tq = n0 >> 8, rr = n0 & 255;
        const int c0 = rr < 128 ? 128 * tq + rr : DFF + 128 * tq + (rr - 128);
        t.s = w_in + (size_t)f * D * NFF2 + (size_t)kt * 64 * NFF2 + c0; t.lds_ = NFF2; t.d = (bf16_t*)(W + W_IN) + (size_t)(1 - f) * NFF2 * D + (size_t)n0 * D + kt * 64; t.ldd = D; }
    else if (it < 4224) { const int j = it - 2816, f = j / 704, r = j % 704, kt = r / 16, ntile = r % 16;
        t.s = w_out + (size_t)f * DFF * D + (size_t)kt * 64 * D + ntile * 64; t.lds_ = D; t.d = (bf16_t*)(W + W_OUT) + (size_t)(1 - f) * D * DFF + (size_t)ntile * 64 * DFF + kt * 64; t.ldd = DFF; }
    else if (it < 6208) { const int j = it - 4224, kt = j / 124, ntile = j % 124, n0 = ntile * 64;
        const int c0 = n0 < 2560 ? n0 : (n0 < 3328 ? 4096 + (n0 - 2560) : (n0 < 4864 ? 2560 + (n0 - 3328) : n0));
        t.s = w_mix + (size_t)kt * 64 * NMIX + c0; t.lds_ = NMIX; t.d = (bf16_t*)(W + W_MIX) + (size_t)n0 * D + kt * 64; t.ldd = D; }
    else if (it < 6592) { const int j = it - 6208, br = j / 128, r = j % 128, kt = r / 16, ntile = r % 16;
        t.s = w_br + (size_t)br * 512 * D + (size_t)kt * 64 * D + ntile * 64; t.lds_ = D; t.d = (bf16_t*)(W + W_BR) + (size_t)br * D * 512 + (size_t)ntile * 64 * 512 + kt * 64; t.ldd = 512; }
    else { const int j = it - 6592, kt = j / 16, ntile = j % 16;
        t.s = w_o + (size_t)kt * 64 * D + ntile * 64; t.lds_ = D; t.d = (bf16_t*)(W + W_O) + (size_t)ntile * 64 * D + kt * 64; t.ldd = D; }
    return t;
}
__device__ __forceinline__ void phase_wconv(LAS unsigned char* L, const Args& a, int layer, int bid, int G) {
    LAS float* tl = (LAS float*)L;
    const int tid = otid(); const int r0 = tid >> 4, c4 = (tid & 15) * 4;
    int it = bid;
    if (it >= 6848) return;
    WTile cur = wconv_decode(a, layer, it);
    f32x4 v0 = *(const f32x4*)(cur.s + (size_t)r0 * cur.lds_ + c4), v1 = *(const f32x4*)(cur.s + (size_t)(r0 + 32) * cur.lds_ + c4);
    for (; it < 6848; it += G) {
        __syncthreads();
        tl[r0 * 65 + c4] = v0[0]; tl[r0 * 65 + c4 + 1] = v0[1]; tl[r0 * 65 + c4 + 2] = v0[2]; tl[r0 * 65 + c4 + 3] = v0[3];
        tl[(r0 + 32) * 65 + c4] = v1[0]; tl[(r0 + 32) * 65 + c4 + 1] = v1[1]; tl[(r0 + 32) * 65 + c4 + 2] = v1[2]; tl[(r0 + 32) * 65 + c4 + 3] = v1[3];
        __syncthreads();
        WTile nxt = cur;
        if (it + G < 6848) { nxt = wconv_decode(a, layer, it + G); v0 = *(const f32x4*)(nxt.s + (size_t)r0 * nxt.lds_ + c4); v1 = *(const f32x4*)(nxt.s + (size_t)(r0 + 32) * nxt.lds_ + c4); }
        { const int n = tid >> 3, kc = (tid & 7) * 8; float f[8];
#pragma unroll
          for (int j = 0; j < 8; ++j) f[j] = tl[(kc + j) * 65 + n];
          *(u32x4*)(cur.d + (size_t)n * cur.ldd + kc) = pack8(f); }
        cur = nxt;
    }
    __syncthreads();
}

__device__ __forceinline__ void phase_mods(LAS unsigned char* L, const Args& a, int bid, int G) {
    LAS float* sc = (LAS float*)L;
    LAS float* red = sc + 3 * 1024;
    const int tid = otid();
    float* mods = (float*)(a.ws + WS_MISC + MI_MODS);
    for (int e = tid; e < 3 * 1024; e += 512) { const int v = e >> 10, k = e & 1023; const float x = v < 2 ? a.in[1][v * 1024 + k] : a.in[3][k]; sc[e] = silu(x); }
    __syncthreads();
    for (int it = bid; it < 288; it += G) {
        const int layer = it / 144, n = (it % 144) * 64 + (tid & 63), kq = tid >> 6;
        const float* w = a.in[4] + (size_t)layer * D * NMOD + n;
        float s0 = 0.f, s1 = 0.f, s2 = 0.f;
#pragma unroll 8
        for (int k = kq * 128; k < kq * 128 + 128; ++k) { const float wv = w[(size_t)k * NMOD]; s0 += sc[k] * wv; s1 += sc[1024 + k] * wv; s2 += sc[2048 + k] * wv; }
        red[(kq * 3 + 0) * 64 + (tid & 63)] = s0; red[(kq * 3 + 1) * 64 + (tid & 63)] = s1; red[(kq * 3 + 2) * 64 + (tid & 63)] = s2;
        __syncthreads();
        if (tid < 192) { const int v = tid >> 6, c = tid & 63; const int nn = (it % 144) * 64 + c; float s = 0.f;
#pragma unroll
            for (int q = 0; q < 8; ++q) s += red[(q * 3 + v) * 64 + c];
            mods[((size_t)layer * 3 + v) * NMOD + nn] = s + a.in[5][(size_t)layer * NMOD + nn]; }
        __syncthreads();
    }
    const int gt = bid * 512 + tid;
    if (gt < 4096) { const int pos = gt >> 4, f = gt & 15; const float inv = __builtin_amdgcn_exp2f(-(float)f * (13.287712379549449f / 16.0f)); const float ang = (float)pos * inv;
        float* tab = (float*)(a.ws + WS_MISC + MI_TAB); tab[gt * 2] = __cosf(ang); tab[gt * 2 + 1] = __sinf(ang); }
    if (gt < 3072) ((float*)(a.ws + WS_MISC + MI_L1))[gt] = 0.f;
}

struct LnP { const float* hs_lat; const float* hs_ctx; float* hd_lat; float* hd_ctx; const bf16_t* y; int ldy; const float* mods; int gi; float coef; const float* g; const float* b; const float* mods_u; int si; bf16_t* u; int rows; int mode; };
__device__ __forceinline__ void phase_ln(const LnP& p, int bid, int G) {
    const int tid_ = otid(); const int lane = tid_ & 63, wv = tid_ >> 6;
    const int nw = G * 8, wid = bid * 8 + wv;
    const int per = (MROWS + nw - 1) / nw;
    const int r0 = wid * per, r1 = min(p.rows, r0 + per);
    if (r0 >= r1) return;
    f32x4 t[4], tn[4]; u32x2 yw[4], ywn[4];
#define LN_LOAD(R, T_, Y_) { const int rr = (R); const float* hs = rr < NLAT ? p.hs_lat + (size_t)rr * D : p.hs_ctx + (size_t)(rr - NLAT) * D; \
        _Pragma("unroll") for (int i = 0; i < 4; ++i) { T_[i] = *(const f32x4*)(hs + 4 * lane + 256 * i); Y_[i] = p.mode != 0 ? *(const u32x2*)(p.y + (size_t)rr * p.ldy + 4 * lane + 256 * i) : *(const u32x2*)(hs + 4 * lane + 256 * i); } }
    LN_LOAD(r0, t, yw)
    for (int r = r0; r < r1; ++r) {
        if (r + 1 < r1) LN_LOAD(r + 1, tn, ywn)
        const int v = r < SEQ ? 0 : (r < NLAT ? 1 : 2);
        if (p.mode != 0) {
            const float* gate = p.mods + (size_t)v * NMOD + p.gi * 1024;
            float s = 0.f;
#pragma unroll
            for (int i = 0; i < 4; ++i) { const f32x4 gv = *(const f32x4*)(gate + 4 * lane + 256 * i);
                t[i][0] = DN_ALPHA * t[i][0] + p.coef * gv[0] * bflo(yw[i].x); t[i][1] = DN_ALPHA * t[i][1] + p.coef * gv[1] * bfhi(yw[i].x);
                t[i][2] = DN_ALPHA * t[i][2] + p.coef * gv[2] * bflo(yw[i].y); t[i][3] = DN_ALPHA * t[i][3] + p.coef * gv[3] * bfhi(yw[i].y);
                s += (t[i][0] + t[i][1]) + (t[i][2] + t[i][3]); }
#pragma unroll
            for (int o = 32; o >= 1; o >>= 1) s += __shfl_xor(s, o);
            const float mean = s * (1.0f / 1024.0f); float q = 0.f;
#pragma unroll
            for (int i = 0; i < 4; ++i) { const f32x4 d = t[i] - mean; q += (d[0] * d[0] + d[1] * d[1]) + (d[2] * d[2] + d[3] * d[3]); }
#pragma unroll
            for (int o = 32; o >= 1; o >>= 1) q += __shfl_xor(q, o);
            const float rstd = rsqrtf(q * (1.0f / 1024.0f) + 1e-5f);
            float* hd = r < NLAT ? p.hd_lat + (size_t)r * D : p.hd_ctx + (size_t)(r - NLAT) * D;
#pragma unroll
            for (int i = 0; i < 4; ++i) { const int c = 4 * lane + 256 * i; const f32x4 gv = *(const f32x4*)(p.g + c), bv = *(const f32x4*)(p.b + c);
                t[i] = (t[i] - mean) * rstd * gv + bv; *(f32x4*)(hd + c) = t[i]; }
        }
        if (p.mode != 2) {
            const float* sh = p.mods_u + (size_t)v * NMOD + p.si * 1024; const float* scl = sh + 1024;
#pragma unroll
            for (int i = 0; i < 4; ++i) { const int c = 4 * lane + 256 * i; const f32x4 sv = *(const f32x4*)(sh + c), cv = *(const f32x4*)(scl + c);
                const f32x4 o = t[i] * (1.0f + cv) + sv; u32x2 w; w.x = cvt_pk_bf16(o[0], o[1]); w.y = cvt_pk_bf16(o[2], o[3]);
                *(u32x2*)(p.u + (size_t)r * D + c) = w; }
        }
#pragma unroll
        for (int i = 0; i < 4; ++i) { t[i] = tn[i]; yw[i] = ywn[i]; }
    }
#undef LN_LOAD
}

__device__ __forceinline__ int hgrn_row(int s, int dir, int b) {
    if (s < LCTX) { const int c = dir ? (LCTX - 1 - s) : s; return NLAT + b * LCTX + c; }
    const int t = s - LCTX; const int pos = dir ? (SEQ - 1 - t) : t; return b * SEQ + pos;
}
typedef float f32x4v __attribute__((ext_vector_type(4)));
constexpr int NGRP = MROWS / 16;
__device__ __forceinline__ void hgrn_prepass(bf16_t* PAC, bf16_t* QB, float* DB, const float* lbsrc, int layer, int bid, int G) {
    const int col = otid();
    float lbf = 0.f, lbb = 0.f;
    if (layer == 1) { const float a0 = lbsrc[(0 * 2 + 0) * 512 + col], a1 = lbsrc[(1 * 2 + 0) * 512 + col], c0 = lbsrc[(0 * 2 + 1) * 512 + col], c1 = lbsrc[(1 * 2 + 1) * 512 + col];
        lbf = 1.f / (1.f + __expf(a0 - a1)); lbb = 1.f / (1.f + __expf(c0 - c1)); }
    for (int g = bid; g < NGRP; g += G) {
        bf16_t* base = PAC + (size_t)g * 16 * NAC;
        float q[16], ff[16], fb[16];
#pragma unroll
        for (int t = 0; t < 16; ++t) { const bf16_t* rp = base + (size_t)t * NAC; q[t] = bf2f(rp[col]); ff[t] = lbf + (1.f - lbf) * sigm(bf2f(rp[1536 + col])); fb[t] = lbb + (1.f - lbb) * sigm(bf2f(rp[2048 + col])); }
        float p = 1.f;
#pragma unroll
        for (int t = 0; t < 16; ++t) { p *= ff[t]; const float E = fmaxf(p, 1e-30f); bf16_t* rp = base + (size_t)t * NAC; rp[col] = f2bf(q[t] * E); rp[1536 + col] = f2bf((1.f - ff[t]) * __builtin_amdgcn_rcpf(E)); }
        DB[(size_t)g * 512 + col] = p;
        p = 1.f;
#pragma unroll
        for (int t = 15; t >= 0; --t) { p *= fb[t]; const float E = fmaxf(p, 1e-30f); bf16_t* rp = base + (size_t)t * NAC; QB[((size_t)g * 16 + t) * 512 + col] = f2bf(q[t] * E); rp[2048 + col] = f2bf((1.f - fb[t]) * __builtin_amdgcn_rcpf(E)); }
        DB[((size_t)NGRP + g) * 512 + col] = p;
    }
}
__device__ __forceinline__ void hgrn_scan_item(LAS unsigned char* L, int item, const bf16_t* PAC, const bf16_t* QB, const float* DB, bf16_t* OF, bf16_t* OB) {
    const int vs = item & 7, h = (item >> 3) & 3, b = (item >> 5) & 1, dir = item >> 6;
    const int tid = otid(), wave = tid >> 6, lane = tid & 63, l15 = lane & 15, g4 = lane >> 4;
    LAS bf16_t* Qs = (LAS bf16_t*)L;
    LAS bf16_t* Ks = Qs + 64 * 136;
    LAS bf16_t* KT = Ks + 64 * 136;
    LAS bf16_t* VT = KT + 4 * 128 * 40;
    LAS bf16_t* As = VT + 4 * 16 * 40;
    LAS float* Ds = (LAS float*)(As + 4 * 16 * 40);
    LAS float* O2s = Ds + 4 * 128;
    LAS float* Pp = O2s + 4 * 256;
    __syncthreads();
    for (int e2 = tid; e2 < (4 * 128 * 40 + 4 * 16 * 40 + 4 * 16 * 40) / 2; e2 += 512) ((LAS unsigned*)KT)[e2] = 0u;
    __syncthreads();
    f32x4v accS = (f32x4v){0.f, 0.f, 0.f, 0.f};
    bf16_t* Od = dir ? OB : OF;
    const bf16_t* Qsrc = dir ? QB : PAC; const int qld = dir ? 512 : NAC;
    const int kcol = (dir ? 2048 : 1536) + h * 128, qcol = h * 128, icol = 512 + h * 128 + vs * 16;
    const int st = tid >> 3, kc = (tid & 7) * 16;
    constexpr int NSTEP = LCTX + SEQ;
    u32x4 pq0A, pq1A, pk0A, pk1A, piA = (u32x4){0, 0, 0, 0}, pq0B, pq1B, pk0B, pk1B, piB = (u32x4){0, 0, 0, 0}, pq0C, pq1C, pk0C, pk1C, piC = (u32x4){0, 0, 0, 0}, pq0D, pq1D, pk0D, pk1D, piD = (u32x4){0, 0, 0, 0}; float pdA = 0.f, pdB = 0.f, pdC = 0.f, pdD = 0.f;
#define HG_LOAD(S0_, X) { const int row = hgrn_row((S0_) + st, dir, b); const bf16_t* qp = Qsrc + (size_t)row * qld + qcol + kc; const bf16_t* kp = PAC + (size_t)row * NAC + kcol + kc; \
      pq0##X = *(const u32x4*)qp; pq1##X = *(const u32x4*)(qp + 8); pk0##X = *(const u32x4*)kp; pk1##X = *(const u32x4*)(kp + 8); \
      if (tid < 128) { const int row2 = hgrn_row((S0_) + (tid >> 1), dir, b); pi##X = *(const u32x4*)(PAC + (size_t)row2 * NAC + icol + (tid & 1) * 8); } \
      { const int rowc = hgrn_row((S0_) + (tid >> 7) * 16, dir, b); pd##X = DB[((size_t)dir * NGRP + (rowc >> 4)) * 512 + h * 128 + (tid & 127)]; } }
    HG_LOAD(0, A) HG_LOAD(64, B) HG_LOAD(128, C) HG_LOAD(192, D)
    for (int s0 = 0; s0 < NSTEP; s0 += 256) {
      {
        { const int c = st >> 4, sl = st & 15;
          *(LAS u32x4*)(Qs + st * 136 + kc) = pq0A; *(LAS u32x4*)(Qs + st * 136 + kc + 8) = pq1A; *(LAS u32x4*)(Ks + st * 136 + kc) = pk0A; *(LAS u32x4*)(Ks + st * 136 + kc + 8) = pk1A;
          Ds[tid] = pdA; }
        if (tid < 128) { const unsigned vw[4] = {piA.x, piA.y, piA.z, piA.w}; const int tk = tid >> 1, c = tk >> 4, sl = tk & 15;
#pragma unroll
            for (int e = 0; e < 4; ++e) { VT[(c * 16 + (tid & 1) * 8 + 2 * e) * 40 + sl] = (bf16_t)(vw[e] & 0xffffu); VT[(c * 16 + (tid & 1) * 8 + 2 * e + 1) * 40 + sl] = (bf16_t)(vw[e] >> 16); } }
        __syncthreads();
        if (s0 + 0 + 256 < NSTEP) HG_LOAD(s0 + 0 + 256, A)
        if (wave >= 1 && wave <= 4) { const int c = wave - 1;
            f32x4v sc = (f32x4v){0.f, 0.f, 0.f, 0.f};
#pragma unroll
            for (int ks = 0; ks < 4; ++ks) { const bf16x8 af = *(const LAS bf16x8*)(Qs + (c * 16 + l15) * 136 + 32 * ks + 8 * g4), kfv = *(const LAS bf16x8*)(Ks + (c * 16 + l15) * 136 + 32 * ks + 8 * g4);
                sc = __builtin_amdgcn_mfma_f32_16x16x32_bf16(af, kfv, sc, 0, 0, 0); }
#pragma unroll
            for (int rg = 0; rg < 4; ++rg) { const int t = 4 * g4 + rg; As[(c * 16 + t) * 40 + l15] = f2bf(l15 <= t ? sc[rg] : 0.f); }
            asm volatile("s_waitcnt lgkmcnt(0)" ::: "memory");
            const bf16x8 af2 = *(const LAS bf16x8*)(As + (c * 16 + l15) * 40 + 8 * g4), vfv = *(const LAS bf16x8*)(VT + (c * 16 + l15) * 40 + 8 * g4);
            f32x4v o2 = (f32x4v){0.f, 0.f, 0.f, 0.f}; o2 = __builtin_amdgcn_mfma_f32_16x16x32_bf16(af2, vfv, o2, 0, 0, 0);
#pragma unroll
            for (int rg = 0; rg < 4; ++rg) O2s[(c * 16 + 4 * g4 + rg) * 16 + l15] = o2[rg];
        }
        __syncthreads();
#pragma unroll 1
        for (int c = 0; c < 4; ++c) {
            { const u32x2 qa = *(const LAS u32x2*)(Qs + (c * 16 + l15) * 136 + 16 * wave + 4 * g4);
              const bf16x8 af = __builtin_bit_cast(bf16x8, ((u32x4){qa.x, qa.y, 0u, 0u})), sfv = __builtin_bit_cast(bf16x8, ((u32x4){cvt_pk_bf16_sw(accS[0], accS[1]), cvt_pk_bf16_sw(accS[2], accS[3]), 0u, 0u}));
              f32x4v po = (f32x4v){0.f, 0.f, 0.f, 0.f}; po = __builtin_amdgcn_mfma_f32_16x16x32_bf16(af, sfv, po, 0, 0, 0);
#pragma unroll
              for (int rg = 0; rg < 4; ++rg) Pp[((c * 8 + wave) * 16 + 4 * g4 + rg) * 16 + l15] = po[rg]; }
            { const LAS bf16_t* kg_ = Ks + (c * 16 + 8 * (g4 & 1)) * 136 + 16 * wave + l15;
              const unsigned m_ = g4 < 2 ? 0xffffffffu : 0u;
              const u32x4 aw_ = (u32x4){((unsigned)kg_[0] | ((unsigned)kg_[136] << 16)) & m_, ((unsigned)kg_[2 * 136] | ((unsigned)kg_[3 * 136] << 16)) & m_, ((unsigned)kg_[4 * 136] | ((unsigned)kg_[5 * 136] << 16)) & m_, ((unsigned)kg_[6 * 136] | ((unsigned)kg_[7 * 136] << 16)) & m_};
              const bf16x8 af = __builtin_bit_cast(bf16x8, aw_), bfv = *(const LAS bf16x8*)(VT + (c * 16 + l15) * 40 + 8 * g4);
              const f32x4v dv = *(const LAS f32x4v*)(Ds + c * 128 + 16 * wave + 4 * g4);
              accS = __builtin_amdgcn_mfma_f32_16x16x32_bf16(af, bfv, accS, 0, 0, 0); accS = accS * dv; }
        }
        __syncthreads();
        { const int c = tid >> 7, t = (tid >> 3) & 15, v2 = (tid & 7) * 2; f32x2 sum = *(const LAS f32x2*)(O2s + (c * 16 + t) * 16 + v2);
#pragma unroll
          for (int w = 0; w < 8; ++w) sum += *(const LAS f32x2*)(Pp + ((c * 8 + w) * 16 + t) * 16 + v2);
          const int row = hgrn_row((s0 + 0) + c * 16 + t, dir, b); *(unsigned*)(Od + (size_t)row * 512 + h * 128 + vs * 16 + v2) = cvt_pk_bf16(sum[0], sum[1]); }

      }
      {
        { const int c = st >> 4, sl = st & 15;
          *(LAS u32x4*)(Qs + st * 136 + kc) = pq0B; *(LAS u32x4*)(Qs + st * 136 + kc + 8) = pq1B; *(LAS u32x4*)(Ks + st * 136 + kc) = pk0B; *(LAS u32x4*)(Ks + st * 136 + kc + 8) = pk1B;
          Ds[tid] = pdB; }
        if (tid < 128) { const unsigned vw[4] = {piB.x, piB.y, piB.z, piB.w}; const int tk = tid >> 1, c = tk >> 4, sl = tk & 15;
#pragma unroll
            for (int e = 0; e < 4; ++e) { VT[(c * 16 + (tid & 1) * 8 + 2 * e) * 40 + sl] = (bf16_t)(vw[e] & 0xffffu); VT[(c * 16 + (tid & 1) * 8 + 2 * e + 1) * 40 + sl] = (bf16_t)(vw[e] >> 16); } }
        __syncthreads();
        if (s0 + 64 + 256 < NSTEP) HG_LOAD(s0 + 64 + 256, B)
        if (wave >= 1 && wave <= 4) { const int c = wave - 1;
            f32x4v sc = (f32x4v){0.f, 0.f, 0.f, 0.f};
#pragma unroll
            for (int ks = 0; ks < 4; ++ks) { const bf16x8 af = *(const LAS bf16x8*)(Qs + (c * 16 + l15) * 136 + 32 * ks + 8 * g4), kfv = *(const LAS bf16x8*)(Ks + (c * 16 + l15) * 136 + 32 * ks + 8 * g4);
                sc = __builtin_amdgcn_mfma_f32_16x16x32_bf16(af, kfv, sc, 0, 0, 0); }
#pragma unroll
            for (int rg = 0; rg < 4; ++rg) { const int t = 4 * g4 + rg; As[(c * 16 + t) * 40 + l15] = f2bf(l15 <= t ? sc[rg] : 0.f); }
            asm volatile("s_waitcnt lgkmcnt(0)" ::: "memory");
            const bf16x8 af2 = *(const LAS bf16x8*)(As + (c * 16 + l15) * 40 + 8 * g4), vfv = *(const LAS bf16x8*)(VT + (c * 16 + l15) * 40 + 8 * g4);
            f32x4v o2 = (f32x4v){0.f, 0.f, 0.f, 0.f}; o2 = __builtin_amdgcn_mfma_f32_16x16x32_bf16(af2, vfv, o2, 0, 0, 0);
#pragma unroll
            for (int rg = 0; rg < 4; ++rg) O2s[(c * 16 + 4 * g4 + rg) * 16 + l15] = o2[rg];
        }
        __syncthreads();
#pragma unroll 1
        for (int c = 0; c < 4; ++c) {
            { const u32x2 qa = *(const LAS u32x2*)(Qs + (c * 16 + l15) * 136 + 16 * wave + 4 * g4);
              const bf16x8 af = __builtin_bit_cast(bf16x8, ((u32x4){qa.x, qa.y, 0u, 0u})), sfv = __builtin_bit_cast(bf16x8, ((u32x4){cvt_pk_bf16_sw(accS[0], accS[1]), cvt_pk_bf16_sw(accS[2], accS[3]), 0u, 0u}));
              f32x4v po = (f32x4v){0.f, 0.f, 0.f, 0.f}; po = __builtin_amdgcn_mfma_f32_16x16x32_bf16(af, sfv, po, 0, 0, 0);
#pragma unroll
              for (int rg = 0; rg < 4; ++rg) Pp[((c * 8 + wave) * 16 + 4 * g4 + rg) * 16 + l15] = po[rg]; }
            { const LAS bf16_t* kg_ = Ks + (c * 16 + 8 * (g4 & 1)) * 136 + 16 * wave + l15;
              const unsigned m_ = g4 < 2 ? 0xffffffffu : 0u;
              const u32x4 aw_ = (u32x4){((unsigned)kg_[0] | ((unsigned)kg_[136] << 16)) & m_, ((unsigned)kg_[2 * 136] | ((unsigned)kg_[3 * 136] << 16)) & m_, ((unsigned)kg_[4 * 136] | ((unsigned)kg_[5 * 136] << 16)) & m_, ((unsigned)kg_[6 * 136] | ((unsigned)kg_[7 * 136] << 16)) & m_};
              const bf16x8 af = __builtin_bit_cast(bf16x8, aw_), bfv = *(const LAS bf16x8*)(VT + (c * 16 + l15) * 40 + 8 * g4);
              const f32x4v dv = *(const LAS f32x4v*)(Ds + c * 128 + 16 * wave + 4 * g4);
              accS = __builtin_amdgcn_mfma_f32_16x16x32_bf16(af, bfv, accS, 0, 0, 0); accS = accS * dv; }
        }
        __syncthreads();
        { const int c = tid >> 7, t = (tid >> 3) & 15, v2 = (tid & 7) * 2; f32x2 sum = *(const LAS f32x2*)(O2s + (c * 16 + t) * 16 + v2);
#pragma unroll
          for (int w = 0; w < 8; ++w) sum += *(const LAS f32x2*)(Pp + ((c * 8 + w) * 16 + t) * 16 + v2);
          const int row = hgrn_row((s0 + 64) + c * 16 + t, dir, b); *(unsigned*)(Od + (size_t)row * 512 + h * 128 + vs * 16 + v2) = cvt_pk_bf16(sum[0], sum[1]); }

      }
      {
        { const int c = st >> 4, sl = st & 15;
          *(LAS u32x4*)(Qs + st * 136 + kc) = pq0C; *(LAS u32x4*)(Qs + st * 136 + kc + 8) = pq1C; *(LAS u32x4*)(Ks + st * 136 + kc) = pk0C; *(LAS u32x4*)(Ks + st * 136 + kc + 8) = pk1C;
          Ds[tid] = pdC; }
        if (tid < 128) { const unsigned vw[4] = {piC.x, piC.y, piC.z, piC.w}; const int tk = tid >> 1, c = tk >> 4, sl = tk & 15;
#pragma unroll
            for (int e = 0; e < 4; ++e) { VT[(c * 16 + (tid & 1) * 8 + 2 * e) * 40 + sl] = (bf16_t)(vw[e] & 0xffffu); VT[(c * 16 + (tid & 1) * 8 + 2 * e + 1) * 40 + sl] = (bf16_t)(vw[e] >> 16); } }
        __syncthreads();
        if (s0 + 128 + 256 < NSTEP) HG_LOAD(s0 + 128 + 256, C)
        if (wave >= 1 && wave <= 4) { const int c = wave - 1;
            f32x4v sc = (f32x4v){0.f, 0.f, 0.f, 0.f};
#pragma unroll
            for (int ks = 0; ks < 4; ++ks) { const bf16x8 af = *(const LAS bf16x8*)(Qs + (c * 16 + l15) * 136 + 32 * ks + 8 * g4), kfv = *(const LAS bf16x8*)(Ks + (c * 16 + l15) * 136 + 32 * ks + 8 * g4);
                sc = __builtin_amdgcn_mfma_f32_16x16x32_bf16(af, kfv, sc, 0, 0, 0); }
#pragma unroll
            for (int rg = 0; rg < 4; ++rg) { const int t = 4 * g4 + rg; As[(c * 16 + t) * 40 + l15] = f2bf(l15 <= t ? sc[rg] : 0.f); }
            asm volatile("s_waitcnt lgkmcnt(0)" ::: "memory");
            const bf16x8 af2 = *(const LAS bf16x8*)(As + (c * 16 + l15) * 40 + 8 * g4), vfv = *(const LAS bf16x8*)(VT + (c * 16 + l15) * 40 + 8 * g4);
            f32x4v o2 = (f32x4v){0.f, 0.f, 0.f, 0.f}; o2 = __builtin_amdgcn_mfma_f32_16x16x32_bf16(af2, vfv, o2, 0, 0, 0);
#pragma unroll
            for (int rg = 0; rg < 4; ++rg) O2s[(c * 16 + 4 * g4 + rg) * 16 + l15] = o2[rg];
        }
        __syncthreads();
#pragma unroll 1
        for (int c = 0; c < 4; ++c) {
            { const u32x2 qa = *(const LAS u32x2*)(Qs + (c * 16 + l15) * 136 + 16 * wave + 4 * g4);
              const bf16x8 af = __builtin_bit_cast(bf16x8, ((u32x4){qa.x, qa.y, 0u, 0u})), sfv = __builtin_bit_cast(bf16x8, ((u32x4){cvt_pk_bf16_sw(accS[0], accS[1]), cvt_pk_bf16_sw(accS[2], accS[3]), 0u, 0u}));
              f32x4v po = (f32x4v){0.f, 0.f, 0.f, 0.f}; po = __builtin_amdgcn_mfma_f32_16x16x32_bf16(af, sfv, po, 0, 0, 0);
#pragma unroll
              for (int rg = 0; rg < 4; ++rg) Pp[((c * 8 + wave) * 16 + 4 * g4 + rg) * 16 + l15] = po[rg]; }
            { const LAS bf16_t* kg_ = Ks + (c * 16 + 8 * (g4 & 1)) * 136 + 16 * wave + l15;
              const unsigned m_ = g4 < 2 ? 0xffffffffu : 0u;
              const u32x4 aw_ = (u32x4){((unsigned)kg_[0] | ((unsigned)kg_[136] << 16)) & m_, ((unsigned)kg_[2 * 136] | ((unsigned)kg_[3 * 136] << 16)) & m_, ((unsigned)kg_[4 * 136] | ((unsigned)kg_[5 * 136] << 16)) & m_, ((unsigned)kg_[6 * 136] | ((unsigned)kg_[7 * 136] << 16)) & m_};
              const bf16x8 af = __builtin_bit_cast(bf16x8, aw_), bfv = *(const LAS bf16x8*)(VT + (c * 16 + l15) * 40 + 8 * g4);
              const f32x4v dv = *(const LAS f32x4v*)(Ds + c * 128 + 16 * wave + 4 * g4);
              accS = __builtin_amdgcn_mfma_f32_16x16x32_bf16(af, bfv, accS, 0, 0, 0); accS = accS * dv; }
        }
        __syncthreads();
        { const int c = tid >> 7, t = (tid >> 3) & 15, v2 = (tid & 7) * 2; f32x2 sum = *(const LAS f32x2*)(O2s + (c * 16 + t) * 16 + v2);
#pragma unroll
          for (int w = 0; w < 8; ++w) sum += *(const LAS f32x2*)(Pp + ((c * 8 + w) * 16 + t) * 16 + v2);
          const int row = hgrn_row((s0 + 128) + c * 16 + t, dir, b); *(unsigned*)(Od + (size_t)row * 512 + h * 128 + vs * 16 + v2) = cvt_pk_bf16(sum[0], sum[1]); }

      }
      {
        { const int c = st >> 4, sl = st & 15;
          *(LAS u32x4*)(Qs + st * 136 + kc) = pq0D; *(LAS u32x4*)(Qs + st * 136 + kc + 8) = pq1D; *(LAS u32x4*)(Ks + st * 136 + kc) = pk0D; *(LAS u32x4*)(Ks + st * 136 + kc + 8) = pk1D;
          Ds[tid] = pdD; }
        if (tid < 128) { const unsigned vw[4] = {piD.x, piD.y, piD.z, piD.w}; const int tk = tid >> 1, c = tk >> 4, sl = tk & 15;
#pragma unroll
            for (int e = 0; e < 4; ++e) { VT[(c * 16 + (tid & 1) * 8 + 2 * e) * 40 + sl] = (bf16_t)(vw[e] & 0xffffu); VT[(c * 16 + (tid & 1) * 8 + 2 * e + 1) * 40 + sl] = (bf16_t)(vw[e] >> 16); } }
        __syncthreads();
        if (s0 + 192 + 256 < NSTEP) HG_LOAD(s0 + 192 + 256, D)
        if (wave >= 1 && wave <= 4) { const int c = wave - 1;
            f32x4v sc = (f32x4v){0.f, 0.f, 0.f, 0.f};
#pragma unroll
            for (int ks = 0; ks < 4; ++ks) { const bf16x8 af = *(const LAS bf16x8*)(Qs + (c * 16 + l15) * 136 + 32 * ks + 8 * g4), kfv = *(const LAS bf16x8*)(Ks + (c * 16 + l15) * 136 + 32 * ks + 8 * g4);
                sc = __builtin_amdgcn_mfma_f32_16x16x32_bf16(af, kfv, sc, 0, 0, 0); }
#pragma unroll
            for (int rg = 0; rg < 4; ++rg) { const int t = 4 * g4 + rg; As[(c * 16 + t) * 40 + l15] = f2bf(l15 <= t ? sc[rg] : 0.f); }
            asm volatile("s_waitcnt lgkmcnt(0)" ::: "memory");
            const bf16x8 af2 = *(const LAS bf16x8*)(As + (c * 16 + l15) * 40 + 8 * g4), vfv = *(const LAS bf16x8*)(VT + (c * 16 + l15) * 40 + 8 * g4);
            f32x4v o2 = (f32x4v){0.f, 0.f, 0.f, 0.f}; o2 = __builtin_amdgcn_mfma_f32_16x16x32_bf16(af2, vfv, o2, 0, 0, 0);
#pragma unroll
            for (int rg = 0; rg < 4; ++rg) O2s[(c * 16 + 4 * g4 + rg) * 16 + l15] = o2[rg];
        }
        __syncthreads();
#pragma unroll 1
        for (int c = 0; c < 4; ++c) {
            { const u32x2 qa = *(const LAS u32x2*)(Qs + (c * 16 + l15) * 136 + 16 * wave + 4 * g4);
              const bf16x8 af = __builtin_bit_cast(bf16x8, ((u32x4){qa.x, qa.y, 0u, 0u})), sfv = __builtin_bit_cast(bf16x8, ((u32x4){cvt_pk_bf16_sw(accS[0], accS[1]), cvt_pk_bf16_sw(accS[2], accS[3]), 0u, 0u}));
              f32x4v po = (f32x4v){0.f, 0.f, 0.f, 0.f}; po = __builtin_amdgcn_mfma_f32_16x16x32_bf16(af, sfv, po, 0, 0, 0);
#pragma unroll
              for (int rg = 0; rg < 4; ++rg) Pp[((c * 8 + wave) * 16 + 4 * g4 + rg) * 16 + l15] = po[rg]; }
            { const LAS bf16_t* kg_ = Ks + (c * 16 + 8 * (g4 & 1)) * 136 + 16 * wave + l15;
              const unsigned m_ = g4 < 2 ? 0xffffffffu : 0u;
              const u32x4 aw_ = (u32x4){((unsigned)kg_[0] | ((unsigned)kg_[136] << 16)) & m_, ((unsigned)kg_[2 * 136] | ((unsigned)kg_[3 * 136] << 16)) & m_, ((unsigned)kg_[4 * 136] | ((unsigned)kg_[5 * 136] << 16)) & m_, ((unsigned)kg_[6 * 136] | ((unsigned)kg_[7 * 136] << 16)) & m_};
              const bf16x8 af = __builtin_bit_cast(bf16x8, aw_), bfv = *(const LAS bf16x8*)(VT + (c * 16 + l15) * 40 + 8 * g4);
              const f32x4v dv = *(const LAS f32x4v*)(Ds + c * 128 + 16 * wave + 4 * g4);
              accS = __builtin_amdgcn_mfma_f32_16x16x32_bf16(af, bfv, accS, 0, 0, 0); accS = accS * dv; }
        }
        __syncthreads();
        { const int c = tid >> 7, t = (tid >> 3) & 15, v2 = (tid & 7) * 2; f32x2 sum = *(const LAS f32x2*)(O2s + (c * 16 + t) * 16 + v2);
#pragma unroll
          for (int w = 0; w < 8; ++w) sum += *(const LAS f32x2*)(Pp + ((c * 8 + w) * 16 + t) * 16 + v2);
          const int row = hgrn_row((s0 + 192) + c * 16 + t, dir, b); *(unsigned*)(Od + (size_t)row * 512 + h * 128 + vs * 16 + v2) = cvt_pk_bf16(sum[0], sum[1]); }

      }
    }
#undef HG_LOAD
}
__device__ __forceinline__ void phase_readout(const bf16_t* PAC, bf16_t* OF, const bf16_t* OB, const float* nw, int rows, int bid, int G) {
    const int tid_ = otid(); const int lane = tid_ & 63, wv = tid_ >> 6;
    for (int r = bid * 8 + wv; r < rows; r += G * 8) {
        float a[8], c[8], gg[8];
        unpack8(*(const u32x4*)(OF + (size_t)r * 512 + lane * 8), a); unpack8(*(const u32x4*)(OB + (size_t)r * 512 + lane * 8), c); unpack8(*(const u32x4*)(PAC + (size_t)r * NAC + 1024 + lane * 8), gg);
        float q = 0.f;
#pragma unroll
        for (int j = 0; j < 8; ++j) { a[j] += c[j]; q += a[j] * a[j]; }
        q += __shfl_xor(q, 1); q += __shfl_xor(q, 2); q += __shfl_xor(q, 4); q += __shfl_xor(q, 8);
        const float rs = rsqrtf(q * (1.0f / 128.0f) + 1e-6f);
#pragma unroll
        for (int j = 0; j < 8; ++j) a[j] = a[j] * rs * nw[lane * 8 + j] * silu(gg[j]);
        *(u32x4*)(OF + (size_t)r * 512 + lane * 8) = pack8(a);
    }
}

__device__ __forceinline__ void attn_item(LAS unsigned char* L, int item, const bf16_t* PAC, const float* tab, const float* sink, bf16_t* YC) {
    const bool isctx = item >= 1024;
    int n, hk, b;
    if (!isctx) { n = item & 255; hk = (item >> 8) & 1; b = item >> 9; } else { const int j = item - 1024; n = j & 3; hk = (j >> 2) & 1; b = j >> 3; }
    LAS bf16_t* Ks = (LAS bf16_t*)L;
    LAS bf16_t* Vt = Ks + 64 * 72;
    const int tid = otid(), wave = tid >> 6, lane = tid & 63, c32 = lane & 31, hi = lane >> 5;
    const int g = wave >> 1, qt = wave & 1, head = hk * 4 + g;
    const float qscale = 0.125f * 1.44269504089f;
    const int qi = n * 64 + qt * 32 + c32;
    const int qrow = isctx ? NLAT + b * LCTX + qi : b * SEQ + qi;
    bf16x8 qf[4];
    {
        const bf16_t* qp = PAC + (size_t)qrow * NAC + 2560 + head * 64 + 8 * hi;
        float x0[8], x1[8], x2[8], x3[8];
        unpack8(*(const u32x4*)(qp), x0); unpack8(*(const u32x4*)(qp + 16), x1); unpack8(*(const u32x4*)(qp + 32), x2); unpack8(*(const u32x4*)(qp + 48), x3);
        if (!isctx) {
            const float* tr = tab + ((qi >> 6) * 16 + 8 * hi) * 2; const float* tc = tab + ((qi & 63) * 16 + 8 * hi) * 2;
#pragma unroll
            for (int j = 0; j < 8; ++j) { const float cr = tr[2 * j], sr = tr[2 * j + 1], cc = tc[2 * j], scn = tc[2 * j + 1];
                const float a0 = x0[j], a1 = x1[j], b0 = x2[j], b1 = x3[j];
                x0[j] = a0 * cr - a1 * sr; x1[j] = a1 * cr + a0 * sr; x2[j] = b0 * cc - b1 * scn; x3[j] = b1 * cc + b0 * scn; }
        }
#pragma unroll
        for (int j = 0; j < 8; ++j) { x0[j] *= qscale; x1[j] *= qscale; x2[j] *= qscale; x3[j] *= qscale; }
        qf[0] = __builtin_bit_cast(bf16x8, pack8(x0)); qf[1] = __builtin_bit_cast(bf16x8, pack8(x1)); qf[2] = __builtin_bit_cast(bf16x8, pack8(x2)); qf[3] = __builtin_bit_cast(bf16x8, pack8(x3));
    }
    float m_ = sink[head] * 1.44269504089f, l_ = hi == 0 ? 1.f : 0.f;
    f32x16 O0, O1;
#pragma unroll
    for (int e = 0; e < 16; ++e) { O0[e] = 0.f; O1[e] = 0.f; }
    const int nch = isctx ? 4 : 9;
    for (int ci = 0; ci < nch; ++ci) {
        bool kctx; int kbase;
        if (isctx) { kctx = true; kbase = ci * 64; }
        else if (ci < 5) { kctx = false; kbase = (n - 2 + ci) * 64; if (kbase < 0 || kbase >= SEQ) continue; }
        else { kctx = true; kbase = (ci - 5) * 64; }
        __syncthreads();
        { const int key = tid >> 3, sub = tid & 7, a = sub >> 2, f0 = (sub & 3) * 4;
          const int krow = kctx ? NLAT + b * LCTX + kbase + key : b * SEQ + kbase + key;
          const bf16_t* kp = PAC + (size_t)krow * NAC + 3072 + hk * 64 + a * 32 + f0;
          const u32x2 w1 = *(const u32x2*)kp, w2 = *(const u32x2*)(kp + 16);
          float y1[4] = {bflo(w1.x), bfhi(w1.x), bflo(w1.y), bfhi(w1.y)}, y2[4] = {bflo(w2.x), bfhi(w2.x), bflo(w2.y), bfhi(w2.y)};
          if (!kctx) { const int pos = kbase + key; const int idx = a ? (pos & 63) : (pos >> 6); const float* tp = tab + (idx * 16 + f0) * 2;
#pragma unroll
              for (int j = 0; j < 4; ++j) { const float c = tp[2 * j], s = tp[2 * j + 1]; const float u0 = y1[j], u1 = y2[j]; y1[j] = u0 * c - u1 * s; y2[j] = u1 * c + u0 * s; } }
          u32x2 o1, o2; o1.x = cvt_pk_bf16(y1[0], y1[1]); o1.y = cvt_pk_bf16(y1[2], y1[3]); o2.x = cvt_pk_bf16(y2[0], y2[1]); o2.y = cvt_pk_bf16(y2[2], y2[3]);
          *(LAS u32x2*)(Ks + key * 72 + a * 32 + f0) = o1; *(LAS u32x2*)(Ks + key * 72 + a * 32 + 16 + f0) = o2;
          const u32x4 vw = *(const u32x4*)(PAC + (size_t)krow * NAC + 3200 + hk * 64 + sub * 8);
          Vt[(sub * 8 + 0) * 68 + key] = (bf16_t)(vw.x & 0xffffu); Vt[(sub * 8 + 1) * 68 + key] = (bf16_t)(vw.x >> 16);
          Vt[(sub * 8 + 2) * 68 + key] = (bf16_t)(vw.y & 0xffffu); Vt[(sub * 8 + 3) * 68 + key] = (bf16_t)(vw.y >> 16);
          Vt[(sub * 8 + 4) * 68 + key] = (bf16_t)(vw.z & 0xffffu); Vt[(sub * 8 + 5) * 68 + key] = (bf16_t)(vw.z >> 16);
          Vt[(sub * 8 + 6) * 68 + key] = (bf16_t)(vw.w & 0xffffu); Vt[(sub * 8 + 7) * 68 + key] = (bf16_t)(vw.w >> 16); }
        __syncthreads();
        f32x16 S0, S1;
#pragma unroll
        for (int e = 0; e < 16; ++e) { S0[e] = 0.f; S1[e] = 0.f; }
#pragma unroll
        for (int ks = 0; ks < 4; ++ks) {
            const bf16x8 k0 = *(const LAS bf16x8*)(Ks + (c32) * 72 + ks * 16 + hi * 8), k1 = *(const LAS bf16x8*)(Ks + (32 + c32) * 72 + ks * 16 + hi * 8);
            S0 = __builtin_amdgcn_mfma_f32_32x32x16_bf16(k0, qf[ks], S0, 0, 0, 0); S1 = __builtin_amdgcn_mfma_f32_32x32x16_bf16(k1, qf[ks], S1, 0, 0, 0); }
        float mx = -1e30f;
        if (!kctx) {
#pragma unroll
            for (int e = 0; e < 16; ++e) { const int kp0 = kbase + (e & 3) + 8 * (e >> 2) + 4 * hi; const int d0 = qi - kp0, d1 = d0 - 32;
                if (d0 > 128 || d0 < -128) S0[e] = -1e30f; if (d1 > 128 || d1 < -128) S1[e] = -1e30f; }
        }
#pragma unroll
        for (int e = 0; e < 16; ++e) mx = fmaxf(mx, fmaxf(S0[e], S1[e]));
        mx = fmaxf(mx, __shfl_xor(mx, 32));
        const float mnew = fmaxf(m_, mx), alpha = __builtin_amdgcn_exp2f(m_ - mnew); m_ = mnew;
        float ps = 0.f;
#pragma unroll
        for (int e = 0; e < 16; ++e) { S0[e] = __builtin_amdgcn_exp2f(S0[e] - mnew); S1[e] = __builtin_amdgcn_exp2f(S1[e] - mnew); ps += S0[e] + S1[e]; }
        l_ = l_ * alpha + ps;
#pragma unroll
        for (int e = 0; e < 16; ++e) { O0[e] *= alpha; O1[e] *= alpha; }
#pragma unroll
        for (int kt = 0; kt < 2; ++kt)
#pragma unroll
            for (int s2 = 0; s2 < 2; ++s2) {
                u32x4 w;
                if (kt == 0) { w.x = cvt_pk_bf16_sw(S0[8 * s2 + 0], S0[8 * s2 + 1]); w.y = cvt_pk_bf16_sw(S0[8 * s2 + 2], S0[8 * s2 + 3]); w.z = cvt_pk_bf16_sw(S0[8 * s2 + 4], S0[8 * s2 + 5]); w.w = cvt_pk_bf16_sw(S0[8 * s2 + 6], S0[8 * s2 + 7]); }
                else { w.x = cvt_pk_bf16_sw(S1[8 * s2 + 0], S1[8 * s2 + 1]); w.y = cvt_pk_bf16_sw(S1[8 * s2 + 2], S1[8 * s2 + 3]); w.z = cvt_pk_bf16_sw(S1[8 * s2 + 4], S1[8 * s2 + 5]); w.w = cvt_pk_bf16_sw(S1[8 * s2 + 6], S1[8 * s2 + 7]); }
                const bf16x8 pf = __builtin_bit_cast(bf16x8, w);
                const LAS bf16_t* vp0 = Vt + (c32) * 68 + kt * 32 + 16 * s2 + 4 * hi; const LAS bf16_t* vp1 = vp0 + 32 * 68;
                const u32x2 a0 = *(const LAS u32x2*)vp0, a1 = *(const LAS u32x2*)(vp0 + 8), b0 = *(const LAS u32x2*)vp1, b1 = *(const LAS u32x2*)(vp1 + 8);
                const bf16x8 vf0 = __builtin_bit_cast(bf16x8, ((u32x4){a0.x, a0.y, a1.x, a1.y})), vf1 = __builtin_bit_cast(bf16x8, ((u32x4){b0.x, b0.y, b1.x, b1.y}));
                O0 = __builtin_amdgcn_mfma_f32_32x32x16_bf16(vf0, pf, O0, 0, 0, 0); O1 = __builtin_amdgcn_mfma_f32_32x32x16_bf16(vf1, pf, O1, 0, 0, 0);
            }
    }
    {
        const float lt = l_ + __shfl_xor(l_, 32); const float inv = 1.f / lt;
        bf16_t* yp = YC + (size_t)qrow * 512 + head * 64 + 4 * hi;
#pragma unroll
        for (int i = 0; i < 4; ++i) { u32x2 w; w.x = cvt_pk_bf16(O0[4 * i] * inv, O0[4 * i + 1] * inv); w.y = cvt_pk_bf16(O0[4 * i + 2] * inv, O0[4 * i + 3] * inv); *(u32x2*)(yp + 8 * i) = w;
            u32x2 w2; w2.x = cvt_pk_bf16(O1[4 * i] * inv, O1[4 * i + 1] * inv); w2.y = cvt_pk_bf16(O1[4 * i + 2] * inv, O1[4 * i + 3] * inv); *(u32x2*)(yp + 32 + 8 * i) = w2; }
    }
    __syncthreads();
}

__device__ __forceinline__ void filt_item(LAS unsigned char* L, int item, int Lseq, bool latent, const float* w1, const float* b1, const float* f1, const float* w2, const float* b2, const float* f2, const float* w3, float* l1acc, bf16_t* FR, float* fc) {
    const int tid = otid(), p0 = item * 64;
    LAS float* feats = (LAS float*)L; LAS float* h1 = feats + 64 * 36; LAS float* h2 = h1 + 64 * 64;
    __syncthreads();
    for (int e = tid; e < 64 * 33; e += 512) { const int p = e / 33, j = e % 33; const float pos = (float)(p0 + p);
        float val;
        if (j == 0) val = pos / (float)(Lseq - 1);
        else { const int bi = (j - 1) & 15; const float band = 1e-4f + (float)bi * ((15.0f - 1e-4f) / 15.0f); const float w = 2.0f * 3.14159265358979f * pos / (float)Lseq;
            val = j <= 16 ? __cosf(w * band) : -__sinf(w * band); }
        feats[p * 36 + j] = val; }
    __syncthreads();
    { const int nn = tid & 63, pg = tid >> 6;
      float acc[8];
#pragma unroll
      for (int i = 0; i < 8; ++i) acc[i] = 0.f;
      for (int j = 0; j < 33; ++j) { const float wv = w1[j * 64 + nn];
#pragma unroll
          for (int i = 0; i < 8; ++i) acc[i] += feats[(pg * 8 + i) * 36 + j] * wv; }
      const float bb = b1[nn], ff = f1[nn];
#pragma unroll
      for (int i = 0; i < 8; ++i) h1[(pg * 8 + i) * 64 + nn] = __sinf(ff * (acc[i] + bb)); }
    __syncthreads();
    { const int nn = tid & 63, pg = tid >> 6;
      float acc[8];
#pragma unroll
      for (int i = 0; i < 8; ++i) acc[i] = 0.f;
      for (int j = 0; j < 64; ++j) { const float wv = w2[j * 64 + nn];
#pragma unroll
          for (int i = 0; i < 8; ++i) acc[i] += h1[(pg * 8 + i) * 64 + j] * wv; }
      const float bb = b2[nn], ff = f2[nn];
#pragma unroll
      for (int i = 0; i < 8; ++i) h2[(pg * 8 + i) * 64 + nn] = __sinf(ff * (acc[i] + bb)); }
    __syncthreads();
    {
        float asum[4] = {0.f, 0.f, 0.f, 0.f};
        for (int pgp = 0; pgp < 4; ++pgp) {
            float acc[4][16];
#pragma unroll
            for (int jj = 0; jj < 4; ++jj)
#pragma unroll
                for (int p = 0; p < 16; ++p) acc[jj][p] = 0.f;
            for (int k4 = 0; k4 < 16; ++k4) {
                f32x4 w[4];
#pragma unroll
                for (int jj = 0; jj < 4; ++jj) { const int c = tid + 512 * jj; w[jj] = (f32x4){w3[(size_t)(4 * k4) * 2048 + c], w3[(size_t)(4 * k4 + 1) * 2048 + c], w3[(size_t)(4 * k4 + 2) * 2048 + c], w3[(size_t)(4 * k4 + 3) * 2048 + c]}; }
#pragma unroll
                for (int p = 0; p < 16; ++p) { const f32x4 hv = *(const LAS f32x4*)(h2 + (pgp * 16 + p) * 64 + 4 * k4);
#pragma unroll
                    for (int jj = 0; jj < 4; ++jj) acc[jj][p] += (hv[0] * w[jj][0] + hv[1] * w[jj][1]) + (hv[2] * w[jj][2] + hv[3] * w[jj][3]); }
            }
#pragma unroll
            for (int jj = 0; jj < 4; ++jj) { const int c = tid + 512 * jj; const int dirn = c >> 10, ord = (c >> 9) & 1, ch = c & 511;
                const float rate = fabsf(-3.0701134573f + (float)ch * ((-15.350567286f + 3.0701134573f) / 511.0f));
#pragma unroll
                for (int p = 0; p < 16; ++p) { const int pos = p0 + pgp * 16 + p; const float t = (float)pos / (float)(Lseq - 1); const float val = acc[jj][p] * __expf(-t * rate);
                    if (!(dirn == 1 && pos == 0)) { asum[jj] += fabsf(val);
                        if (latent) { const int m = dirn == 0 ? FRC - pos : FRC + pos; FR[(size_t)(ord * 512 + ch) * FRLEN + m] = f2bf(val); } }
                    if (!latent) fc[(size_t)pos * 2048 + c] = val; } }
        }
#pragma unroll
        for (int jj = 0; jj < 4; ++jj) { const int c = tid + 512 * jj; atomicAdd(l1acc + ((c >> 9) & 1) * 512 + (c & 511), asum[jj]); }
    }
    if (latent) {
        for (int e = tid; e < 4 * 129; e += 512) { const int rr = item * 4 + e / 129, q = e % 129; const int m = q < 64 ? q : (FRC + SEQ + (q - 64)); FR[(size_t)rr * FRLEN + m] = 0; }
    }
}
__device__ __forceinline__ void hyprep_phase(LAS unsigned char* L, const bf16_t* PB, const float* cw, const float* cb, bf16_t* T, int bid, int G) {
    LAS float* xs = (LAS float*)L;
    const int tid = otid();
    u32x4 p0 = (u32x4){0, 0, 0, 0}, p1 = (u32x4){0, 0, 0, 0};
#define HP_LOAD(IT) { const int tt_ = (IT) / 24, ct_ = (IT) % 24; const int r0_ = tt_ * 64, c0_ = ct_ * 64; const int b_ = r0_ >> 14, t0_ = r0_ & (SEQ - 1); \
        { const int rr = tid >> 3, ck = (tid & 7) * 8; const int t = t0_ - 1 + rr; p0 = (t >= 0 && t < SEQ) ? *(const u32x4*)(PB + (size_t)(b_ * SEQ + t) * NPB + c0_ + ck) : (u32x4){0, 0, 0, 0}; } \
        if (tid < 16) { const int rr = 64 + (tid >> 3), ck = (tid & 7) * 8; const int t = t0_ - 1 + rr; p1 = (t >= 0 && t < SEQ) ? *(const u32x4*)(PB + (size_t)(b_ * SEQ + t) * NPB + c0_ + ck) : (u32x4){0, 0, 0, 0}; } }
    int it = bid;
    if (it < 512 * 24) HP_LOAD(it)
    for (; it < 512 * 24; it += G) {
        const int tt = it / 24, ct = it % 24; const int r0 = tt * 64, c0 = ct * 64; const int b = r0 >> 14, t0 = r0 & (SEQ - 1);
        __syncthreads();
        { float f[8]; unpack8(p0, f); const int rr = tid >> 3, ck = (tid & 7) * 8;
#pragma unroll
          for (int j = 0; j < 8; ++j) xs[rr * 65 + ck + j] = f[j];
          if (tid < 16) { unpack8(p1, f); const int rr2 = 64 + (tid >> 3);
#pragma unroll
              for (int j = 0; j < 8; ++j) xs[rr2 * 65 + ck + j] = f[j]; } }
        __syncthreads();
        if (it + G < 512 * 24) HP_LOAD(it + G)
        { const int cl = tid >> 3, tc = (tid & 7) * 8, c = c0 + cl; const float w0 = cw[c], w1 = cw[NPB + c], w2 = cw[2 * NPB + c], bb = cb[c]; float o[8];
#pragma unroll
          for (int j = 0; j < 8; ++j) o[j] = xs[(tc + j) * 65 + cl] * w0 + xs[(tc + j + 1) * 65 + cl] * w1 + xs[(tc + j + 2) * 65 + cl] * w2 + bb;
          *(u32x4*)(T + ((size_t)c * 2 + b) * SEQ + t0 + tc) = pack8(o); }
    }
#undef HP_LOAD
}
__device__ __forceinline__ void hyconv_item(LAS unsigned char* L, int ch, bf16_t* T, const bf16_t* FR, const float* l1acc, const float* hbias) {
    LAS bf16_t* zs = (LAS bf16_t*)L; LAS bf16_t* fr = zs + 2 * ZP;
    const int tid = otid(), wave = tid >> 6, lane = tid & 63, r = lane & 31, h = lane >> 5;
    const int b = wave >> 2, tt0 = (wave & 3) * 4;
    __syncthreads();
    for (int e = tid; e < 2 * 2048; e += 512) { const int bb = e >> 11, ck = e & 2047; const u32x4 w = *(const u32x4*)(T + ((size_t)ch * 2 + bb) * SEQ + ck * 8); const int i = 1024 + ck * 8;
        *(LAS u32x4*)(zs + bb * ZP + (i >> 5) * 40 + (i & 31)) = w; }
    for (int e = tid; e < 2 * 64 * 5; e += 512) { const int bb = e / 320, q = e % 320, blk = q / 5, part = q % 5; const int bk = blk < 32 ? blk : 512 + blk;
        *(LAS u32x4*)(zs + bb * ZP + bk * 40 + part * 8) = (u32x4){0, 0, 0, 0}; }
    for (int ord = 0; ord < 2; ++ord) {
        const bf16_t* frg = FR + (size_t)(ord * 512 + ch) * FRLEN;
        for (int e = tid; e < FRLEN / 8; e += 512) *(LAS u32x4*)(fr + e * 8) = *(const u32x4*)(frg + e * 8);
        __syncthreads();
        f32x16 acc[4];
#pragma unroll
        for (int i = 0; i < 4; ++i)
#pragma unroll
            for (int e = 0; e < 16; ++e) acc[i][e] = 0.f;
        const int s_lo = 64 * tt0 - 1023, s_hi = 64 * (tt0 + 3) + 62;
        const LAS unsigned char* zb = (const LAS unsigned char*)(zs + b * ZP);
#define HY_A(off) ({ const LAS unsigned* ap_ = (const LAS unsigned*)(abase + (off)); const unsigned e0 = ap_[0], e1 = ap_[1], e2 = ap_[2], e3 = ap_[3], e4 = ap_[4]; \
            __builtin_bit_cast(bf16x8, ((u32x4){__builtin_amdgcn_alignbit(e1, e0, shb), __builtin_amdgcn_alignbit(e2, e1, shb), __builtin_amdgcn_alignbit(e3, e2, shb), __builtin_amdgcn_alignbit(e4, e3, shb)})); })
#define HY_MM(i, OFF, AF) acc[i] = __builtin_amdgcn_mfma_f32_32x32x16_bf16(AF, *(const LAS bf16x8*)(bbase + 2560 * (i) + (OFF)), acc[i], 0, 0, 0);
#define HY_SEG(SB, NP, T0, T1, T2, T3) { const int sb_ = (SB); const int m0b = FRC - 16 * sb_ - r + 8 * h; \
            const LAS unsigned char* abase = (const LAS unsigned char*)fr + ((2 * m0b) & ~3) - 32; \
            const LAS unsigned char* bbase = zb + (((32 - ((sb_ + 1) >> 1)) + 32 * tt0 + r) * 40 + 8 * h) * 2; \
            _Pragma("unroll 1") for (int p = 0; p < (NP); ++p) { const bf16x8 a_o = HY_A(32), a_e = HY_A(0); \
                if (T0) HY_MM(0, 32, a_o) if (T1) HY_MM(1, 32, a_o) if (T2) HY_MM(2, 32, a_o) if (T3) HY_MM(3, 32, a_o) \
                if (T0) HY_MM(0, 0, a_e) if (T1) HY_MM(1, 0, a_e) if (T2) HY_MM(2, 0, a_e) if (T3) HY_MM(3, 0, a_e) \
                abase -= 64; bbase -= 80; } }
        const unsigned shb = ((FRC - r) & 1) * 16;
        HY_SEG(s_lo, 32, 1, 0, 0, 0) HY_SEG(s_lo + 64, 32, 1, 1, 0, 0) HY_SEG(s_lo + 128, 32, 1, 1, 1, 0)
        HY_SEG(s_lo + 192, 447, 1, 1, 1, 1)
        HY_SEG(s_lo + 1086, 32, 0, 1, 1, 1) HY_SEG(s_lo + 1150, 32, 0, 0, 1, 1) HY_SEG(s_lo + 1214, 32, 0, 0, 0, 1)
#undef HY_A
#undef HY_MM
#undef HY_SEG
        __syncthreads();
        const float inv = 1.0f / l1acc[ord * 512 + ch], bs = hbias[ord * 512 + ch];
        bf16_t* xg = T + ((size_t)((ord + 1) * 512 + ch) * 2 + b) * SEQ;
#pragma unroll
        for (int i = 0; i < 4; ++i) { const int col = 32 * (tt0 + i) + r;
#pragma unroll
            for (int gq = 0; gq < 4; ++gq) { const int t = 32 * col + 8 * gq + 4 * h; const int iz = 1024 + t;
                LAS u32x2* zp = (LAS u32x2*)(zs + b * ZP + (iz >> 5) * 40 + (iz & 31));
                const u32x2 zw = *zp; const u32x2 xw = *(const u32x2*)(xg + t);
                const float z0 = bflo(zw.x), z1 = bfhi(zw.x), z2 = bflo(zw.y), z3 = bfhi(zw.y);
                const float o0 = bflo(xw.x) * (acc[i][4 * gq] * inv + bs * z0), o1 = bfhi(xw.x) * (acc[i][4 * gq + 1] * inv + bs * z1);
                const float o2 = bflo(xw.y) * (acc[i][4 * gq + 2] * inv + bs * z2), o3 = bfhi(xw.y) * (acc[i][4 * gq + 3] * inv + bs * z3);
                u32x2 ow; ow.x = cvt_pk_bf16(o0, o1); ow.y = cvt_pk_bf16(o2, o3);
                if (ord == 0) *zp = ow; else *(u32x2*)(xg + t) = ow; } }
        __syncthreads();
    }
}
__device__ __forceinline__ void hytrb_phase(LAS unsigned char* L, const bf16_t* T2, bf16_t* YB, int bid, int G) {
    LAS bf16_t* tl = (LAS bf16_t*)L;
    const int tid = otid(); const int cl = tid >> 3, tc = (tid & 7) * 8;
    int it = bid;
    if (it >= 512 * 8) return;
    u32x4 pv;
#define TRB_LOAD(IT) { const int tt_ = (IT) >> 3, ct_ = (IT) & 7; const int r0_ = tt_ * 64, c0_ = ct_ * 64, b_ = r0_ >> 14, t0_ = r0_ & (SEQ - 1); pv = *(const u32x4*)(T2 + ((size_t)(c0_ + cl) * 2 + b_) * SEQ + t0_ + tc); }
    TRB_LOAD(it)
    for (; it < 512 * 8; it += G) {
        const int tt = it >> 3, ct = it & 7; const int r0 = tt * 64, c0 = ct * 64;
        __syncthreads();
        *(LAS u32x4*)(tl + cl * 72 + tc) = pv;
        __syncthreads();
        if (it + G < 512 * 8) TRB_LOAD(it + G)
        { const int tl_ = tid >> 3, cc = (tid & 7) * 8; unsigned w[4];
#pragma unroll
          for (int j = 0; j < 4; ++j) w[j] = (unsigned)tl[(cc + 2 * j) * 72 + tl_] | ((unsigned)tl[(cc + 2 * j + 1) * 72 + tl_] << 16);
          *(u32x4*)(YB + (size_t)(r0 + tl_) * 512 + c0 + cc) = (u32x4){w[0], w[1], w[2], w[3]}; }
    }
#undef TRB_LOAD
    __syncthreads();
}
__device__ __forceinline__ void hyctx_shortconv(const bf16_t* PB, const float* cw, const float* cb, float* SC, int bid, int G) {
    for (int e = bid * 512 + otid(); e < NCTX * NPB; e += G * 512) { const int r = e / NPB, c = e % NPB, t = r & 255;
        const bf16_t* p = PB + (size_t)(NLAT + r) * NPB + c;
        const float xm = t > 0 ? bf2f(p[-NPB]) : 0.f, x0 = bf2f(p[0]), xp = t < 255 ? bf2f(p[NPB]) : 0.f;
        SC[e] = xm * cw[c] + x0 * cw[NPB + c] + xp * cw[2 * NPB + c] + cb[c]; }
}
__device__ __forceinline__ void hyctx_conv(int ord, const float* SC, const float* zin, int ldz, const float* fc, const float* l1c, const float* hbias, float* z1c, bf16_t* YB, int bid, int G) {
    for (int e = bid * 512 + otid(); e < NCTX * 512; e += G * 512) { const int r = e >> 9, ch = e & 511, b = r >> 8, t = r & 255;
        float s = 0.f;
        for (int j = 0; j < 256; ++j) { const int x = t - j; const float fv = x >= 0 ? fc[(size_t)x * 2048 + ord * 512 + ch] : fc[(size_t)(-x) * 2048 + 1024 + ord * 512 + ch];
            s += fv * zin[(size_t)(b * 256 + j) * ldz + ch]; }
        const float zt = zin[(size_t)r * ldz + ch];
        const float o = SC[(size_t)r * NPB + (ord + 1) * 512 + ch] * (s / l1c[ord * 512 + ch] + hbias[ord * 512 + ch] * zt);
        if (ord == 0) z1c[e] = o; else YB[(size_t)(NLAT + r) * 512 + ch] = f2bf(o); }
}

constexpr int NPHASE = 2 + 17 * 2;
#define P_BIG (a.ws + WS_BIG)
#define P_W (a.ws + WS_W)
#define P_U ((bf16_t*)(a.ws + WS_U))
#define P_U2 ((bf16_t*)(P_BIG + (size_t)MROWS * D * 2))
#define P_HC ((float*)(a.ws + WS_HC))
#define P_MODS ((float*)(a.ws + WS_MISC + MI_MODS))
#define P_TAB ((const float*)(a.ws + WS_MISC + MI_TAB))
#define P_ACT ((bf16_t*)(P_BIG + ((sp >= 14 || sp <= 2) ? B_Y : B_ACT)))
#define P_Y ((bf16_t*)(P_BIG + ((sp >= 14 || sp <= 2) ? (size_t)0 : B_Y)))
#define P_PAC ((bf16_t*)(P_BIG + B_PAC))
#define P_OB ((bf16_t*)(P_BIG + B_OB))
#define P_PB ((bf16_t*)(P_BIG + B_PB))
#define P_T ((bf16_t*)(P_BIG + B_T))
#define P_FR ((bf16_t*)(P_BIG + B_F))
#define P_PG ((bf16_t*)(P_BIG + B_PG))
#define P_YA ((bf16_t*)(P_BIG + B_YA))
#define P_YB ((bf16_t*)(P_BIG + B_YB))
#define P_YC ((bf16_t*)(P_BIG + B_YC))
#define P_L1 ((float*)(a.ws + WS_MISC + MI_L1) + layer * 1024)
#define P_L1C ((float*)(a.ws + WS_MISC + MI_L1C))
#define P_FC ((float*)(a.ws + WS_MISC + MI_FC))
#define P_SC ((float*)(a.ws + WS_MISC + MI_SC))
#define P_Z1C ((float*)(a.ws + WS_MISC + MI_Z1C))
#define HY_W1 (a.in[15] + layer * 33 * 64)
#define HY_B1 (a.in[16] + layer * 64)
#define HY_F1 (a.in[17] + layer * 64)
#define HY_W2 (a.in[18] + layer * 64 * 64)
#define HY_B2 (a.in[19] + layer * 64)
#define HY_F2 (a.in[20] + layer * 64)
#define HY_W3 (a.in[21] + (size_t)layer * 64 * 2048)
#define HY_BIAS (a.in[22] + layer * 1024)
#define HY_CW (a.in[13] + layer * 3 * NPB)
#define HY_CB (a.in[14] + layer * NPB)
#define MODL (P_MODS + (size_t)layer * 3 * NMOD)
#define LNG (a.in[6] + (size_t)layer * 3 * D)
#define LNB (a.in[7] + (size_t)layer * 3 * D)
__global__ void __launch_bounds__(512, 2) mega(Args a) {
    extern __shared__ __attribute__((aligned(16))) unsigned char lds_raw[];
    LAS unsigned char* L = (LAS unsigned char*)lds_raw;
    cg::grid_group grid = cg::this_grid();
    const int bid = blockIdx.x, G = gridDim.x;
    if (a.ph_hi - a.ph_lo > 1) grid.sync();
    for (int ph = a.ph_lo; ph < a.ph_hi; ++ph) {
        bool do_gemm = false; pg8::Gemm gg{}; pg8::EpiAny ep{}; int gM = 0, gN = 0, gbr = 1;
        if (ph == 0) { phase_wconv(L, a, 0, bid, G); phase_mods(L, a, bid, G); }
        else if (ph == 1) { LnP p{a.in[0], a.in[2], nullptr, nullptr, nullptr, 0, nullptr, 0, 0.f, nullptr, nullptr, P_MODS, 0, P_U, MROWS, 0}; phase_ln(p, bid, G); }
        else {
            const int layer = (ph - 2) / 17, sp = (ph - 2) % 17;
            const int Mpost = layer == 1 ? NLAT : MROWS;
            switch (sp) {
            case 0: case 14: {
                const int f = sp == 0 ? 1 : 0; const bf16_t* Wt = (const bf16_t*)(P_W + W_IN) + (size_t)f * NFF2 * D;
                gg = pg8::Gemm{sp == 0 ? P_U : P_U2, Wt, 0, 0, D, D, D}; gM = sp == 0 ? MROWS : Mpost; gN = NFF2; ep = pg8::EpiAny{1, P_ACT, DFF, nullptr, nullptr}; do_gemm = true; } break;
            case 1: case 15: {
                const int f = sp == 1 ? 1 : 0; const bf16_t* Wt = (const bf16_t*)(P_W + W_OUT) + (size_t)f * D * DFF;
                gg = pg8::Gemm{P_ACT, Wt, 0, 0, DFF, DFF, DFF}; gM = sp == 1 ? MROWS : Mpost; gN = D; ep = pg8::EpiAny{0, P_Y, D, nullptr, nullptr}; do_gemm = true; } break;
            case 2: { const bool first = layer == 0;
                LnP p{first ? a.in[0] : a.out, first ? a.in[2] : P_HC, a.out, P_HC, P_Y, D, MODL, 2, 0.5f, LNG, LNB, MODL, 3, P_U, MROWS, 1}; phase_ln(p, bid, G); } break;
            case 3: { const bf16_t* Wt = (const bf16_t*)(P_W + W_MIX);
                gg = pg8::Gemm{P_U, Wt, 0, 0, D, D, D}; gM = MROWS; gN = NAC; ep = pg8::EpiAny{0, P_PAC, NAC, nullptr, nullptr}; do_gemm = true; } break;
            case 4: {
                bf16_t* QB = (bf16_t*)(P_BIG + B_QB); float* DB = (float*)(P_BIG + B_DB);
                hgrn_prepass(P_PAC, QB, DB, a.in[11], layer, bid, G);
                {
                    __syncthreads();
                    if (threadIdx.x < 64) {
                        __builtin_amdgcn_fence(__ATOMIC_RELEASE, "agent"); asm volatile("s_waitcnt vmcnt(0) lgkmcnt(0)" ::: "memory");
                        if (threadIdx.x == 0) { unsigned* bar2 = (unsigned*)(a.ws + WS_MISC + MI_BAR) + 16;
                            __hip_atomic_fetch_add(bar2, 1u, __ATOMIC_RELAXED, __HIP_MEMORY_SCOPE_AGENT);
                            const unsigned target = (unsigned)(layer + 1) * (unsigned)G;
                            while (__hip_atomic_load(bar2, __ATOMIC_RELAXED, __HIP_MEMORY_SCOPE_AGENT) < target) __builtin_amdgcn_s_sleep(1); }
                        __builtin_amdgcn_fence(__ATOMIC_ACQUIRE, "agent"); asm volatile("s_waitcnt vmcnt(0) lgkmcnt(0)" ::: "memory"); }
                    __syncthreads();
                }
                const int nh = G >= 256 ? 128 : G / 2;
                if (bid < nh) { for (int it = bid; it < 128; it += nh) hgrn_scan_item(L, it, P_PAC, QB, DB, P_YA, P_OB); }
                else { const int nitem = layer == 0 ? 1040 : 1024; for (int it = bid - nh; it < nitem; it += G - nh) attn_item(L, it, P_PAC, P_TAB, a.in[23] + layer * 8, P_YC); }
            } break;
            case 5: phase_readout(P_PAC, P_YA, P_OB, a.in[12] + layer * 512, Mpost, bid, G); break;
            case 6: { const bf16_t* Wt = (const bf16_t*)(P_W + W_MIX) + (size_t)NAC * D;
                gg = pg8::Gemm{P_U, Wt, 0, 0, D, D, D}; gM = Mpost; gN = NPB; ep = pg8::EpiAny{0, P_PB, NPB, nullptr, nullptr}; do_gemm = true; } break;
            case 7: {
                for (int it = bid; it < 256; it += G) filt_item(L, it, SEQ, true, HY_W1, HY_B1, HY_F1, HY_W2, HY_B2, HY_F2, HY_W3, P_L1, P_FR, nullptr);
                if (layer == 0) { for (int it = bid; it < 4; it += G) filt_item(L, it, LCTX, false, HY_W1, HY_B1, HY_F1, HY_W2, HY_B2, HY_F2, HY_W3, P_L1C, nullptr, P_FC);
                    hyctx_shortconv(P_PB, HY_CW, HY_CB, P_SC, bid, G); }
                hyprep_phase(L, P_PB, HY_CW, HY_CB, P_T, bid, G);
            } break;
            case 8: {
                for (int ch = bid; ch < 512; ch += G) hyconv_item(L, ch, P_T, P_FR, P_L1, HY_BIAS);
                if (layer == 0) hyctx_conv(0, P_SC, P_SC, NPB, P_FC, P_L1C, HY_BIAS, P_Z1C, P_YB, bid, G);
            } break;
            case 9: {
                hytrb_phase(L, P_T + (size_t)2 * 512 * 2 * SEQ, P_YB, bid, G);
                if (layer == 0) hyctx_conv(1, P_SC, P_Z1C, 512, P_FC, P_L1C, HY_BIAS, P_Z1C, P_YB, bid, G);
            } break;
            case 10: { const bf16_t* Wt = (const bf16_t*)(P_W + W_MIX) + (size_t)(NAC + NPB) * D;
                gg = pg8::Gemm{P_U, Wt, 0, 0, D, D, D}; gM = Mpost; gN = NPG; ep = pg8::EpiAny{0, P_PG, NPG, nullptr, nullptr}; do_gemm = true; } break;
            case 11: { const bf16_t* Wt = (const bf16_t*)(P_W + W_BR);
                gg = pg8::Gemm{P_YA, Wt, YSZ, (size_t)D * 512 * 2, 512, 512, 512}; gM = Mpost; gN = D; gbr = 3;
                ep = pg8::EpiAny{2, P_PG, NPG, P_PG, (float*)(P_BIG + B_SCR) + (size_t)bid * 65536}; do_gemm = true; } break;
            case 12: { const bf16_t* Wt = (const bf16_t*)(P_W + W_O);
                gg = pg8::Gemm{P_PG, Wt, 0, 0, NPG, D, D}; gM = Mpost; gN = D; ep = pg8::EpiAny{0, P_Y, D, nullptr, nullptr}; do_gemm = true; } break;
            case 13: { LnP p{a.out, P_HC, a.out, P_HC, P_Y, D, MODL, 5, 1.0f, LNG + D, LNB + D, MODL, 6, P_U2, Mpost, 1}; phase_ln(p, bid, G); } break;
            case 16: {
                LnP p{a.out, P_HC, a.out, P_HC, P_Y, D, MODL, 8, 0.5f, LNG + 2 * D, LNB + 2 * D, P_MODS + (size_t)(layer + 1) * 3 * NMOD, 0, P_U, Mpost, layer == 0 ? 1 : 2}; phase_ln(p, bid, G);
                if (layer == 0) phase_wconv(L, a, 1, bid, G);
            } break;
            }
        }
        if (do_gemm) { pg8::Order S; S.init(gM, gN, G, bid, gbr); pg8::gemm_phase(L, gg, S, ep); }
        if (ph + 1 < a.ph_hi) {
            __syncthreads();
            if (threadIdx.x < 64) {
                __builtin_amdgcn_fence(__ATOMIC_RELEASE, "agent"); asm volatile("s_waitcnt vmcnt(0) lgkmcnt(0)" ::: "memory");
                if (threadIdx.x == 0) {
                    unsigned* bar = (unsigned*)(a.ws + WS_MISC + MI_BAR);
                    const unsigned k = (unsigned)(ph - a.ph_lo + 1);
                    if ((G & 7) == 0) {
                        unsigned* grp = (unsigned*)(a.ws + WS_MISC + MI_BAR2) + (bid & 7) * 16;
                        const unsigned old = __hip_atomic_fetch_add(grp, 1u, __ATOMIC_RELAXED, __HIP_MEMORY_SCOPE_AGENT);
                        if (old + 1u == k * (unsigned)(G >> 3)) __hip_atomic_fetch_add(bar, 1u, __ATOMIC_RELAXED, __HIP_MEMORY_SCOPE_AGENT);
                        while (__hip_atomic_load(bar, __ATOMIC_RELAXED, __HIP_MEMORY_SCOPE_AGENT) < 8u * k) __builtin_amdgcn_s_sleep(1);
                    } else {
                        __hip_atomic_fetch_add(bar, 1u, __ATOMIC_RELAXED, __HIP_MEMORY_SCOPE_AGENT);
                        while (__hip_atomic_load(bar, __ATOMIC_RELAXED, __HIP_MEMORY_SCOPE_AGENT) < k * (unsigned)G) __builtin_amdgcn_s_sleep(1);
                    }
                }
                __builtin_amdgcn_fence(__ATOMIC_ACQUIRE, "agent"); asm volatile("s_waitcnt vmcnt(0) lgkmcnt(0)" ::: "memory");
            }
            __syncthreads();
        }
    }
}

extern "C" void kernel_launch(void* const* d_in, const int* in_sizes, int n_in, void* d_out, int out_size, void* d_ws, size_t ws_size, hipStream_t stream) {
    static int grid = 0;
    if (grid == 0) {
        if (n_in != 26 || ws_size < WS_TOTAL) { fprintf(stderr, "kernel_launch: needs 26 inputs and >= %zu bytes of workspace (got %d, %zu)\n", (size_t)WS_TOTAL, n_in, ws_size); grid = -1; return; }
        int dev = 0, cus = 0, per_cu = 0;
        (void)hipGetDevice(&dev);
        (void)hipDeviceGetAttribute(&cus, hipDeviceAttributeMultiprocessorCount, dev);
        (void)hipFuncSetAttribute((const void*)mega, hipFuncAttributeMaxDynamicSharedMemorySize, LDS_BYTES);
        (void)hipOccupancyMaxActiveBlocksPerMultiprocessor(&per_cu, (const void*)mega, 512, LDS_BYTES);
        if (per_cu < 1) per_cu = 1;
        grid = cus * per_cu;
        if (grid > 256) grid = 256;
    }
    if (grid < 0) return;
    Args a{};
    for (int i = 0; i < 26; ++i) a.in[i] = (const float*)d_in[i];
    a.out = (float*)d_out; a.ws = (unsigned char*)d_ws;
#ifndef ONE_LAUNCH
#define ONE_LAUNCH 1
#endif
    if (ONE_LAUNCH) {
        a.ph_lo = 0; a.ph_hi = NPHASE;
        void* args[] = {&a};
        (void)hipMemsetAsync((unsigned char*)d_ws + WS_MISC + MI_BAR, 0, 768, stream);
        hipError_t e = hipLaunchCooperativeKernel((const void*)mega, dim3(grid), dim3(512), args, LDS_BYTES, stream);
        if (e != hipSuccess) fprintf(stderr, "cooperative launch failed: %s (grid %d)\n", hipGetErrorString(e), grid);
    } else {
        for (int ph = 0; ph < NPHASE; ++ph) { a.ph_lo = ph; a.ph_hi = ph + 1; hipLaunchKernelGGL(mega, dim3(grid), dim3(512), LDS_BYTES, stream, a); }
    }
}
```

```cpp
#include <hip/hip_runtime.h>
#include <hip/hip_cooperative_groups.h>
#include <cstdio>
namespace cg = cooperative_groups;
#define LAS __attribute__((address_space(3)))
typedef unsigned short bf16_t;
typedef short bf16x8 __attribute__((ext_vector_type(8)));
typedef float f32x4 __attribute__((ext_vector_type(4)));
typedef float f32x2 __attribute__((ext_vector_type(2)));
typedef float f32x16 __attribute__((ext_vector_type(16)));
typedef unsigned u32x4 __attribute__((ext_vector_type(4)));
typedef unsigned u32x2 __attribute__((ext_vector_type(2)));

constexpr int D = 1024, SEQ = 16384, NLAT = 32768, LCTX = 256, NCTX = 512, MROWS = 33280;
constexpr int DFF = 2816, NFF2 = 5632;
constexpr int NAC = 3328, NPB = 1536, NPG = 3072, NMIX = 7936;
constexpr int NMOD = 9216;
constexpr int FRLEN = 2 * SEQ + 128, FRC = SEQ + 63;
constexpr int ZP = ((SEQ + 2048) / 32) * 40;
constexpr int LDS_BYTES = 2 * ZP * 2 + FRLEN * 2 + 256;
constexpr float DN_ALPHA = 1.41421356237f;

constexpr size_t WS_U = 0;
constexpr size_t WS_HC = WS_U + (size_t)MROWS * D * 2;
constexpr size_t WS_W = WS_HC + (size_t)NCTX * D * 4;
constexpr size_t W_IN = 0, W_OUT = W_IN + (size_t)2 * NFF2 * D * 2, W_MIX = W_OUT + (size_t)2 * D * DFF * 2, W_BR = W_MIX + (size_t)NMIX * D * 2, W_O = W_BR + (size_t)3 * D * 512 * 2, W_END = W_O + (size_t)D * D * 2;
constexpr size_t WS_MISC = WS_W + W_END;
constexpr size_t MI_MODS = 0, MI_TAB = MI_MODS + (size_t)2 * 3 * NMOD * 4, MI_L1 = MI_TAB + 256 * 16 * 2 * 4, MI_L1C = MI_L1 + 2 * 1024 * 4, MI_FC = MI_L1C + 1024 * 4,
                 MI_SC = MI_FC + (size_t)256 * 2048 * 4, MI_Z1C = MI_SC + (size_t)NCTX * 1536 * 4, MI_BAR = MI_Z1C + (size_t)NCTX * 512 * 4, MI_BAR2 = MI_BAR + 256, MI_END = MI_BAR2 + 512;
constexpr size_t WS_BIG = WS_MISC + 8388608;
static_assert(MI_END <= 8388608, "misc");
constexpr size_t WS_TOTAL = 536870912;
constexpr size_t BIG_SIZE = WS_TOTAL - WS_BIG;
constexpr size_t YSZ = (size_t)MROWS * 512 * 2;
constexpr size_t B_PAC = 0, B_OB = (size_t)MROWS * NAC * 2, B_ACT = 0, B_PG = 0, B_Y = (size_t)MROWS * NPG * 2, B_PB = 0, B_T = (size_t)MROWS * NPB * 2,
                 B_F = B_T + (size_t)3 * 512 * 2 * SEQ * 2, B_SCR = B_Y, B_QB = B_OB + YSZ, B_DB = B_QB + YSZ, B_YA = BIG_SIZE - 3 * YSZ, B_YB = B_YA + YSZ, B_YC = B_YB + YSZ;
static_assert(B_DB + (size_t)2 * (MROWS / 16) * 512 * 4 <= B_YA && B_OB + YSZ <= B_YA && B_F + (size_t)1024 * FRLEN * 2 <= B_YA && B_Y + (size_t)MROWS * D * 2 <= B_YA && B_SCR + (size_t)256 * 65536 * 4 <= B_YA && (size_t)MROWS * DFF * 2 <= B_Y, "big region");

struct Args { const float* in[26]; float* out; unsigned char* ws; int ph_lo, ph_hi; };

__device__ __forceinline__ float bf2f(unsigned b) { return __uint_as_float(b << 16); }
__device__ __forceinline__ float bflo(unsigned w) { return __uint_as_float(w << 16); }
__device__ __forceinline__ float bfhi(unsigned w) { return __uint_as_float(w & 0xffff0000u); }
typedef __bf16 bf16x2_hw __attribute__((ext_vector_type(2)));
__device__ __forceinline__ unsigned cvt_pk_bf16(float lo, float hi) { const f32x2 v = (f32x2){lo, hi}; return __builtin_bit_cast(unsigned, __builtin_convertvector(v, bf16x2_hw)); }
__device__ __forceinline__ unsigned cvt_pk_bf16_sw(float lo, float hi) { return cvt_pk_bf16(lo, hi); }
__device__ __forceinline__ bf16_t f2bf(float f) { return (bf16_t)(cvt_pk_bf16(f, 0.f) & 0xffffu); }
__device__ __forceinline__ int otid() { int t = threadIdx.x; asm volatile("" : "+v"(t)); return t; }
__device__ __forceinline__ f32x4 zero4() { float z; asm volatile("v_mov_b32 %0, 0" : "=v"(z)); return (f32x4){z, z, z, z}; }
__device__ __forceinline__ float sigm(float x) { return __builtin_amdgcn_rcpf(1.f + __builtin_amdgcn_exp2f(-1.44269504089f * x)); }
__device__ __forceinline__ float silu(float x) { return x * __builtin_amdgcn_rcpf(1.f + __builtin_amdgcn_exp2f(-1.44269504089f * x)); }
__device__ __forceinline__ void unpack8(u32x4 w, float* f) { f[0] = bflo(w.x); f[1] = bfhi(w.x); f[2] = bflo(w.y); f[3] = bfhi(w.y); f[4] = bflo(w.z); f[5] = bfhi(w.z); f[6] = bflo(w.w); f[7] = bfhi(w.w); }
__device__ __forceinline__ u32x4 pack8(const float* f) { u32x4 w; w.x = cvt_pk_bf16(f[0], f[1]); w.y = cvt_pk_bf16(f[2], f[3]); w.z = cvt_pk_bf16(f[4], f[5]); w.w = cvt_pk_bf16(f[6], f[7]); return w; }

namespace pg8 {
constexpr int BM = 256, BK = 64, HALF = 128, HTB = HALF * BK * 2, STAGE_BYTES = 8 * HTB, NXCD = 8, WGM = 8;
__device__ __forceinline__ int lds_byte(int r, int c) { const int st = (r >> 4) * 2 + (c >> 5), rr = r & 15, cc = c & 31, ob = rr * 64 + cc * 2; return st * 1024 + (ob ^ (((ob >> 9) & 1) << 5)); }
__device__ __forceinline__ void stage_rc(int b, int& R, int& C) { const int st = b / 1024, sb = b % 1024, swz = sb ^ (((sb >> 9) & 1) << 5); R = (st >> 1) * 16 + swz / 64; C = (st & 1) * 32 + (swz % 64) / 2; }
__device__ __forceinline__ int perm32(int rho) { const int n = rho >> 4, i = rho & 15; return 8 * (i >> 2) + 4 * n + (i & 3); }
struct Unit { int pm, pn, br; };
struct Gemm { const bf16_t* A; const bf16_t* Bt; size_t sA, sB; int lda, ldb, K;
    __device__ __forceinline__ const char* a(int br) const { return (const char*)A + (size_t)br * sA; }
    __device__ __forceinline__ const char* b(int br) const { return (const char*)Bt + (size_t)br * sB; } };
struct Order {
    int nM, nN, nwg, G, c, nbr;
    __device__ void init(int M, int N, int G_, int c_, int nbr_) { nM = M / BM; nN = N / BM; nwg = nM * nN; G = G_; c = c_; nbr = nbr_; }
    __device__ bool next(int i, Unit& u) const {
        const int ti = i / nbr; u.br = i - ti * nbr;
        const long L = (long)ti * G + c; if (L >= nwg) return false;
        int wgid = (int)L; { const int q = nwg / NXCD, r = nwg % NXCD, xcd = wgid % NXCD, off = wgid / NXCD; wgid = (xcd < r ? xcd * (q + 1) : r * (q + 1) + (xcd - r) * q) + off; }
        const int nig = WGM * nN, gid = wgid / nig, fm = gid * WGM, gsz = (nM - fm) < WGM ? (nM - fm) : WGM;
        u.pm = fm + ((wgid % nig) % gsz); u.pn = (wgid % nig) / gsz; return true;
    }
};
struct EpiAny {
    int kind; bf16_t* O; int ldc; const bf16_t* PG; float* scr;
    __device__ __forceinline__ void operator()(const f32x4 (&acc)[2][2][4][2], const Unit& u, int wr, int wc, int fr, int fq) const {
        asm volatile("" : "+v"(fr), "+v"(fq));
        if (kind == 0) {
            const int row0 = u.pm * BM + wr * 64 + fr, col0 = u.pn * BM + wc * 32 + 8 * fq;
#pragma unroll
            for (int ai = 0; ai < 2; ++ai)
#pragma unroll
                for (int m = 0; m < 4; ++m) { bf16_t* rowp = O + (size_t)(row0 + ai * HALF + m * 16) * ldc + col0;
#pragma unroll
                    for (int bj = 0; bj < 2; ++bj) { const f32x4 v0 = acc[ai][bj][m][0], v1 = acc[ai][bj][m][1];
                        u32x4 w; w.x = cvt_pk_bf16(v0[0], v0[1]); w.y = cvt_pk_bf16(v0[2], v0[3]); w.z = cvt_pk_bf16(v1[0], v1[1]); w.w = cvt_pk_bf16(v1[2], v1[3]);
                        *(u32x4*)(rowp + bj * HALF) = w; } }
        } else if (kind == 1) {
            const int row0 = u.pm * BM + wr * 64 + fr, col0 = u.pn * HALF + wc * 32 + 8 * fq;
#pragma unroll
            for (int ai = 0; ai < 2; ++ai)
#pragma unroll
                for (int m = 0; m < 4; ++m) { bf16_t* rowp = O + (size_t)(row0 + ai * HALF + m * 16) * ldc + col0;
                    const f32x4 a0 = acc[ai][0][m][0], a1 = acc[ai][0][m][1], b0 = acc[ai][1][m][0], b1 = acc[ai][1][m][1];
                    u32x4 w; w.x = cvt_pk_bf16(silu(a0[0]) * b0[0], silu(a0[1]) * b0[1]); w.y = cvt_pk_bf16(silu(a0[2]) * b0[2], silu(a0[3]) * b0[3]);
                    w.z = cvt_pk_bf16(silu(a1[0]) * b1[0], silu(a1[1]) * b1[1]); w.w = cvt_pk_bf16(silu(a1[2]) * b1[2], silu(a1[3]) * b1[3]);
                    *(u32x4*)rowp = w; }
        } else {
            const int rl0 = wr * 64 + fr, cl0 = wc * 32 + 8 * fq;
            const bf16_t* gbase = PG + (size_t)u.pm * BM * ldc + u.pn * BM + u.br * 1024; bf16_t* obase = O + (size_t)u.pm * BM * ldc + u.pn * BM;
#define MERGE_LOOP(BODY) _Pragma("unroll") for (int ai = 0; ai < 2; ++ai) _Pragma("unroll") for (int m = 0; m < 4; ++m) { _Pragma("unroll") for (int bj = 0; bj < 2; ++bj) _Pragma("unroll") for (int n = 0; n < 2; ++n) { \
                const unsigned rl = rl0 + ai * HALF + m * 16, cl = cl0 + bj * HALF + 4 * n; const unsigned go = rl * (unsigned)ldc + cl, so = rl * 256u + cl; \
                const u32x2 gw = *(const u32x2*)(gbase + go); f32x4 v = acc[ai][bj][m][n]; \
                v[0] *= sigm(bflo(gw.x)); v[1] *= sigm(bfhi(gw.x)); v[2] *= sigm(bflo(gw.y)); v[3] *= sigm(bfhi(gw.y)); BODY } __builtin_amdgcn_sched_barrier(0); }
            if (u.br == 0) { MERGE_LOOP({ *(f32x4*)(scr + so) = v; }) }
            else if (u.br == 1) { MERGE_LOOP({ v += *(const f32x4*)(scr + so); *(f32x4*)(scr + so) = v; }) }
            else { MERGE_LOOP({ v += *(const f32x4*)(scr + so); u32x2 w; w.x = cvt_pk_bf16(v[0], v[1]); w.y = cvt_pk_bf16(v[2], v[3]); *(u32x2*)(obase + go) = w; }) }
#undef MERGE_LOOP
        }
    }
};

template <class Epi>
__device__ __forceinline__ void gemm_phase(LAS unsigned char* lds, const Gemm g, const Order& S, const Epi& E) {
    const int tid = otid(), wid = __builtin_amdgcn_readfirstlane(tid >> 6), lane = tid & 63, wr = wid >> 2, wc = wid & 3, fr = lane & 15, fq = lane >> 4;
    const int K = g.K, nt = K / BK;
    unsigned voffA[2], voffB[2];
#pragma unroll
    for (int i = 0; i < 2; ++i) { int R, C; stage_rc(tid * 16 + i * 8192, R, C); const int Rb = (R & ~31) + perm32(R & 31);
        voffA[i] = (unsigned)(R * g.lda + C) * 2u; voffB[i] = (unsigned)(Rb * g.ldb + C) * 2u; }
    const size_t kstep = (size_t)(BK * 2);
    const size_t hstepA = (size_t)HALF * g.lda * 2, hstepB = (size_t)HALF * g.ldb * 2;
    const size_t tstepA = 2 * hstepA, tstepB = 2 * hstepB;
    const unsigned ldsw = (unsigned)wid * 1024u;
    const int aoff = lds_byte(wr * 64 + fr, fq * 8), boff = lds_byte(wc * 32 + fr, fq * 8);
#define PG8_SA(b, h) (((b) * 2 + (h)) * HTB)
#define PG8_SB(b, h) ((4 + (b) * 2 + (h)) * HTB)
#define PG8_STAGE(bufoff, gbase, voff) do { _Pragma("unroll") for (int _i = 0; _i < 2; ++_i) \
        __builtin_amdgcn_global_load_lds((const unsigned*)((const char*)(gbase) + (voff)[_i]), (LAS unsigned*)(lds + (bufoff) + ldsw + _i * 8192), 16, 0, 0); } while (0)
#define PG8_LDA(dst, b, h) do { _Pragma("unroll") for (int m = 0; m < 4; ++m) _Pragma("unroll") for (int k = 0; k < 2; ++k) dst[m][k] = *(const LAS bf16x8*)(lds + PG8_SA(b, h) + aoff + m * 2048 + k * 1024); } while (0)
#define PG8_LDB(dst, b, h) do { _Pragma("unroll") for (int n = 0; n < 2; ++n) _Pragma("unroll") for (int k = 0; k < 2; ++k) dst[n][k] = *(const LAS bf16x8*)(lds + PG8_SB(b, h) + boff + n * 2048 + k * 1024); } while (0)
#define PG8_MMA(ai, bj, At, Bt) do { __builtin_amdgcn_s_setprio(1); _Pragma("unroll") for (int m = 0; m < 4; ++m) _Pragma("unroll") for (int n = 0; n < 2; ++n) _Pragma("unroll") for (int k = 0; k < 2; ++k) \
        acc[ai][bj][m][n] = __builtin_amdgcn_mfma_f32_16x16x32_bf16(Bt[n][k], At[m][k], acc[ai][bj][m][n], 0, 0, 0); __builtin_amdgcn_s_setprio(0); } while (0)
#define PG8_WAIT_V(n) asm volatile("s_waitcnt vmcnt(" #n ")" ::: "memory")
#define PG8_WAIT_L(n) asm volatile("s_waitcnt lgkmcnt(" #n ")" ::: "memory")
#define PG8_BAR __builtin_amdgcn_s_barrier()
#define PG8_SCHED __builtin_amdgcn_sched_barrier(0)
    Unit cur, nxt; int ui = 0;
    if (!S.next(0, cur)) return;
    f32x4 acc[2][2][4][2];
#pragma unroll
    for (int a = 0; a < 2; ++a)
#pragma unroll
        for (int b = 0; b < 2; ++b)
#pragma unroll
            for (int m = 0; m < 4; ++m)
#pragma unroll
                for (int n = 0; n < 2; ++n) acc[a][b][m][n] = (f32x4){0.f, 0.f, 0.f, 0.f};
    bf16x8 At[4][2], B0[2][2], B1[2][2];
    const char* cA = g.a(cur.br) + (size_t)cur.pm * tstepA; const char* cB = g.b(cur.br) + (size_t)cur.pn * tstepB;
    PG8_STAGE(PG8_SB(0, 0), cB, voffB); PG8_STAGE(PG8_SA(0, 0), cA, voffA); PG8_STAGE(PG8_SB(0, 1), cB + hstepB, voffB); PG8_STAGE(PG8_SA(0, 1), cA + hstepA, voffA);
    if (wr == 1) PG8_BAR;
    PG8_WAIT_V(4); PG8_BAR;
    PG8_STAGE(PG8_SB(1, 0), cB + kstep, voffB); PG8_STAGE(PG8_SA(1, 0), cA + kstep, voffA); PG8_STAGE(PG8_SB(1, 1), cB + hstepB + kstep, voffB);
    PG8_WAIT_V(6); PG8_BAR;
    for (;;) {
        const bool has_next = S.next(ui + 1, nxt);
        const char* nA = has_next ? g.a(nxt.br) + (size_t)nxt.pm * tstepA : cA; const char* nB = has_next ? g.b(nxt.br) + (size_t)nxt.pn * tstepB : cB;
        for (int t = 0; t < nt; t += 2) {
            const bool last = (t == nt - 2);
            const char* a1 = cA + (size_t)(t + 1) * kstep;
            const char* a2 = last ? nA : cA + (size_t)(t + 2) * kstep; const char* b2 = last ? nB : cB + (size_t)(t + 2) * kstep;
            const char* a3 = a2 + kstep; const char* b3 = b2 + kstep;
            PG8_LDB(B0, 0, 0); PG8_SCHED; PG8_LDA(At, 0, 0); PG8_STAGE(PG8_SA(1, 1), a1 + hstepA, voffA);
            PG8_WAIT_L(8); PG8_BAR; PG8_WAIT_L(0); PG8_MMA(0, 0, At, B0); PG8_BAR; PG8_SCHED;
            PG8_LDB(B1, 0, 1); PG8_STAGE(PG8_SB(0, 0), b2, voffB);
            PG8_BAR; PG8_WAIT_L(0); PG8_MMA(0, 1, At, B1); PG8_BAR;
            PG8_LDA(At, 0, 1); PG8_STAGE(PG8_SA(0, 0), a2, voffA);
            PG8_BAR; PG8_WAIT_L(0); PG8_MMA(1, 0, At, B0); PG8_BAR; PG8_SCHED;
            PG8_STAGE(PG8_SB(0, 1), b2 + hstepB, voffB);
            PG8_WAIT_V(6); PG8_BAR; PG8_MMA(1, 1, At, B1); PG8_BAR;
            PG8_LDB(B0, 1, 0); PG8_SCHED; PG8_LDA(At, 1, 0); PG8_STAGE(PG8_SA(0, 1), a2 + hstepA, voffA);
            PG8_WAIT_L(8); PG8_BAR; PG8_WAIT_L(0); PG8_MMA(0, 0, At, B0); PG8_BAR; PG8_SCHED;
            PG8_LDB(B1, 1, 1); PG8_STAGE(PG8_SB(1, 0), b3, voffB);
            PG8_BAR; PG8_WAIT_L(0); PG8_MMA(0, 1, At, B1); PG8_BAR;
            PG8_LDA(At, 1, 1); PG8_STAGE(PG8_SA(1, 0), a3, voffA);
            PG8_BAR; PG8_WAIT_L(0); PG8_MMA(1, 0, At, B0); PG8_BAR; PG8_SCHED;
            PG8_STAGE(PG8_SB(1, 1), b3 + hstepB, voffB);
            PG8_WAIT_V(6); PG8_BAR; PG8_MMA(1, 1, At, B1); PG8_BAR;
        }
        E(acc, cur, wr, wc, fr, fq);
        if (!has_next) break;
#pragma unroll
        for (int a = 0; a < 2; ++a)
#pragma unroll
            for (int b = 0; b < 2; ++b)
#pragma unroll
                for (int m = 0; m < 4; ++m)
#pragma unroll
                    for (int n = 0; n < 2; ++n) acc[a][b][m][n] = (f32x4){0.f, 0.f, 0.f, 0.f};
        cur = nxt; cA = nA; cB = nB; ++ui;
    }
    PG8_WAIT_V(0);
    if (wr == 0) PG8_BAR;
    PG8_BAR;
#undef PG8_SA
#undef PG8_SB
#undef PG8_STAGE
#undef PG8_LDA
#undef PG8_LDB
#undef PG8_MMA
#undef PG8_WAIT_V
#undef PG8_WAIT_L
#undef PG8_BAR
#undef PG8_SCHED
}
}

struct WTile { const float* s; int lds_; bf16_t* d; int ldd; };
__device__ __forceinline__ WTile wconv_decode(const Args& a, int layer, int it) {
    unsigned char* W = a.ws + WS_W;
    const float* w_in = a.in[8] + (size_t)layer * 2 * D * NFF2; const float* w_out = a.in[9] + (size_t)layer * 2 * DFF * D;
    const float* w_mix = a.in[10] + (size_t)layer * D * NMIX; const float* w_br = a.in[24] + (size_t)layer * 3 * 512 * D; const float* w_o = a.in[25] + (size_t)layer * D * D;
    WTile t;
    if (it < 2816) { const int f = it / 1408, r = it % 1408, kt = r / 88, ntile = r % 88, n0 = ntile * 64, tq = n0 >> 8, rr = n0 & 255;
        const int c0 = rr < 128 ? 128 * tq + rr : DFF + 128 * tq + (rr - 128);
        t.s = w_in + (size_t)f * D * NFF2 + (size_t)kt * 64 * NFF2 + c0; t.lds_ = NFF2; t.d = (bf16_t*)(W + W_IN) + (size_t)(1 - f) * NFF2 * D + (size_t)n0 * D + kt * 64; t.ldd = D; }
    else if (it < 4224) { const int j = it - 2816, f = j / 704, r = j % 704, kt = r / 16, ntile = r % 16;
        t.s = w_out + (size_t)f * DFF * D + (size_t)kt * 64 * D + ntile * 64; t.lds_ = D; t.d = (bf16_t*)(W + W_OUT) + (size_t)(1 - f) * D * DFF + (size_t)ntile * 64 * DFF + kt * 64; t.ldd = DFF; }
    else if (it < 6208) { const int j = it - 4224, kt = j / 124, ntile = j % 124, n0 = ntile * 64;
        const int c0 = n0 < 2560 ? n0 : (n0 < 3328 ? 4096 + (n0 - 2560) : (n0 < 4864 ? 2560 + (n0 - 3328) : n0));
        t.s = w_mix + (size_t)kt * 64 * NMIX + c0; t.lds_ = NMIX; t.d = (bf16_t*)(W + W_MIX) + (size_t)n0 * D + kt * 64; t.ldd = D; }
    else if (it < 6592) { const int j = it - 6208, br = j / 128, r = j % 128, kt = r / 16, ntile = r % 16;
        t.s = w_br + (size_t)br * 512 * D + (size_t)kt * 64 * D + ntile * 64; t.lds_ = D; t.d = (bf16_t*)(W + W_BR) + (size_t)br * D * 512 + (size_t)ntile * 64 * 512 + kt * 64; t.ldd = 512; }
    else { const int j = it - 6592, kt = j / 16, ntile = j % 16;
        t.s = w_o + (size_t)kt * 64 * D + ntile * 64; t.lds_ = D; t.d = (bf16_t*)(W + W_O) + (size_t)ntile * 64 * D + kt * 64; t.ldd = D; }
    return t;
}
__device__ __forceinline__ void phase_wconv(LAS unsigned char* L, const Args& a, int layer, int bid, int G) {
    LAS float* tl = (LAS float*)L;
    const int tid = otid(); const int r0 = tid >> 4, c4 = (tid & 15) * 4;
    int it = bid;
    if (it >= 6848) return;
    WTile cur = wconv_decode(a, layer, it);
    f32x4 v0 = *(const f32x4*)(cur.s + (size_t)r0 * cur.lds_ + c4), v1 = *(const f32x4*)(cur.s + (size_t)(r0 + 32) * cur.lds_ + c4);
    for (; it < 6848; it += G) {
        __syncthreads();
        tl[r0 * 65 + c4] = v0[0]; tl[r0 * 65 + c4 + 1] = v0[1]; tl[r0 * 65 + c4 + 2] = v0[2]; tl[r0 * 65 + c4 + 3] = v0[3];
        tl[(r0 + 32) * 65 + c4] = v1[0]; tl[(r0 + 32) * 65 + c4 + 1] = v1[1]; tl[(r0 + 32) * 65 + c4 + 2] = v1[2]; tl[(r0 + 32) * 65 + c4 + 3] = v1[3];
        __syncthreads();
        WTile nxt = cur;
        if (it + G < 6848) { nxt = wconv_decode(a, layer, it + G); v0 = *(const f32x4*)(nxt.s + (size_t)r0 * nxt.lds_ + c4); v1 = *(const f32x4*)(nxt.s + (size_t)(r0 + 32) * nxt.lds_ + c4); }
        { const int n = tid >> 3, kc = (tid & 7) * 8; float f[8];
#pragma unroll
          for (int j = 0; j < 8; ++j) f[j] = tl[(kc + j) * 65 + n];
          *(u32x4*)(cur.d + (size_t)n * cur.ldd + kc) = pack8(f); }
        cur = nxt;
    }
    __syncthreads();
}

__device__ __forceinline__ void phase_mods(LAS unsigned char* L, const Args& a, int bid, int G) {
    LAS float* sc = (LAS float*)L;
    LAS float* red = sc + 3 * 1024;
    const int tid = otid();
    float* mods = (float*)(a.ws + WS_MISC + MI_MODS);
    for (int e = tid; e < 3 * 1024; e += 512) { const int v = e >> 10, k = e & 1023; const float x = v < 2 ? a.in[1][v * 1024 + k] : a.in[3][k]; sc[e] = silu(x); }
    __syncthreads();
    for (int it = bid; it < 288; it += G) {
        const int layer = it / 144, n = (it % 144) * 64 + (tid & 63), kq = tid >> 6;
        const float* w = a.in[4] + (size_t)layer * D * NMOD + n;
        float s0 = 0.f, s1 = 0.f, s2 = 0.f;
#pragma unroll 8
        for (int k = kq * 128; k < kq * 128 + 128; ++k) { const float wv = w[(size_t)k * NMOD]; s0 += sc[k] * wv; s1 += sc[1024 + k] * wv; s2 += sc[2048 + k] * wv; }
        red[(kq * 3 + 0) * 64 + (tid & 63)] = s0; red[(kq * 3 + 1) * 64 + (tid & 63)] = s1; red[(kq * 3 + 2) * 64 + (tid & 63)] = s2;
        __syncthreads();
        if (tid < 192) { const int v = tid >> 6, c = tid & 63; const int nn = (it % 144) * 64 + c; float s = 0.f;
#pragma unroll
            for (int q = 0; q < 8; ++q) s += red[(q * 3 + v) * 64 + c];
            mods[((size_t)layer * 3 + v) * NMOD + nn] = s + a.in[5][(size_t)layer * NMOD + nn]; }
        __syncthreads();
    }
    const int gt = bid * 512 + tid;
    if (gt < 4096) { const int pos = gt >> 4, f = gt & 15; const float inv = __builtin_amdgcn_exp2f(-(float)f * (13.287712379549449f / 16.0f)); const float ang = (float)pos * inv;
        float* tab = (float*)(a.ws + WS_MISC + MI_TAB); tab[gt * 2] = __cosf(ang); tab[gt * 2 + 1] = __sinf(ang); }
    if (gt < 3072) ((float*)(a.ws + WS_MISC + MI_L1))[gt] = 0.f;
}

struct LnP { const float* hs_lat; const float* hs_ctx; float* hd_lat; float* hd_ctx; const bf16_t* y; int ldy; const float* mods; int gi; float coef; const float* g; const float* b; const float* mods_u; int si; bf16_t* u; int rows; int mode; };
__device__ __forceinline__ void phase_ln(const LnP& p, int bid, int G) {
    const int tid_ = otid(); const int lane = tid_ & 63, wv = tid_ >> 6;
    const int nw = G * 8, wid = bid * 8 + wv;
    const int per = (MROWS + nw - 1) / nw;
    const int r0 = wid * per, r1 = min(p.rows, r0 + per);
    if (r0 >= r1) return;
    f32x4 t[4], tn[4]; u32x2 yw[4], ywn[4];
#define LN_LOAD(R, T_, Y_) { const int rr = (R); const float* hs = rr < NLAT ? p.hs_lat + (size_t)rr * D : p.hs_ctx + (size_t)(rr - NLAT) * D; \
        _Pragma("unroll") for (int i = 0; i < 4; ++i) { T_[i] = *(const f32x4*)(hs + 4 * lane + 256 * i); Y_[i] = p.mode != 0 ? *(const u32x2*)(p.y + (size_t)rr * p.ldy + 4 * lane + 256 * i) : *(const u32x2*)(hs + 4 * lane + 256 * i); } }
    LN_LOAD(r0, t, yw)
    for (int r = r0; r < r1; ++r) {
        if (r + 1 < r1) LN_LOAD(r + 1, tn, ywn)
        const int v = r < SEQ ? 0 : (r < NLAT ? 1 : 2);
        if (p.mode != 0) {
            const float* gate = p.mods + (size_t)v * NMOD + p.gi * 1024;
            float s = 0.f;
#pragma unroll
            for (int i = 0; i < 4; ++i) { const f32x4 gv = *(const f32x4*)(gate + 4 * lane + 256 * i);
                t[i][0] = DN_ALPHA * t[i][0] + p.coef * gv[0] * bflo(yw[i].x); t[i][1] = DN_ALPHA * t[i][1] + p.coef * gv[1] * bfhi(yw[i].x);
                t[i][2] = DN_ALPHA * t[i][2] + p.coef * gv[2] * bflo(yw[i].y); t[i][3] = DN_ALPHA * t[i][3] + p.coef * gv[3] * bfhi(yw[i].y);
                s += (t[i][0] + t[i][1]) + (t[i][2] + t[i][3]); }
#pragma unroll
            for (int o = 32; o >= 1; o >>= 1) s += __shfl_xor(s, o);
            const float mean = s * (1.0f / 1024.0f); float q = 0.f;
#pragma unroll
            for (int i = 0; i < 4; ++i) { const f32x4 d = t[i] - mean; q += (d[0] * d[0] + d[1] * d[1]) + (d[2] * d[2] + d[3] * d[3]); }
#pragma unroll
            for (int o = 32; o >= 1; o >>= 1) q += __shfl_xor(q, o);
            const float rstd = rsqrtf(q * (1.0f / 1024.0f) + 1e-5f);
            float* hd = r < NLAT ? p.hd_lat + (size_t)r * D : p.hd_ctx + (size_t)(r - NLAT) * D;
#pragma unroll
            for (int i = 0; i < 4; ++i) { const int c = 4 * lane + 256 * i; const f32x4 gv = *(const f32x4*)(p.g + c), bv = *(const f32x4*)(p.b + c);
                t[i] = (t[i] - mean) * rstd * gv + bv; *(f32x4*)(hd + c) = t[i]; }
        }
        if (p.mode != 2) {
            const float* sh = p.mods_u + (size_t)v * NMOD + p.si * 1024; const float* scl = sh + 1024;
#pragma unroll
            for (int i = 0; i < 4; ++i) { const int c = 4 * lane + 256 * i; const f32x4 sv = *(const f32x4*)(sh + c), cv = *(const f32x4*)(scl + c);
                const f32x4 o = t[i] * (1.0f + cv) + sv; u32x2 w; w.x = cvt_pk_bf16(o[0], o[1]); w.y = cvt_pk_bf16(o[2], o[3]);
                *(u32x2*)(p.u + (size_t)r * D + c) = w; }
        }
#pragma unroll
        for (int i = 0; i < 4; ++i) { t[i] = tn[i]; yw[i] = ywn[i]; }
    }
#undef LN_LOAD
}

__device__ __forceinline__ int hgrn_row(int s, int dir, int b) {
    if (s < LCTX) { const int c = dir ? (LCTX - 1 - s) : s; return NLAT + b * LCTX + c; }
    const int t = s - LCTX; const int pos = dir ? (SEQ - 1 - t) : t; return b * SEQ + pos;
}
typedef float f32x4v __attribute__((ext_vector_type(4)));
constexpr int NGRP = MROWS / 16;
__device__ __forceinline__ void hgrn_prepass(bf16_t* PAC, bf16_t* QB, float* DB, const float* lbsrc, int layer, int bid, int G) {
    const int col = otid();
    float lbf = 0.f, lbb = 0.f;
    if (layer == 1) { const float a0 = lbsrc[(0 * 2 + 0) * 512 + col], a1 = lbsrc[(1 * 2 + 0) * 512 + col], c0 = lbsrc[(0 * 2 + 1) * 512 + col], c1 = lbsrc[(1 * 2 + 1) * 512 + col];
        lbf = 1.f / (1.f + __expf(a0 - a1)); lbb = 1.f / (1.f + __expf(c0 - c1)); }
    for (int g = bid; g < NGRP; g += G) {
        bf16_t* base = PAC + (size_t)g * 16 * NAC;
        float q[16], ff[16], fb[16];
#pragma unroll
        for (int t = 0; t < 16; ++t) { const bf16_t* rp = base + (size_t)t * NAC; q[t] = bf2f(rp[col]); ff[t] = lbf + (1.f - lbf) * sigm(bf2f(rp[1536 + col])); fb[t] = lbb + (1.f - lbb) * sigm(bf2f(rp[2048 + col])); }
        float p = 1.f;
#pragma unroll
        for (int t = 0; t < 16; ++t) { p *= ff[t]; const float E = fmaxf(p, 1e-30f); bf16_t* rp = base + (size_t)t * NAC; rp[col] = f2bf(q[t] * E); rp[1536 + col] = f2bf((1.f - ff[t]) * __builtin_amdgcn_rcpf(E)); }
        DB[(size_t)g * 512 + col] = p;
        p = 1.f;
#pragma unroll
        for (int t = 15; t >= 0; --t) { p *= fb[t]; const float E = fmaxf(p, 1e-30f); bf16_t* rp = base + (size_t)t * NAC; QB[((size_t)g * 16 + t) * 512 + col] = f2bf(q[t] * E); rp[2048 + col] = f2bf((1.f - fb[t]) * __builtin_amdgcn_rcpf(E)); }
        DB[((size_t)NGRP + g) * 512 + col] = p;
    }
}
__device__ __forceinline__ void hgrn_scan_item(LAS unsigned char* L, int item, const bf16_t* PAC, const bf16_t* QB, const float* DB, bf16_t* OF, bf16_t* OB) {
    const int vs = item & 7, h = (item >> 3) & 3, b = (item >> 5) & 1, dir = item >> 6;
    const int tid = otid(), wave = tid >> 6, lane = tid & 63, l15 = lane & 15, g4 = lane >> 4;
    LAS bf16_t* Qs = (LAS bf16_t*)L;
    LAS bf16_t* Ks = Qs + 64 * 136;
    LAS bf16_t* KT = Ks + 64 * 136;
    LAS bf16_t* VT = KT + 4 * 128 * 40;
    LAS bf16_t* As = VT + 4 * 16 * 40;
    LAS float* Ds = (LAS float*)(As + 4 * 16 * 40);
    LAS float* O2s = Ds + 4 * 128;
    LAS float* Pp = O2s + 4 * 256;
    __syncthreads();
    for (int e2 = tid; e2 < (4 * 128 * 40 + 4 * 16 * 40 + 4 * 16 * 40) / 2; e2 += 512) ((LAS unsigned*)KT)[e2] = 0u;
    __syncthreads();
    f32x4v accS = (f32x4v){0.f, 0.f, 0.f, 0.f};
    bf16_t* Od = dir ? OB : OF;
    const bf16_t* Qsrc = dir ? QB : PAC; const int qld = dir ? 512 : NAC;
    const int kcol = (dir ? 2048 : 1536) + h * 128, qcol = h * 128, icol = 512 + h * 128 + vs * 16;
    const int st = tid >> 3, kc = (tid & 7) * 16;
    constexpr int NSTEP = LCTX + SEQ;
    u32x4 pq0A, pq1A, pk0A, pk1A, piA = (u32x4){0, 0, 0, 0}, pq0B, pq1B, pk0B, pk1B, piB = (u32x4){0, 0, 0, 0}, pq0C, pq1C, pk0C, pk1C, piC = (u32x4){0, 0, 0, 0}, pq0D, pq1D, pk0D, pk1D, piD = (u32x4){0, 0, 0, 0}; float pdA = 0.f, pdB = 0.f, pdC = 0.f, pdD = 0.f;
#define HG_LOAD(S0_, X) { const int row = hgrn_row((S0_) + st, dir, b); const bf16_t* qp = Qsrc + (size_t)row * qld + qcol + kc; const bf16_t* kp = PAC + (size_t)row * NAC + kcol + kc; \
      pq0##X = *(const u32x4*)qp; pq1##X = *(const u32x4*)(qp + 8); pk0##X = *(const u32x4*)kp; pk1##X = *(const u32x4*)(kp + 8); \
      if (tid < 128) { const int row2 = hgrn_row((S0_) + (tid >> 1), dir, b); pi##X = *(const u32x4*)(PAC + (size_t)row2 * NAC + icol + (tid & 1) * 8); } \
      { const int rowc = hgrn_row((S0_) + (tid >> 7) * 16, dir, b); pd##X = DB[((size_t)dir * NGRP + (rowc >> 4)) * 512 + h * 128 + (tid & 127)]; } }
    HG_LOAD(0, A) HG_LOAD(64, B) HG_LOAD(128, C) HG_LOAD(192, D)
    for (int s0 = 0; s0 < NSTEP; s0 += 256) {
      {
        { const int c = st >> 4, sl = st & 15;
          *(LAS u32x4*)(Qs + st * 136 + kc) = pq0A; *(LAS u32x4*)(Qs + st * 136 + kc + 8) = pq1A; *(LAS u32x4*)(Ks + st * 136 + kc) = pk0A; *(LAS u32x4*)(Ks + st * 136 + kc + 8) = pk1A;
          Ds[tid] = pdA; }
        if (tid < 128) { const unsigned vw[4] = {piA.x, piA.y, piA.z, piA.w}; const int tk = tid >> 1, c = tk >> 4, sl = tk & 15;
#pragma unroll
            for (int e = 0; e < 4; ++e) { VT[(c * 16 + (tid & 1) * 8 + 2 * e) * 40 + sl] = (bf16_t)(vw[e] & 0xffffu); VT[(c * 16 + (tid & 1) * 8 + 2 * e + 1) * 40 + sl] = (bf16_t)(vw[e] >> 16); } }
        __syncthreads();
        if (s0 + 0 + 256 < NSTEP) HG_LOAD(s0 + 0 + 256, A)
        if (wave >= 1 && wave <= 4) { const int c = wave - 1;
            f32x4v sc = (f32x4v){0.f, 0.f, 0.f, 0.f};
#pragma unroll
            for (int ks = 0; ks < 4; ++ks) { const bf16x8 af = *(const LAS bf16x8*)(Qs + (c * 16 + l15) * 136 + 32 * ks + 8 * g4), kfv = *(const LAS bf16x8*)(Ks + (c * 16 + l15) * 136 + 32 * ks + 8 * g4);
                sc = __builtin_amdgcn_mfma_f32_16x16x32_bf16(af, kfv, sc, 0, 0, 0); }
#pragma unroll
            for (int rg = 0; rg < 4; ++rg) { const int t = 4 * g4 + rg; As[(c * 16 + t) * 40 + l15] = f2bf(l15 <= t ? sc[rg] : 0.f); }
            asm volatile("s_waitcnt lgkmcnt(0)" ::: "memory");
            const bf16x8 af2 = *(const LAS bf16x8*)(As + (c * 16 + l15) * 40 + 8 * g4), vfv = *(const LAS bf16x8*)(VT + (c * 16 + l15) * 40 + 8 * g4);
            f32x4v o2 = (f32x4v){0.f, 0.f, 0.f, 0.f}; o2 = __builtin_amdgcn_mfma_f32_16x16x32_bf16(af2, vfv, o2, 0, 0, 0);
#pragma unroll
            for (int rg = 0; rg < 4; ++rg) O2s[(c * 16 + 4 * g4 + rg) * 16 + l15] = o2[rg];
        }
        __syncthreads();
#pragma unroll 1
        for (int c = 0; c < 4; ++c) {
            { const u32x2 qa = *(const LAS u32x2*)(Qs + (c * 16 + l15) * 136 + 16 * wave + 4 * g4);
              const bf16x8 af = __builtin_bit_cast(bf16x8, ((u32x4){qa.x, qa.y, 0u, 0u})), sfv = __builtin_bit_cast(bf16x8, ((u32x4){cvt_pk_bf16_sw(accS[0], accS[1]), cvt_pk_bf16_sw(accS[2], accS[3]), 0u, 0u}));
              f32x4v po = (f32x4v){0.f, 0.f, 0.f, 0.f}; po = __builtin_amdgcn_mfma_f32_16x16x32_bf16(af, sfv, po, 0, 0, 0);
#pragma unroll
              for (int rg = 0; rg < 4; ++rg) Pp[((c * 8 + wave) * 16 + 4 * g4 + rg) * 16 + l15] = po[rg]; }
            { const LAS bf16_t* kg_ = Ks + (c * 16 + 8 * (g4 & 1)) * 136 + 16 * wave + l15;
              const unsigned m_ = g4 < 2 ? 0xffffffffu : 0u;
              const u32x4 aw_ = (u32x4){((unsigned)kg_[0] | ((unsigned)kg_[136] << 16)) & m_, ((unsigned)kg_[2 * 136] | ((unsigned)kg_[3 * 136] << 16)) & m_, ((unsigned)kg_[4 * 136] | ((unsigned)kg_[5 * 136] << 16)) & m_, ((unsigned)kg_[6 * 136] | ((unsigned)kg_[7 * 136] << 16)) & m_};
              const bf16x8 af = __builtin_bit_cast(bf16x8, aw_), bfv = *(const LAS bf16x8*)(VT + (c * 16 + l15) * 40 + 8 * g4);
              const f32x4v dv = *(const LAS f32x4v*)(Ds + c * 128 + 16 * wave + 4 * g4);
              accS = __builtin_amdgcn_mfma_f32_16x16x32_bf16(af, bfv, accS, 0, 0, 0); accS = accS * dv; }
        }
        __syncthreads();
        { const int c = tid >> 7, t = (tid >> 3) & 15, v2 = (tid & 7) * 2; f32x2 sum = *(const LAS f32x2*)(O2s + (c * 16 + t) * 16 + v2);
#pragma unroll
          for (int w = 0; w < 8; ++w) sum += *(const LAS f32x2*)(Pp + ((c * 8 + w) * 16 + t) * 16 + v2);
          const int row = hgrn_row((s0 + 0) + c * 16 + t, dir, b); *(unsigned*)(Od + (size_t)row * 512 + h * 128 + vs * 16 + v2) = cvt_pk_bf16(sum[0], sum[1]); }

      }
      {
        { const int c = st >> 4, sl = st & 15;
          *(LAS u32x4*)(Qs + st * 136 + kc) = pq0B; *(LAS u32x4*)(Qs + st * 136 + kc + 8) = pq1B; *(LAS u32x4*)(Ks + st * 136 + kc) = pk0B; *(LAS u32x4*)(Ks + st * 136 + kc + 8) = pk1B;
          Ds[tid] = pdB; }
        if (tid < 128) { const unsigned vw[4] = {piB.x, piB.y, piB.z, piB.w}; const int tk = tid >> 1, c = tk >> 4, sl = tk & 15;
#pragma unroll
            for (int e = 0; e < 4; ++e) { VT[(c * 16 + (tid & 1) * 8 + 2 * e) * 40 + sl] = (bf16_t)(vw[e] & 0xffffu); VT[(c * 16 + (tid & 1) * 8 + 2 * e + 1) * 40 + sl] = (bf16_t)(vw[e] >> 16); } }
        __syncthreads();
        if (s0 + 64 + 256 < NSTEP) HG_LOAD(s0 + 64 + 256, B)
        if (wave >= 1 && wave <= 4) { const int c = wave - 1;
            f32x4v sc = (f32x4v){0.f, 0.f, 0.f, 0.f};
#pragma unroll
            for (int ks = 0; ks < 4; ++ks) { const bf16x8 af = *(const LAS bf16x8*)(Qs + (c * 16 + l15) * 136 + 32 * ks + 8 * g4), kfv = *(const LAS bf16x8*)(Ks + (c * 16 + l15) * 136 + 32 * ks + 8 * g4);
                sc = __builtin_amdgcn_mfma_f32_16x16x32_bf16(af, kfv, sc, 0, 0, 0); }
#pragma unroll
            for (int rg = 0; rg < 4; ++rg) { const int t = 4 * g4 + rg; As[(c * 16 + t) * 40 + l15] = f2bf(l15 <= t ? sc[rg] : 0.f); }
            asm volatile("s_waitcnt lgkmcnt(0)" ::: "memory");
            const bf16x8 af2 = *(const LAS bf16x8*)(As + (c * 16 + l15) * 40 + 8 * g4), vfv = *(const LAS bf16x8*)(VT + (c * 16 + l15) * 40 + 8 * g4);
            f32x4v o2 = (f32x4v){0.f, 0.f, 0.f, 0.f}; o2 = __builtin_amdgcn_mfma_f32_16x16x32_bf16(af2, vfv, o2, 0, 0, 0);
#pragma unroll
            for (int rg = 0; rg < 4; ++rg) O2s[(c * 16 + 4 * g4 + rg) * 16 + l15] = o2[rg];
        }
        __syncthreads();
#pragma unroll 1
        for (int c = 0; c < 4; ++c) {
            { const u32x2 qa = *(const LAS u32x2*)(Qs + (c * 16 + l15) * 136 + 16 * wave + 4 * g4);
              const bf16x8 af = __builtin_bit_cast(bf16x8, ((u32x4){qa.x, qa.y, 0u, 0u})), sfv = __builtin_bit_cast(bf16x8, ((u32x4){cvt_pk_bf16_sw(accS[0], accS[1]), cvt_pk_bf16_sw(accS[2], accS[3]), 0u, 0u}));
              f32x4v po = (f32x4v){0.f, 0.f, 0.f, 0.f}; po = __builtin_amdgcn_mfma_f32_16x16x32_bf16(af, sfv, po, 0, 0, 0);
#pragma unroll
              for (int rg = 0; rg < 4; ++rg) Pp[((c * 8 + wave) * 16 + 4 * g4 + rg) * 16 + l15] = po[rg]; }
            { const LAS bf16_t* kg_ = Ks + (c * 16 + 8 * (g4 & 1)) * 136 + 16 * wave + l15;
              const unsigned m_ = g4 < 2 ? 0xffffffffu : 0u;
              const u32x4 aw_ = (u32x4){((unsigned)kg_[0] | ((unsigned)kg_[136] << 16)) & m_, ((unsigned)kg_[2 * 136] | ((unsigned)kg_[3 * 136] << 16)) & m_, ((unsigned)kg_[4 * 136] | ((unsigned)kg_[5 * 136] << 16)) & m_, ((unsigned)kg_[6 * 136] | ((unsigned)kg_[7 * 136] << 16)) & m_};
              const bf16x8 af = __builtin_bit_cast(bf16x8, aw_), bfv = *(const LAS bf16x8*)(VT + (c * 16 + l15) * 40 + 8 * g4);
              const f32x4v dv = *(const LAS f32x4v*)(Ds + c * 128 + 16 * wave + 4 * g4);
              accS = __builtin_amdgcn_mfma_f32_16x16x32_bf16(af, bfv, accS, 0, 0, 0); accS = accS * dv; }
        }
        __syncthreads();
        { const int c = tid >> 7, t = (tid >> 3) & 15, v2 = (tid & 7) * 2; f32x2 sum = *(const LAS f32x2*)(O2s + (c * 16 + t) * 16 + v2);
#pragma unroll
          for (int w = 0; w < 8; ++w) sum += *(const LAS f32x2*)(Pp + ((c * 8 + w) * 16 + t) * 16 + v2);
          const int row = hgrn_row((s0 + 64) + c * 16 + t, dir, b); *(unsigned*)(Od + (size_t)row * 512 + h * 128 + vs * 16 + v2) = cvt_pk_bf16(sum[0], sum[1]); }

      }
      {
        { const int c = st >> 4, sl = st & 15;
          *(LAS u32x4*)(Qs + st * 136 + kc) = pq0C; *(LAS u32x4*)(Qs + st * 136 + kc + 8) = pq1C; *(LAS u32x4*)(Ks + st * 136 + kc) = pk0C; *(LAS u32x4*)(Ks + st * 136 + kc + 8) = pk1C;
          Ds[tid] = pdC; }
        if (tid < 128) { const unsigned vw[4] = {piC.x, piC.y, piC.z, piC.w}; const int tk = tid >> 1, c = tk >> 4, sl = tk & 15;
#pragma unroll
            for (int e = 0; e < 4; ++e) { VT[(c * 16 + (tid & 1) * 8 + 2 * e) * 40 + sl] = (bf16_t)(vw[e] & 0xffffu); VT[(c * 16 + (tid & 1) * 8 + 2 * e + 1) * 40 + sl] = (bf16_t)(vw[e] >> 16); } }
        __syncthreads();
        if (s0 + 128 + 256 < NSTEP) HG_LOAD(s0 + 128 + 256, C)
        if (wave >= 1 && wave <= 4) { const int c = wave - 1;
            f32x4v sc = (f32x4v){0.f, 0.f, 0.f, 0.f};
#pragma unroll
            for (int ks = 0; ks < 4; ++ks) { const bf16x8 af = *(const LAS bf16x8*)(Qs + (c * 16 + l15) * 136 + 32 * ks + 8 * g4), kfv = *(const LAS bf16x8*)(Ks + (c * 16 + l15) * 136 + 32 * ks + 8 * g4);
                sc = __builtin_amdgcn_mfma_f32_16x16x32_bf16(af, kfv, sc, 0, 0, 0); }
#pragma unroll
            for (int rg = 0; rg < 4; ++rg) { const int t = 4 * g4 + rg; As[(c * 16 + t) * 40 + l15] = f2bf(l15 <= t ? sc[rg] : 0.f); }
            asm volatile("s_waitcnt lgkmcnt(0)" ::: "memory");
            const bf16x8 af2 = *(const LAS bf16x8*)(As + (c * 16 + l15) * 40 + 8 * g4), vfv = *(const LAS bf16x8*)(VT + (c * 16 + l15) * 40 + 8 * g4);
            f32x4v o2 = (f32x4v){0.f, 0.f, 0.f, 0.f}; o2 = __builtin_amdgcn_mfma_f32_16x16x32_bf16(af2, vfv, o2, 0, 0, 0);
#pragma unroll
            for (int rg = 0; rg < 4; ++rg) O2s[(c * 16 + 4 * g4 + rg) * 16 + l15] = o2[rg];
        }
        __syncthreads();
#pragma unroll 1
        for (int c = 0; c < 4; ++c) {
            { const u32x2 qa = *(const LAS u32x2*)(Qs + (c * 16 + l15) * 136 + 16 * wave + 4 * g4);
              const bf16x8 af = __builtin_bit_cast(bf16x8, ((u32x4){qa.x, qa.y, 0u, 0u})), sfv = __builtin_bit_cast(bf16x8, ((u32x4){cvt_pk_bf16_sw(accS[0], accS[1]), cvt_pk_bf16_sw(accS[2], accS[3]), 0u, 0u}));
              f32x4v po = (f32x4v){0.f, 0.f, 0.f, 0.f}; po = __builtin_amdgcn_mfma_f32_16x16x32_bf16(af, sfv, po, 0, 0, 0);
#pragma unroll
              for (int rg = 0; rg < 4; ++rg) Pp[((c * 8 + wave) * 16 + 4 * g4 + rg) * 16 + l15] = po[rg]; }
            { const LAS bf16_t* kg_ = Ks + (c * 16 + 8 * (g4 & 1)) * 136 + 16 * wave + l15;
              const unsigned m_ = g4 < 2 ? 0xffffffffu : 0u;
              const u32x4 aw_ = (u32x4){((unsigned)kg_[0] | ((unsigned)kg_[136] << 16)) & m_, ((unsigned)kg_[2 * 136] | ((unsigned)kg_[3 * 136] << 16)) & m_, ((unsigned)kg_[4 * 136] | ((unsigned)kg_[5 * 136] << 16)) & m_, ((unsigned)kg_[6 * 136] | ((unsigned)kg_[7 * 136] << 16)) & m_};
              const bf16x8 af = __builtin_bit_cast(bf16x8, aw_), bfv = *(const LAS bf16x8*)(VT + (c * 16 + l15) * 40 + 8 * g4);
              const f32x4v dv = *(const LAS f32x4v*)(Ds + c * 128 + 16 * wave + 4 * g4);
              accS = __builtin_amdgcn_mfma_f32_16x16x32_bf16(af, bfv, accS, 0, 0, 0); accS = accS * dv; }
        }
        __syncthreads();
        { const int c = tid >> 7, t = (tid >> 3) & 15, v2 = (tid & 7) * 2; f32x2 sum = *(const LAS f32x2*)(O2s + (c * 16 + t) * 16 + v2);
#pragma unroll
          for (int w = 0; w < 8; ++w) sum += *(const LAS f32x2*)(Pp + ((c * 8 + w) * 16 + t) * 16 + v2);
          const int row = hgrn_row((s0 + 128) + c * 16 + t, dir, b); *(unsigned*)(Od + (size_t)row * 512 + h * 128 + vs * 16 + v2) = cvt_pk_bf16(sum[0], sum[1]); }

      }
      {
        { const int c = st >> 4, sl = st & 15;
          *(LAS u32x4*)(Qs + st * 136 + kc) = pq0D; *(LAS u32x4*)(Qs + st * 136 + kc + 8) = pq1D; *(LAS u32x4*)(Ks + st * 136 + kc) = pk0D; *(LAS u32x4*)(Ks + st * 136 + kc + 8) = pk1D;
          Ds[tid] = pdD; }
        if (tid < 128) { const unsigned vw[4] = {piD.x, piD.y, piD.z, piD.w}; const int tk = tid >> 1, c = tk >> 4, sl = tk & 15;
#pragma unroll
            for (int e = 0; e < 4; ++e) { VT[(c * 16 + (tid & 1) * 8 + 2 * e) * 40 + sl] = (bf16_t)(vw[e] & 0xffffu); VT[(c * 16 + (tid & 1) * 8 + 2 * e + 1) * 40 + sl] = (bf16_t)(vw[e] >> 16); } }
        __syncthreads();
        if (s0 + 192 + 256 < NSTEP) HG_LOAD(s0 + 192 + 256, D)
        if (wave >= 1 && wave <= 4) { const int c = wave - 1;
            f32x4v sc = (f32x4v){0.f, 0.f, 0.f, 0.f};
#pragma unroll
            for (int ks = 0; ks < 4; ++ks) { const bf16x8 af = *(const LAS bf16x8*)(Qs + (c * 16 + l15) * 136 + 32 * ks + 8 * g4), kfv = *(const LAS bf16x8*)(Ks + (c * 16 + l15) * 136 + 32 * ks + 8 * g4);
                sc = __builtin_amdgcn_mfma_f32_16x16x32_bf16(af, kfv, sc, 0, 0, 0); }
#pragma unroll
            for (int rg = 0; rg < 4; ++rg) { const int t = 4 * g4 + rg; As[(c * 16 + t) * 40 + l15] = f2bf(l15 <= t ? sc[rg] : 0.f); }
            asm volatile("s_waitcnt lgkmcnt(0)" ::: "memory");
            const bf16x8 af2 = *(const LAS bf16x8*)(As + (c * 16 + l15) * 40 + 8 * g4), vfv = *(const LAS bf16x8*)(VT + (c * 16 + l15) * 40 + 8 * g4);
            f32x4v o2 = (f32x4v){0.f, 0.f, 0.f, 0.f}; o2 = __builtin_amdgcn_mfma_f32_16x16x32_bf16(af2, vfv, o2, 0, 0, 0);
#pragma unroll
            for (int rg = 0; rg < 4; ++rg) O2s[(c * 16 + 4 * g4 + rg) * 16 + l15] = o2[rg];
        }
        __syncthreads();
#pragma unroll 1
        for (int c = 0; c < 4; ++c) {
            { const u32x2 qa = *(const LAS u32x2*)(Qs + (c * 16 + l15) * 136 + 16 * wave + 4 * g4);
              const bf16x8 af = __builtin_bit_cast(bf16x8, ((u32x4){qa.x, qa.y, 0u, 0u})), sfv = __builtin_bit_cast(bf16x8, ((u32x4){cvt_pk_bf16_sw(accS[0], accS[1]), cvt_pk_bf16_sw(accS[2], accS[3]), 0u, 0u}));
              f32x4v po = (f32x4v){0.f, 0.f, 0.f, 0.f}; po = __builtin_amdgcn_mfma_f32_16x16x32_bf16(af, sfv, po, 0, 0, 0);
#pragma unroll
              for (int rg = 0; rg < 4; ++rg) Pp[((c * 8 + wave) * 16 + 4 * g4 + rg) * 16 + l15] = po[rg]; }
            { const LAS bf16_t* kg_ = Ks + (c * 16 + 8 * (g4 & 1)) * 136 + 16 * wave + l15;
              const unsigned m_ = g4 < 2 ? 0xffffffffu : 0u;
              const u32x4 aw_ = (u32x4){((unsigned)kg_[0] | ((unsigned)kg_[136] << 16)) & m_, ((unsigned)kg_[2 * 136] | ((unsigned)kg_[3 * 136] << 16)) & m_, ((unsigned)kg_[4 * 136] | ((unsigned)kg_[5 * 136] << 16)) & m_, ((unsigned)kg_[6 * 136] | ((unsigned)kg_[7 * 136] << 16)) & m_};
              const bf16x8 af = __builtin_bit_cast(bf16x8, aw_), bfv = *(const LAS bf16x8*)(VT + (c * 16 + l15) * 40 + 8 * g4);
              const f32x4v dv = *(const LAS f32x4v*)(Ds + c * 128 + 16 * wave + 4 * g4);
              accS = __builtin_amdgcn_mfma_f32_16x16x32_bf16(af, bfv, accS, 0, 0, 0); accS = accS * dv; }
        }
        __syncthreads();
        { const int c = tid >> 7, t = (tid >> 3) & 15, v2 = (tid & 7) * 2; f32x2 sum = *(const LAS f32x2*)(O2s + (c * 16 + t) * 16 + v2);
#pragma unroll
          for (int w = 0; w < 8; ++w) sum += *(const LAS f32x2*)(Pp + ((c * 8 + w) * 16 + t) * 16 + v2);
          const int row = hgrn_row((s0 + 192) + c * 16 + t, dir, b); *(unsigned*)(Od + (size_t)row * 512 + h * 128 + vs * 16 + v2) = cvt_pk_bf16(sum[0], sum[1]); }

      }
    }
#undef HG_LOAD
}
__device__ __forceinline__ void phase_readout(const bf16_t* PAC, bf16_t* OF, const bf16_t* OB, const float* nw, int rows, int bid, int G) {
    const int tid_ = otid(); const int lane = tid_ & 63, wv = tid_ >> 6;
    for (int r = bid * 8 + wv; r < rows; r += G * 8) {
        float a[8], c[8], gg[8];
        unpack8(*(const u32x4*)(OF + (size_t)r * 512 + lane * 8), a); unpack8(*(const u32x4*)(OB + (size_t)r * 512 + lane * 8), c); unpack8(*(const u32x4*)(PAC + (size_t)r * NAC + 1024 + lane * 8), gg);
        float q = 0.f;
#pragma unroll
        for (int j = 0; j < 8; ++j) { a[j] += c[j]; q += a[j] * a[j]; }
        q += __shfl_xor(q, 1); q += __shfl_xor(q, 2); q += __shfl_xor(q, 4); q += __shfl_xor(q, 8);
        const float rs = rsqrtf(q * (1.0f / 128.0f) + 1e-6f);
#pragma unroll
        for (int j = 0; j < 8; ++j) a[j] = a[j] * rs * nw[lane * 8 + j] * silu(gg[j]);
        *(u32x4*)(OF + (size_t)r * 512 + lane * 8) = pack8(a);
    }
}

__device__ __forceinline__ void attn_item(LAS unsigned char* L, int item, const bf16_t* PAC, const float* tab, const float* sink, bf16_t* YC) {
    const bool isctx = item >= 1024;
    int n, hk, b;
    if (!isctx) { n = item & 255; hk = (item >> 8) & 1; b = item >> 9; } else { const int j = item - 1024; n = j & 3; hk = (j >> 2) & 1; b = j >> 3; }
    LAS bf16_t* Ks = (LAS bf16_t*)L;
    LAS bf16_t* Vt = Ks + 64 * 72;
    const int tid = otid(), wave = tid >> 6, lane = tid & 63, c32 = lane & 31, hi = lane >> 5;
    const int g = wave >> 1, qt = wave & 1, head = hk * 4 + g;
    const float qscale = 0.125f * 1.44269504089f;
    const int qi = n * 64 + qt * 32 + c32;
    const int qrow = isctx ? NLAT + b * LCTX + qi : b * SEQ + qi;
    bf16x8 qf[4];
    {
        const bf16_t* qp = PAC + (size_t)qrow * NAC + 2560 + head * 64 + 8 * hi;
        float x0[8], x1[8], x2[8], x3[8];
        unpack8(*(const u32x4*)(qp), x0); unpack8(*(const u32x4*)(qp + 16), x1); unpack8(*(const u32x4*)(qp + 32), x2); unpack8(*(const u32x4*)(qp + 48), x3);
        if (!isctx) {
            const float* tr = tab + ((qi >> 6) * 16 + 8 * hi) * 2; const float* tc = tab + ((qi & 63) * 16 + 8 * hi) * 2;
#pragma unroll
            for (int j = 0; j < 8; ++j) { const float cr = tr[2 * j], sr = tr[2 * j + 1], cc = tc[2 * j], scn = tc[2 * j + 1];
                const float a0 = x0[j], a1 = x1[j], b0 = x2[j], b1 = x3[j];
                x0[j] = a0 * cr - a1 * sr; x1[j] = a1 * cr + a0 * sr; x2[j] = b0 * cc - b1 * scn; x3[j] = b1 * cc + b0 * scn; }
        }
#pragma unroll
        for (int j = 0; j < 8; ++j) { x0[j] *= qscale; x1[j] *= qscale; x2[j] *= qscale; x3[j] *= qscale; }
        qf[0] = __builtin_bit_cast(bf16x8, pack8(x0)); qf[1] = __builtin_bit_cast(bf16x8, pack8(x1)); qf[2] = __builtin_bit_cast(bf16x8, pack8(x2)); qf[3] = __builtin_bit_cast(bf16x8, pack8(x3));
    }
    float m_ = sink[head] * 1.44269504089f, l_ = hi == 0 ? 1.f : 0.f;
    f32x16 O0, O1;
#pragma unroll
    for (int e = 0; e < 16; ++e) { O0[e] = 0.f; O1[e] = 0.f; }
    const int nch = isctx ? 4 : 9;
    for (int ci = 0; ci < nch; ++ci) {
        bool kctx; int kbase;
        if (isctx) { kctx = true; kbase = ci * 64; }
        else if (ci < 5) { kctx = false; kbase = (n - 2 + ci) * 64; if (kbase < 0 || kbase >= SEQ) continue; }
        else { kctx = true; kbase = (ci - 5) * 64; }
        __syncthreads();
        { const int key = tid >> 3, sub = tid & 7, a = sub >> 2, f0 = (sub & 3) * 4;
          const int krow = kctx ? NLAT + b * LCTX + kbase + key : b * SEQ + kbase + key;
          const bf16_t* kp = PAC + (size_t)krow * NAC + 3072 + hk * 64 + a * 32 + f0;
          const u32x2 w1 = *(const u32x2*)kp, w2 = *(const u32x2*)(kp + 16);
          float y1[4] = {bflo(w1.x), bfhi(w1.x), bflo(w1.y), bfhi(w1.y)}, y2[4] = {bflo(w2.x), bfhi(w2.x), bflo(w2.y), bfhi(w2.y)};
          if (!kctx) { const int pos = kbase + key; const int idx = a ? (pos & 63) : (pos >> 6); const float* tp = tab + (idx * 16 + f0) * 2;
#pragma unroll
              for (int j = 0; j < 4; ++j) { const float c = tp[2 * j], s = tp[2 * j + 1]; const float u0 = y1[j], u1 = y2[j]; y1[j] = u0 * c - u1 * s; y2[j] = u1 * c + u0 * s; } }
          u32x2 o1, o2; o1.x = cvt_pk_bf16(y1[0], y1[1]); o1.y = cvt_pk_bf16(y1[2], y1[3]); o2.x = cvt_pk_bf16(y2[0], y2[1]); o2.y = cvt_pk_bf16(y2[2], y2[3]);
          *(LAS u32x2*)(Ks + key * 72 + a * 32 + f0) = o1; *(LAS u32x2*)(Ks + key * 72 + a * 32 + 16 + f0) = o2;
          const u32x4 vw = *(const u32x4*)(PAC + (size_t)krow * NAC + 3200 + hk * 64 + sub * 8);
          Vt[(sub * 8 + 0) * 68 + key] = (bf16_t)(vw.x & 0xffffu); Vt[(sub * 8 + 1) * 68 + key] = (bf16_t)(vw.x >> 16);
          Vt[(sub * 8 + 2) * 68 + key] = (bf16_t)(vw.y & 0xffffu); Vt[(sub * 8 + 3) * 68 + key] = (bf16_t)(vw.y >> 16);
          Vt[(sub * 8 + 4) * 68 + key] = (bf16_t)(vw.z & 0xffffu); Vt[(sub * 8 + 5) * 68 + key] = (bf16_t)(vw.z >> 16);
          Vt[(sub * 8 + 6) * 68 + key] = (bf16_t)(vw.w & 0xffffu); Vt[(sub * 8 + 7) * 68 + key] = (bf16_t)(vw.w >> 16); }
        __syncthreads();
        f32x16 S0, S1;
#pragma unroll
        for (int e = 0; e < 16; ++e) { S0[e] = 0.f; S1[e] = 0.f; }
#pragma unroll
        for (int ks = 0; ks < 4; ++ks) {
            const bf16x8 k0 = *(const LAS bf16x8*)(Ks + (c32) * 72 + ks * 16 + hi * 8), k1 = *(const LAS bf16x8*)(Ks + (32 + c32) * 72 + ks * 16 + hi * 8);
            S0 = __builtin_amdgcn_mfma_f32_32x32x16_bf16(k0, qf[ks], S0, 0, 0, 0); S1 = __builtin_amdgcn_mfma_f32_32x32x16_bf16(k1, qf[ks], S1, 0, 0, 0); }
        float mx = -1e30f;
        if (!kctx) {
#pragma unroll
            for (int e = 0; e < 16; ++e) { const int kp0 = kbase + (e & 3) + 8 * (e >> 2) + 4 * hi; const int d0 = qi - kp0, d1 = d0 - 32;
                if (d0 > 128 || d0 < -128) S0[e] = -1e30f; if (d1 > 128 || d1 < -128) S1[e] = -1e30f; }
        }
#pragma unroll
        for (int e = 0; e < 16; ++e) mx = fmaxf(mx, fmaxf(S0[e], S1[e]));
        mx = fmaxf(mx, __shfl_xor(mx, 32));
        const float mnew = fmaxf(m_, mx), alpha = __builtin_amdgcn_exp2f(m_ - mnew); m_ = mnew;
        float ps = 0.f;
#pragma unroll
        for (int e = 0; e < 16; ++e) { S0[e] = __builtin_amdgcn_exp2f(S0[e] - mnew); S1[e] = __builtin_amdgcn_exp2f(S1[e] - mnew); ps += S0[e] + S1[e]; }
        l_ = l_ * alpha + ps;
#pragma unroll
        for (int e = 0; e < 16; ++e) { O0[e] *= alpha; O1[e] *= alpha; }
#pragma unroll
        for (int kt = 0; kt < 2; ++kt)
#pragma unroll
            for (int s2 = 0; s2 < 2; ++s2) {
                u32x4 w;
                if (kt == 0) { w.x = cvt_pk_bf16_sw(S0[8 * s2 + 0], S0[8 * s2 + 1]); w.y = cvt_pk_bf16_sw(S0[8 * s2 + 2], S0[8 * s2 + 3]); w.z = cvt_pk_bf16_sw(S0[8 * s2 + 4], S0[8 * s2 + 5]); w.w = cvt_pk_bf16_sw(S0[8 * s2 + 6], S0[8 * s2 + 7]); }
                else { w.x = cvt_pk_bf16_sw(S1[8 * s2 + 0], S1[8 * s2 + 1]); w.y = cvt_pk_bf16_sw(S1[8 * s2 + 2], S1[8 * s2 + 3]); w.z = cvt_pk_bf16_sw(S1[8 * s2 + 4], S1[8 * s2 + 5]); w.w = cvt_pk_bf16_sw(S1[8 * s2 + 6], S1[8 * s2 + 7]); }
                const bf16x8 pf = __builtin_bit_cast(bf16x8, w);
                const LAS bf16_t* vp0 = Vt + (c32) * 68 + kt * 32 + 16 * s2 + 4 * hi; const LAS bf16_t* vp1 = vp0 + 32 * 68;
                const u32x2 a0 = *(const LAS u32x2*)vp0, a1 = *(const LAS u32x2*)(vp0 + 8), b0 = *(const LAS u32x2*)vp1, b1 = *(const LAS u32x2*)(vp1 + 8);
                const bf16x8 vf0 = __builtin_bit_cast(bf16x8, ((u32x4){a0.x, a0.y, a1.x, a1.y})), vf1 = __builtin_bit_cast(bf16x8, ((u32x4){b0.x, b0.y, b1.x, b1.y}));
                O0 = __builtin_amdgcn_mfma_f32_32x32x16_bf16(vf0, pf, O0, 0, 0, 0); O1 = __builtin_amdgcn_mfma_f32_32x32x16_bf16(vf1, pf, O1, 0, 0, 0);
            }
    }
    {
        const float lt = l_ + __shfl_xor(l_, 32); const float inv = 1.f / lt;
        bf16_t* yp = YC + (size_t)qrow * 512 + head * 64 + 4 * hi;
#pragma unroll
        for (int i = 0; i < 4; ++i) { u32x2 w; w.x = cvt_pk_bf16(O0[4 * i] * inv, O0[4 * i + 1] * inv); w.y = cvt_pk_bf16(O0[4 * i + 2] * inv, O0[4 * i + 3] * inv); *(u32x2*)(yp + 8 * i) = w;
            u32x2 w2; w2.x = cvt_pk_bf16(O1[4 * i] * inv, O1[4 * i + 1] * inv); w2.y = cvt_pk_bf16(O1[4 * i + 2] * inv, O1[4 * i + 3] * inv); *(u32x2*)(yp + 32 + 8 * i) = w2; }
    }
    __syncthreads();
}

__device__ __forceinline__ void filt_item(LAS unsigned char* L, int item, int Lseq, bool latent, const float* w1, const float* b1, const float* f1, const float* w2, const float* b2, const float* f2, const float* w3, float* l1acc, bf16_t* FR, float* fc) {
    const int tid = otid(), p0 = item * 64;
    LAS float* feats = (LAS float*)L; LAS float* h1 = feats + 64 * 36; LAS float* h2 = h1 + 64 * 64;
    __syncthreads();
    for (int e = tid; e < 64 * 33; e += 512) { const int p = e / 33, j = e % 33; const float pos = (float)(p0 + p);
        float val;
        if (j == 0) val = pos / (float)(Lseq - 1);
        else { const int bi = (j - 1) & 15; const float band = 1e-4f + (float)bi * ((15.0f - 1e-4f) / 15.0f); const float w = 2.0f * 3.14159265358979f * pos / (float)Lseq;
            val = j <= 16 ? __cosf(w * band) : -__sinf(w * band); }
        feats[p * 36 + j] = val; }
    __syncthreads();
    { const int nn = tid & 63, pg = tid >> 6;
      float acc[8];
#pragma unroll
      for (int i = 0; i < 8; ++i) acc[i] = 0.f;
      for (int j = 0; j < 33; ++j) { const float wv = w1[j * 64 + nn];
#pragma unroll
          for (int i = 0; i < 8; ++i) acc[i] += feats[(pg * 8 + i) * 36 + j] * wv; }
      const float bb = b1[nn], ff = f1[nn];
#pragma unroll
      for (int i = 0; i < 8; ++i) h1[(pg * 8 + i) * 64 + nn] = __sinf(ff * (acc[i] + bb)); }
    __syncthreads();
    { const int nn = tid & 63, pg = tid >> 6;
      float acc[8];
#pragma unroll
      for (int i = 0; i < 8; ++i) acc[i] = 0.f;
      for (int j = 0; j < 64; ++j) { const float wv = w2[j * 64 + nn];
#pragma unroll
          for (int i = 0; i < 8; ++i) acc[i] += h1[(pg * 8 + i) * 64 + j] * wv; }
      const float bb = b2[nn], ff = f2[nn];
#pragma unroll
      for (int i = 0; i < 8; ++i) h2[(pg * 8 + i) * 64 + nn] = __sinf(ff * (acc[i] + bb)); }
    __syncthreads();
    {
        float asum[4] = {0.f, 0.f, 0.f, 0.f};
        for (int pgp = 0; pgp < 4; ++pgp) {
            float acc[4][16];
#pragma unroll
            for (int jj = 0; jj < 4; ++jj)
#pragma unroll
                for (int p = 0; p < 16; ++p) acc[jj][p] = 0.f;
            for (int k4 = 0; k4 < 16; ++k4) {
                f32x4 w[4];
#pragma unroll
                for (int jj = 0; jj < 4; ++jj) { const int c = tid + 512 * jj; w[jj] = (f32x4){w3[(size_t)(4 * k4) * 2048 + c], w3[(size_t)(4 * k4 + 1) * 2048 + c], w3[(size_t)(4 * k4 + 2) * 2048 + c], w3[(size_t)(4 * k4 + 3) * 2048 + c]}; }
#pragma unroll
                for (int p = 0; p < 16; ++p) { const f32x4 hv = *(const LAS f32x4*)(h2 + (pgp * 16 + p) * 64 + 4 * k4);
#pragma unroll
                    for (int jj = 0; jj < 4; ++jj) acc[jj][p] += (hv[0] * w[jj][0] + hv[1] * w[jj][1]) + (hv[2] * w[jj][2] + hv[3] * w[jj][3]); }
            }
#pragma unroll
            for (int jj = 0; jj < 4; ++jj) { const int c = tid + 512 * jj; const int dirn = c >> 10, ord = (c >> 9) & 1, ch = c & 511;
                const float rate = fabsf(-3.0701134573f + (float)ch * ((-15.350567286f + 3.0701134573f) / 511.0f));
#pragma unroll
                for (int p = 0; p < 16; ++p) { const int pos = p0 + pgp * 16 + p; const float t = (float)pos / (float)(Lseq - 1); const float val = acc[jj][p] * __expf(-t * rate);
                    if (!(dirn == 1 && pos == 0)) { asum[jj] += fabsf(val);
                        if (latent) { const int m = dirn == 0 ? FRC - pos : FRC + pos; FR[(size_t)(ord * 512 + ch) * FRLEN + m] = f2bf(val); } }
                    if (!latent) fc[(size_t)pos * 2048 + c] = val; } }
        }
#pragma unroll
        for (int jj = 0; jj < 4; ++jj) { const int c = tid + 512 * jj; atomicAdd(l1acc + ((c >> 9) & 1) * 512 + (c & 511), asum[jj]); }
    }
    if (latent) {
        for (int e = tid; e < 4 * 129; e += 512) { const int rr = item * 4 + e / 129, q = e % 129; const int m = q < 64 ? q : (FRC + SEQ + (q - 64)); FR[(size_t)rr * FRLEN + m] = 0; }
    }
}
__device__ __forceinline__ void hyprep_phase(LAS unsigned char* L, const bf16_t* PB, const float* cw, const float* cb, bf16_t* T, int bid, int G) {
    LAS float* xs = (LAS float*)L;
    const int tid = otid();
    u32x4 p0 = (u32x4){0, 0, 0, 0}, p1 = (u32x4){0, 0, 0, 0};
#define HP_LOAD(IT) { const int tt_ = (IT) / 24, ct_ = (IT) % 24; const int r0_ = tt_ * 64, c0_ = ct_ * 64; const int b_ = r0_ >> 14, t0_ = r0_ & (SEQ - 1); \
        { const int rr = tid >> 3, ck = (tid & 7) * 8; const int t = t0_ - 1 + rr; p0 = (t >= 0 && t < SEQ) ? *(const u32x4*)(PB + (size_t)(b_ * SEQ + t) * NPB + c0_ + ck) : (u32x4){0, 0, 0, 0}; } \
        if (tid < 16) { const int rr = 64 + (tid >> 3), ck = (tid & 7) * 8; const int t = t0_ - 1 + rr; p1 = (t >= 0 && t < SEQ) ? *(const u32x4*)(PB + (size_t)(b_ * SEQ + t) * NPB + c0_ + ck) : (u32x4){0, 0, 0, 0}; } }
    int it = bid;
    if (it < 512 * 24) HP_LOAD(it)
    for (; it < 512 * 24; it += G) {
        const int tt = it / 24, ct = it % 24; const int r0 = tt * 64, c0 = ct * 64; const int b = r0 >> 14, t0 = r0 & (SEQ - 1);
        __syncthreads();
        { float f[8]; unpack8(p0, f); const int rr = tid >> 3, ck = (tid & 7) * 8;
#pragma unroll
          for (int j = 0; j < 8; ++j) xs[rr * 65 + ck + j] = f[j];
          if (tid < 16) { unpack8(p1, f); const int rr2 = 64 + (tid >> 3);
#pragma unroll
              for (int j = 0; j < 8; ++j) xs[rr2 * 65 + ck + j] = f[j]; } }
        __syncthreads();
        if (it + G < 512 * 24) HP_LOAD(it + G)
        { const int cl = tid >> 3, tc = (tid & 7) * 8, c = c0 + cl; const float w0 = cw[c], w1 = cw[NPB + c], w2 = cw[2 * NPB + c], bb = cb[c]; float o[8];
#pragma unroll
          for (int j = 0; j < 8; ++j) o[j] = xs[(tc + j) * 65 + cl] * w0 + xs[(tc + j + 1) * 65 + cl] * w1 + xs[(tc + j + 2) * 65 + cl] * w2 + bb;
          *(u32x4*)(T + ((size_t)c * 2 + b) * SEQ + t0 + tc) = pack8(o); }
    }
#undef HP_LOAD
}
__device__ __forceinline__ void hyconv_item(LAS unsigned char* L, int ch, bf16_t* T, const bf16_t* FR, const float* l1acc, const float* hbias) {
    LAS bf16_t* zs = (LAS bf16_t*)L; LAS bf16_t* fr = zs + 2 * ZP;
    const int tid = otid(), wave = tid >> 6, lane = tid & 63, r = lane & 31, h = lane >> 5;
    const int b = wave >> 2, tt0 = (wave & 3) * 4;
    __syncthreads();
    for (int e = tid; e < 2 * 2048; e += 512) { const int bb = e >> 11, ck = e & 2047; const u32x4 w = *(const u32x4*)(T + ((size_t)ch * 2 + bb) * SEQ + ck * 8); const int i = 1024 + ck * 8;
        *(LAS u32x4*)(zs + bb * ZP + (i >> 5) * 40 + (i & 31)) = w; }
    for (int e = tid; e < 2 * 64 * 5; e += 512) { const int bb = e / 320, q = e % 320, blk = q / 5, part = q % 5; const int bk = blk < 32 ? blk : 512 + blk;
        *(LAS u32x4*)(zs + bb * ZP + bk * 40 + part * 8) = (u32x4){0, 0, 0, 0}; }
    for (int ord = 0; ord < 2; ++ord) {
        const bf16_t* frg = FR + (size_t)(ord * 512 + ch) * FRLEN;
        for (int e = tid; e < FRLEN / 8; e += 512) *(LAS u32x4*)(fr + e * 8) = *(const u32x4*)(frg + e * 8);
        __syncthreads();
        f32x16 acc[4];
#pragma unroll
        for (int i = 0; i < 4; ++i)
#pragma unroll
            for (int e = 0; e < 16; ++e) acc[i][e] = 0.f;
        const int s_lo = 64 * tt0 - 1023, s_hi = 64 * (tt0 + 3) + 62;
        const LAS unsigned char* zb = (const LAS unsigned char*)(zs + b * ZP);
#define HY_A(off) ({ const LAS unsigned* ap_ = (const LAS unsigned*)(abase + (off)); const unsigned e0 = ap_[0], e1 = ap_[1], e2 = ap_[2], e3 = ap_[3], e4 = ap_[4]; \
            __builtin_bit_cast(bf16x8, ((u32x4){__builtin_amdgcn_alignbit(e1, e0, shb), __builtin_amdgcn_alignbit(e2, e1, shb), __builtin_amdgcn_alignbit(e3, e2, shb), __builtin_amdgcn_alignbit(e4, e3, shb)})); })
#define HY_MM(i, OFF, AF) acc[i] = __builtin_amdgcn_mfma_f32_32x32x16_bf16(AF, *(const LAS bf16x8*)(bbase + 2560 * (i) + (OFF)), acc[i], 0, 0, 0);
#define HY_SEG(SB, NP, T0, T1, T2, T3) { const int sb_ = (SB); const int m0b = FRC - 16 * sb_ - r + 8 * h; \
            const LAS unsigned char* abase = (const LAS unsigned char*)fr + ((2 * m0b) & ~3) - 32; \
            const LAS unsigned char* bbase = zb + (((32 - ((sb_ + 1) >> 1)) + 32 * tt0 + r) * 40 + 8 * h) * 2; \
            _Pragma("unroll 1") for (int p = 0; p < (NP); ++p) { const bf16x8 a_o = HY_A(32), a_e = HY_A(0); \
                if (T0) HY_MM(0, 32, a_o) if (T1) HY_MM(1, 32, a_o) if (T2) HY_MM(2, 32, a_o) if (T3) HY_MM(3, 32, a_o) \
                if (T0) HY_MM(0, 0, a_e) if (T1) HY_MM(1, 0, a_e) if (T2) HY_MM(2, 0, a_e) if (T3) HY_MM(3, 0, a_e) \
                abase -= 64; bbase -= 80; } }
        const unsigned shb = ((FRC - r) & 1) * 16;
        HY_SEG(s_lo, 32, 1, 0, 0, 0) HY_SEG(s_lo + 64, 32, 1, 1, 0, 0) HY_SEG(s_lo + 128, 32, 1, 1, 1, 0)
        HY_SEG(s_lo + 192, 447, 1, 1, 1, 1)
        HY_SEG(s_lo + 1086, 32, 0, 1, 1, 1) HY_SEG(s_lo + 1150, 32, 0, 0, 1, 1) HY_SEG(s_lo + 1214, 32, 0, 0, 0, 1)
#undef HY_A
#undef HY_MM
#undef HY_SEG
        __syncthreads();
        const float inv = 1.0f / l1acc[ord * 512 + ch], bs = hbias[ord * 512 + ch];
        bf16_t* xg = T + ((size_t)((ord + 1) * 512 + ch) * 2 + b) * SEQ;
#pragma unroll
        for (int i = 0; i < 4; ++i) { const int col = 32 * (tt0 + i) + r;
#pragma unroll
            for (int gq = 0; gq < 4; ++gq) { const int t = 32 * col + 8 * gq + 4 * h; const int iz = 1024 + t;
                LAS u32x2* zp = (LAS u32x2*)(zs + b * ZP + (iz >> 5) * 40 + (iz & 31));
                const u32x2 zw = *zp; const u32x2 xw = *(const u32x2*)(xg + t);
                const float z0 = bflo(zw.x), z1 = bfhi(zw.x), z2 = bflo(zw.y), z3 = bfhi(zw.y);
                const float o0 = bflo(xw.x) * (acc[i][4 * gq] * inv + bs * z0), o1 = bfhi(xw.x) * (acc[i][4 * gq + 1] * inv + bs * z1);
                const float o2 = bflo(xw.y) * (acc[i][4 * gq + 2] * inv + bs * z2), o3 = bfhi(xw.y) * (acc[i][4 * gq + 3] * inv + bs * z3);
                u32x2 ow; ow.x = cvt_pk_bf16(o0, o1); ow.y = cvt_pk_bf16(o2, o3);
                if (ord == 0) *zp = ow; else *(u32x2*)(xg + t) = ow; } }
        __syncthreads();
    }
}
__device__ __forceinline__ void hytrb_phase(LAS unsigned char* L, const bf16_t* T2, bf16_t* YB, int bid, int G) {
    LAS bf16_t* tl = (LAS bf16_t*)L;
    const int tid = otid(); const int cl = tid >> 3, tc = (tid & 7) * 8;
    int it = bid;
    if (it >= 512 * 8) return;
    u32x4 pv;
#define TRB_LOAD(IT) { const int tt_ = (IT) >> 3, ct_ = (IT) & 7; const int r0_ = tt_ * 64, c0_ = ct_ * 64, b_ = r0_ >> 14, t0_ = r0_ & (SEQ - 1); pv = *(const u32x4*)(T2 + ((size_t)(c0_ + cl) * 2 + b_) * SEQ + t0_ + tc); }
    TRB_LOAD(it)
    for (; it < 512 * 8; it += G) {
        const int tt = it >> 3, ct = it & 7; const int r0 = tt * 64, c0 = ct * 64;
        __syncthreads();
        *(LAS u32x4*)(tl + cl * 72 + tc) = pv;
        __syncthreads();
        if (it + G < 512 * 8) TRB_LOAD(it + G)
        { const int tl_ = tid >> 3, cc = (tid & 7) * 8; unsigned w[4];
#pragma unroll
          for (int j = 0; j < 4; ++j) w[j] = (unsigned)tl[(cc + 2 * j) * 72 + tl_] | ((unsigned)tl[(cc + 2 * j + 1) * 72 + tl_] << 16);
          *(u32x4*)(YB + (size_t)(r0 + tl_) * 512 + c0 + cc) = (u32x4){w[0], w[1], w[2], w[3]}; }
    }
#undef TRB_LOAD
    __syncthreads();
}
__device__ __forceinline__ void hyctx_shortconv(const bf16_t* PB, const float* cw, const float* cb, float* SC, int bid, int G) {
    for (int e = bid * 512 + otid(); e < NCTX * NPB; e += G * 512) { const int r = e / NPB, c = e % NPB, t = r & 255;
        const bf16_t* p = PB + (size_t)(NLAT + r) * NPB + c;
        const float xm = t > 0 ? bf2f(p[-NPB]) : 0.f, x0 = bf2f(p[0]), xp = t < 255 ? bf2f(p[NPB]) : 0.f;
        SC[e] = xm * cw[c] + x0 * cw[NPB + c] + xp * cw[2 * NPB + c] + cb[c]; }
}
__device__ __forceinline__ void hyctx_conv(int ord, const float* SC, const float* zin, int ldz, const float* fc, const float* l1c, const float* hbias, float* z1c, bf16_t* YB, int bid, int G) {
    for (int e = bid * 512 + otid(); e < NCTX * 512; e += G * 512) { const int r = e >> 9, ch = e & 511, b = r >> 8, t = r & 255;
        float s = 0.f;
        for (int j = 0; j < 256; ++j) { const int x = t - j; const float fv = x >= 0 ? fc[(size_t)x * 2048 + ord * 512 + ch] : fc[(size_t)(-x) * 2048 + 1024 + ord * 512 + ch];
            s += fv * zin[(size_t)(b * 256 + j) * ldz + ch]; }
        const float zt = zin[(size_t)r * ldz + ch];
        const float o = SC[(size_t)r * NPB + (ord + 1) * 512 + ch] * (s / l1c[ord * 512 + ch] + hbias[ord * 512 + ch] * zt);
        if (ord == 0) z1c[e] = o; else YB[(size_t)(NLAT + r) * 512 + ch] = f2bf(o); }
}

constexpr int NPHASE = 2 + 17 * 2;
#define P_BIG (a.ws + WS_BIG)
#define P_W (a.ws + WS_W)
#define P_U ((bf16_t*)(a.ws + WS_U))
#define P_U2 ((bf16_t*)(P_BIG + (size_t)MROWS * D * 2))
#define P_HC ((float*)(a.ws + WS_HC))
#define P_MODS ((float*)(a.ws + WS_MISC + MI_MODS))
#define P_TAB ((const float*)(a.ws + WS_MISC + MI_TAB))
#define P_ACT ((bf16_t*)(P_BIG + ((sp >= 14 || sp <= 2) ? B_Y : B_ACT)))
#define P_Y ((bf16_t*)(P_BIG + ((sp >= 14 || sp <= 2) ? (size_t)0 : B_Y)))
#define P_PAC ((bf16_t*)(P_BIG + B_PAC))
#define P_OB ((bf16_t*)(P_BIG + B_OB))
#define P_PB ((bf16_t*)(P_BIG + B_PB))
#define P_T ((bf16_t*)(P_BIG + B_T))
#define P_FR ((bf16_t*)(P_BIG + B_F))
#define P_PG ((bf16_t*)(P_BIG + B_PG))
#define P_YA ((bf16_t*)(P_BIG + B_YA))
#define P_YB ((bf16_t*)(P_BIG + B_YB))
#define P_YC ((bf16_t*)(P_BIG + B_YC))
#define P_L1 ((float*)(a.ws + WS_MISC + MI_L1) + layer * 1024)
#define P_L1C ((float*)(a.ws + WS_MISC + MI_L1C))
#define P_FC ((float*)(a.ws + WS_MISC + MI_FC))
#define P_SC ((float*)(a.ws + WS_MISC + MI_SC))
#define P_Z1C ((float*)(a.ws + WS_MISC + MI_Z1C))
#define HY_W1 (a.in[15] + layer * 33 * 64)
#define HY_B1 (a.in[16] + layer * 64)
#define HY_F1 (a.in[17] + layer * 64)
#define HY_W2 (a.in[18] + layer * 64 * 64)
#define HY_B2 (a.in[19] + layer * 64)
#define HY_F2 (a.in[20] + layer * 64)
#define HY_W3 (a.in[21] + (size_t)layer * 64 * 2048)
#define HY_BIAS (a.in[22] + layer * 1024)
#define HY_CW (a.in[13] + layer * 3 * NPB)
#define HY_CB (a.in[14] + layer * NPB)
#define MODL (P_MODS + (size_t)layer * 3 * NMOD)
#define LNG (a.in[6] + (size_t)layer * 3 * D)
#define LNB (a.in[7] + (size_t)layer * 3 * D)
__global__ void __launch_bounds__(512, 2) mega(Args a) {
    extern __shared__ __attribute__((aligned(16))) unsigned char lds_raw[];
    LAS unsigned char* L = (LAS unsigned char*)lds_raw;
    cg::grid_group grid = cg::this_grid();
    const int bid = blockIdx.x, G = gridDim.x;
    if (a.ph_hi - a.ph_lo > 1) grid.sync();
    for (int ph = a.ph_lo; ph < a.ph_hi; ++ph) {
        bool do_gemm = false; pg8::Gemm gg{}; pg8::EpiAny ep{}; int gM = 0, gN = 0, gbr = 1;
        if (ph == 0) { phase_wconv(L, a, 0, bid, G); phase_mods(L, a, bid, G); }
        else if (ph == 1) { LnP p{a.in[0], a.in[2], nullptr, nullptr, nullptr, 0, nullptr, 0, 0.f, nullptr, nullptr, P_MODS, 0, P_U, MROWS, 0}; phase_ln(p, bid, G); }
        else {
            const int layer = (ph - 2) / 17, sp = (ph - 2) % 17;
            const int Mpost = layer == 1 ? NLAT : MROWS;
            switch (sp) {
            case 0: case 14: {
                const int f = sp == 0 ? 1 : 0; const bf16_t* Wt = (const bf16_t*)(P_W + W_IN) + (size_t)f * NFF2 * D;
                gg = pg8::Gemm{sp == 0 ? P_U : P_U2, Wt, 0, 0, D, D, D}; gM = sp == 0 ? MROWS : Mpost; gN = NFF2; ep = pg8::EpiAny{1, P_ACT, DFF, nullptr, nullptr}; do_gemm = true; } break;
            case 1: case 15: {
                const int f = sp == 1 ? 1 : 0; const bf16_t* Wt = (const bf16_t*)(P_W + W_OUT) + (size_t)f * D * DFF;
                gg = pg8::Gemm{P_ACT, Wt, 0, 0, DFF, DFF, DFF}; gM = sp == 1 ? MROWS : Mpost; gN = D; ep = pg8::EpiAny{0, P_Y, D, nullptr, nullptr}; do_gemm = true; } break;
            case 2: { const bool first = layer == 0;
                LnP p{first ? a.in[0] : a.out, first ? a.in[2] : P_HC, a.out, P_HC, P_Y, D, MODL, 2, 0.5f, LNG, LNB, MODL, 3, P_U, MROWS, 1}; phase_ln(p, bid, G); } break;
            case 3: { const bf16_t* Wt = (const bf16_t*)(P_W + W_MIX);
                gg = pg8::Gemm{P_U, Wt, 0, 0, D, D, D}; gM = MROWS; gN = NAC; ep = pg8::EpiAny{0, P_PAC, NAC, nullptr, nullptr}; do_gemm = true; } break;
            case 4: {
                bf16_t* QB = (bf16_t*)(P_BIG + B_QB); float* DB = (float*)(P_BIG + B_DB);
                hgrn_prepass(P_PAC, QB, DB, a.in[11], layer, bid, G);
                {
                    __syncthreads();
                    if (threadIdx.x < 64) {
                        __builtin_amdgcn_fence(__ATOMIC_RELEASE, "agent"); asm volatile("s_waitcnt vmcnt(0) lgkmcnt(0)" ::: "memory");
                        if (threadIdx.x == 0) { unsigned* bar2 = (unsigned*)(a.ws + WS_MISC + MI_BAR) + 16;
                            __hip_atomic_fetch_add(bar2, 1u, __ATOMIC_RELAXED, __HIP_MEMORY_SCOPE_AGENT);
                            const unsigned target = (unsigned)(layer + 1) * (unsigned)G;
                            while (__hip_atomic_load(bar2, __ATOMIC_RELAXED, __HIP_MEMORY_SCOPE_AGENT) < target) __builtin_amdgcn_s_sleep(1); }
                        __builtin_amdgcn_fence(__ATOMIC_ACQUIRE, "agent"); asm volatile("s_waitcnt vmcnt(0) lgkmcnt(0)" ::: "memory"); }
                    __syncthreads();
                }
                const int nh = G >= 256 ? 128 : G / 2;
                if (bid < nh) { for (int it = bid; it < 128; it += nh) hgrn_scan_item(L, it, P_PAC, QB, DB, P_YA, P_OB); }
                else { const int nitem = layer == 0 ? 1040 : 1024; for (int it = bid - nh; it < nitem; it += G - nh) attn_item(L, it, P_PAC, P_TAB, a.in[23] + layer * 8, P_YC);
                    if (layer == 0) { for (int it = bid - nh; it < 4; it += G - nh) filt_item(L, it, LCTX, false, HY_W1, HY_B1, HY_F1, HY_W2, HY_B2, HY_F2, HY_W3, P_L1C, nullptr, P_FC); } }
            } break;
            case 5: phase_readout(P_PAC, P_YA, P_OB, a.in[12] + layer * 512, Mpost, bid, G); break;
            case 6: { const bf16_t* Wt = (const bf16_t*)(P_W + W_MIX) + (size_t)NAC * D;
                gg = pg8::Gemm{P_U, Wt, 0, 0, D, D, D}; gM = Mpost; gN = NPB; ep = pg8::EpiAny{0, P_PB, NPB, nullptr, nullptr}; do_gemm = true; } break;
            case 7: {
                for (int it = bid; it < 256; it += G) filt_item(L, it, SEQ, true, HY_W1, HY_B1, HY_F1, HY_W2, HY_B2, HY_F2, HY_W3, P_L1, P_FR, nullptr);
                if (layer == 0) hyctx_shortconv(P_PB, HY_CW, HY_CB, P_SC, bid, G);
                hyprep_phase(L, P_PB, HY_CW, HY_CB, P_T, bid, G);
            } break;
            case 8: {
                for (int ch = bid; ch < 512; ch += G) hyconv_item(L, ch, P_T, P_FR, P_L1, HY_BIAS);
                if (layer == 0) hyctx_conv(0, P_SC, P_SC, NPB, P_FC, P_L1C, HY_BIAS, P_Z1C, P_YB, bid, G);
            } break;
            case 9: {
                hytrb_phase(L, P_T + (size_t)2 * 512 * 2 * SEQ, P_YB, bid, G);
                if (layer == 0) hyctx_conv(1, P_SC, P_Z1C, 512, P_FC, P_L1C, HY_BIAS, P_Z1C, P_YB, bid, G);
            } break;
            case 10: { const bf16_t* Wt = (const bf16_t*)(P_W + W_MIX) + (size_t)(NAC + NPB) * D;
                gg = pg8::Gemm{P_U, Wt, 0, 0, D, D, D}; gM = Mpost; gN = NPG; ep = pg8::EpiAny{0, P_PG, NPG, nullptr, nullptr}; do_gemm = true; } break;
            case 11: { const bf16_t* Wt = (const bf16_t*)(P_W + W_BR);
                gg = pg8::Gemm{P_YA, Wt, YSZ, (size_t)D * 512 * 2, 512, 512, 512}; gM = Mpost; gN = D; gbr = 3;
                ep = pg8::EpiAny{2, P_PG, NPG, P_PG, (float*)(P_BIG + B_SCR) + (size_t)bid * 65536}; do_gemm = true; } break;
            case 12: { const bf16_t* Wt = (const bf16_t*)(P_W + W_O);
                gg = pg8::Gemm{P_PG, Wt, 0, 0, NPG, D, D}; gM = Mpost; gN = D; ep = pg8::EpiAny{0, P_Y, D, nullptr, nullptr}; do_gemm = true; } break;
            case 13: { LnP p{a.out, P_HC, a.out, P_HC, P_Y, D, MODL, 5, 1.0f, LNG + D, LNB + D, MODL, 6, P_U2, Mpost, 1}; phase_ln(p, bid, G); } break;
            case 16: {
                LnP p{a.out, P_HC, a.out, P_HC, P_Y, D, MODL, 8, 0.5f, LNG + 2 * D, LNB + 2 * D, P_MODS + (size_t)(layer + 1) * 3 * NMOD, 0, P_U, Mpost, layer == 0 ? 1 : 2}; phase_ln(p, bid, G);
                if (layer == 0) phase_wconv(L, a, 1, bid, G);
            } break;
            }
        }
        if (do_gemm) { pg8::Order S; S.init(gM, gN, G, bid, gbr); pg8::gemm_phase(L, gg, S, ep); }
        if (ph + 1 < a.ph_hi) {
            __syncthreads();
            if (threadIdx.x < 64) {
                __builtin_amdgcn_fence(__ATOMIC_RELEASE, "agent"); asm volatile("s_waitcnt vmcnt(0) lgkmcnt(0)" ::: "memory");
                if (threadIdx.x == 0) {
                    unsigned* bar = (unsigned*)(a.ws + WS_MISC + MI_BAR);
                    const unsigned k = (unsigned)(ph - a.ph_lo + 1);
                    if ((G & 7) == 0) {
                        unsigned* grp = (unsigned*)(a.ws + WS_MISC + MI_BAR2) + (bid & 7) * 16;
                        const unsigned old = __hip_atomic_fetch_add(grp, 1u, __ATOMIC_RELAXED, __HIP_MEMORY_SCOPE_AGENT);
                        if (old + 1u == k * (unsigned)(G >> 3)) __hip_atomic_fetch_add(bar, 1u, __ATOMIC_RELAXED, __HIP_MEMORY_SCOPE_AGENT);
                        while (__hip_atomic_load(bar, __ATOMIC_RELAXED, __HIP_MEMORY_SCOPE_AGENT) < 8u * k) __builtin_amdgcn_s_sleep(1);
                    } else {
                        __hip_atomic_fetch_add(bar, 1u, __ATOMIC_RELAXED, __HIP_MEMORY_SCOPE_AGENT);
                        while (__hip_atomic_load(bar, __ATOMIC_RELAXED, __HIP_MEMORY_SCOPE_AGENT) < k * (unsigned)G) __builtin_amdgcn_s_sleep(1);
                    }
                }
                __builtin_amdgcn_fence(__ATOMIC_ACQUIRE, "agent"); asm volatile("s_waitcnt vmcnt(0) lgkmcnt(0)" ::: "memory");
            }
            __syncthreads();
        }
    }
}

extern "C" void kernel_launch(void* const* d_in, const int* in_sizes, int n_in, void* d_out, int out_size, void* d_ws, size_t ws_size, hipStream_t stream) {
    static int grid = 0;
    if (grid == 0) {
        if (n_in != 26 || ws_size < WS_TOTAL) { fprintf(stderr, "kernel_launch: needs 26 inputs and >= %zu bytes of workspace (got %d, %zu)\n", (size_t)WS_TOTAL, n_in, ws_size); grid = -1; return; }
        int dev = 0, cus = 0, per_cu = 0;
        (void)hipGetDevice(&dev);
        (void)hipDeviceGetAttribute(&cus, hipDeviceAttributeMultiprocessorCount, dev);
        (void)hipFuncSetAttribute((const void*)mega, hipFuncAttributeMaxDynamicSharedMemorySize, LDS_BYTES);
        (void)hipOccupancyMaxActiveBlocksPerMultiprocessor(&per_cu, (const void*)mega, 512, LDS_BYTES);
        if (per_cu < 1) per_cu = 1;
        grid = cus * per_cu;
        if (grid > 256) grid = 256;
    }
    if (grid < 0) return;
    Args a{};
    for (int i = 0; i < 26; ++i) a.in[i] = (const float*)d_in[i];
    a.out = (float*)d_out; a.ws = (unsigned char*)d_ws;
#ifndef ONE_LAUNCH
#define ONE_LAUNCH 1
#endif
    if (ONE_LAUNCH) {
        a.ph_lo = 0; a.ph_hi = NPHASE;
        void* args[] = {&a};
        (void)hipMemsetAsync((unsigned char*)d_ws + WS_MISC + MI_BAR, 0, 768, stream);
        hipError_t e = hipLaunchCooperativeKernel((const void*)mega, dim3(grid), dim3(512), args, LDS_BYTES, stream);
        if (e != hipSuccess) fprintf(stderr, "cooperative launch failed: %s (grid %d)\n", hipGetErrorString(e), grid);
    } else {
        for (int ph = 0; ph < NPHASE; ++ph) { a.ph_lo = ph; a.ph_hi = ph + 1; hipLaunchKernelGGL(mega, dim3(grid), dim3(512), LDS_BYTES, stream, a); }
    }
}
```
